# Optimizing an MI355X kernel written in HIP

```python
import math
import jax, jax.numpy as jnp
from jax import lax
import numpy as np

D_MODEL = 2048
BATCH = 4
SEQ = 4096
DEPTH = 2

CHUNK = 64
Q_BLOCK = 128
N_MIXERS = 2
N_MOD = 9
D_FF = 5632
EPS = 1e-5

DA_HEADS = 8
DA_HEAD_DIM = D_MODEL // (2 * DA_HEADS)
DA_V_DIM = 2 * DA_HEAD_DIM
DA_QKV_WIDTH = 2 * 2 * DA_HEADS * DA_HEAD_DIM + DA_HEADS * DA_V_DIM

RET_HEADS = 8
RET_QK_DIM = D_MODEL // RET_HEADS
RET_V_DIM = 2 * RET_QK_DIM
RET_V_WIDTH = RET_HEADS * RET_V_DIM
RET_PROJ_WIDTH = 2 * RET_HEADS * RET_QK_DIM + 2 * RET_V_WIDTH

N_DA_LAYERS = (DEPTH + 1) // 2
N_RET_LAYERS = DEPTH // 2

kernel_name = "hybrid_diffattn_retention_macaron_block"

F32 = jnp.float32


def rms_norm(x, g):
    xf = x.astype(F32)
    y = xf * lax.rsqrt(jnp.mean(xf * xf, axis=-1, keepdims=True) + EPS)
    return (y * g.astype(F32)).astype(x.dtype)


def head_layer_norm(o, g):
    of = o.astype(F32)
    mu = jnp.mean(of, axis=-1, keepdims=True)
    d = of - mu
    y = d * lax.rsqrt(jnp.mean(d * d, axis=-1, keepdims=True) + EPS)
    return (y * g.astype(F32)).astype(o.dtype)


def modulate(h, shift, scale):
    return h * (1.0 + scale[:, None, :]) + shift[:, None, :]


def swiglu(h, w_in, w_out):
    a, b = jnp.split(h @ w_in, 2, axis=-1)
    return (jax.nn.silu(a) * b) @ w_out


def alibi_slopes(n_heads):
    return jnp.asarray([2.0 ** (-8.0 * (h + 1) / n_heads) for h in range(n_heads)], dtype=F32)


def diff_attention(h, w_qkv, lam, subln_g, w_o, lambda_init):
    B, S, _ = h.shape
    H, d = DA_HEADS, DA_HEAD_DIM
    q, k, v = jnp.split(h @ w_qkv, [2 * H * d, 4 * H * d], axis=-1)
    q = q.reshape(B, S, H, 2, d) * (d ** -0.5)
    k = k.reshape(B, S, H, 2, d)
    v = v.reshape(B, S, H, DA_V_DIM)
    lf = lam.astype(F32)
    lam_val = jnp.exp(jnp.sum(lf[0] * lf[1])) - jnp.exp(jnp.sum(lf[2] * lf[3])) + lambda_init
    slopes = alibi_slopes(H)
    pos = jnp.arange(S)
    key_chunk = pos // CHUNK
    nb = S // Q_BLOCK
    qb = q.reshape(B, nb, Q_BLOCK, H, 2, d).transpose(1, 0, 2, 3, 4, 5)

    def block(args):
        q_blk, b_idx = args
        t = b_idx * Q_BLOCK + jnp.arange(Q_BLOCK)
        s = jnp.einsum("bqhnd,bkhnd->bhnqk", q_blk, k).astype(F32)
        dist = jnp.abs(t[:, None] - pos[None, :]).astype(F32)
        s = s - slopes[:, None, None, None] * dist[None, None]
        allowed = key_chunk[None, :] <= (t // CHUNK)[:, None]
        s = jnp.where(allowed, s, -jnp.inf)
        p = jax.nn.softmax(s, axis=-1)
        a = p[:, :, 0] - lam_val * p[:, :, 1]
        return jnp.einsum("bhqk,bkhe->bqhe", a.astype(v.dtype), v)

    o = lax.map(block, (qb, jnp.arange(nb)))
    o = o.transpose(1, 0, 2, 3, 4).reshape(B, S, H, DA_V_DIM)
    o = rms_norm(o, subln_g) * (1.0 - lambda_init)
    return o.reshape(B, S, H * DA_V_DIM) @ w_o


def retention(h, w_qkvg, gn_g, w_o):
    B, S, _ = h.shape
    H, dk, dv, C = RET_HEADS, RET_QK_DIM, RET_V_DIM, CHUNK
    nc = S // C
    q, k, v, g = jnp.split(h @ w_qkvg, [H * dk, 2 * H * dk, 2 * H * dk + H * dv], axis=-1)
    q = q.astype(F32).reshape(B, nc, C, H, dk).transpose(1, 0, 3, 2, 4)
    k = (k.astype(F32) * (dk ** -0.5)).reshape(B, nc, C, H, dk).transpose(1, 0, 3, 2, 4)
    v = v.astype(F32).reshape(B, nc, C, H, dv).transpose(1, 0, 3, 2, 4)
    log_gamma = jnp.log(1.0 - 2.0 ** (-5.0 - jnp.arange(H, dtype=F32)))
    idx = jnp.arange(C, dtype=F32)
    inner_decay = jnp.exp(log_gamma[:, None, None] * jnp.abs(idx[:, None] - idx[None, :]))
    q_decay = jnp.exp(log_gamma[:, None] * idx[None, :])[..., None]
    k_decay = jnp.exp(log_gamma[:, None] * (C - idx)[None, :])[..., None]
    chunk_decay = jnp.exp(log_gamma * C)[:, None, None]

    def step(state, inp):
        qc, kc, vc = inp
        inner = jnp.einsum("bhid,bhjd->bhij", qc, kc) * inner_decay
        o = (jnp.einsum("bhij,bhje->bhie", inner, vc)
             + jnp.einsum("bhid,bhde->bhie", qc * q_decay, state))
        state = state * chunk_decay + jnp.einsum("bhjd,bhje->bhde", kc * k_decay, vc)
        return state, o

    state0 = jnp.zeros((B, H, dk, dv), F32)
    _, o = lax.scan(step, state0, (q, k, v))
    o = o.transpose(1, 0, 3, 2, 4).reshape(B, S, H, dv).astype(h.dtype)
    o = head_layer_norm(o, gn_g).reshape(B, S, H * dv)
    return (jax.nn.silu(g) * o) @ w_o


def setup_inputs(seed: int = 0) -> dict:
    key = jax.random.key(seed)
    ks = jax.random.split(key, 20)
    D, F = D_MODEL, D_FF
    nrm = lambda k, shape, s: jax.random.normal(k, shape, F32) * s
    return {
        "x": nrm(ks[0], (BATCH, SEQ, D), 1.0),
        "c": nrm(ks[1], (BATCH, D), 1.0),
        "ada_w": nrm(ks[2], (DEPTH, D, N_MOD * D), 0.5 * D ** -0.5),
        "ada_b": nrm(ks[3], (DEPTH, N_MOD * D), 0.02),
        "norm_g": 1.0 + nrm(ks[4], (DEPTH, 3, D), 0.02),
        "ffn_w_in": nrm(ks[5], (DEPTH, 2, D, 2 * F), D ** -0.5),
        "ffn_w_out": nrm(ks[6], (DEPTH, 2, F, D), F ** -0.5),
        "da_w_qkv": nrm(ks[7], (N_DA_LAYERS, D, DA_QKV_WIDTH), D ** -0.5),
        "da_lambda": nrm(ks[8], (N_DA_LAYERS, 4, DA_HEAD_DIM), 0.1),
        "da_subln_g": 1.0 + nrm(ks[9], (N_DA_LAYERS, DA_V_DIM), 0.02),
        "da_w_o": nrm(ks[10], (N_DA_LAYERS, DA_HEADS * DA_V_DIM, D), (DA_HEADS * DA_V_DIM) ** -0.5),
        "ret_w_qkvg": nrm(ks[11], (N_RET_LAYERS, D, RET_PROJ_WIDTH), D ** -0.5),
        "ret_gn_g": 1.0 + nrm(ks[12], (N_RET_LAYERS, RET_V_DIM), 0.02),
        "ret_w_o": nrm(ks[13], (N_RET_LAYERS, RET_V_WIDTH, D), RET_V_WIDTH ** -0.5),
        "final_g": 1.0 + nrm(ks[14], (D,), 0.02),
    }


def reference(x, c, ada_w, ada_b, norm_g, ffn_w_in, ffn_w_out, da_w_qkv, da_lambda, da_subln_g,
              da_w_o, ret_w_qkvg, ret_gn_g, ret_w_o, final_g):
    cs = jax.nn.silu(c)
    for i in range(DEPTH):
        mod = cs @ ada_w[i] + ada_b[i]
        sh1, sc1, g1, sh2, sc2, g2, sh3, sc3, g3 = jnp.split(mod, N_MOD, axis=-1)
        h = modulate(rms_norm(x, norm_g[i, 0]), sh1, sc1)
        x = x + 0.5 * g1[:, None, :] * swiglu(h, ffn_w_in[i, 0], ffn_w_out[i, 0])
        h = modulate(rms_norm(x, norm_g[i, 1]), sh2, sc2)
        j = i // N_MIXERS
        if i % N_MIXERS == 0:
            lambda_init = 0.8 - 0.6 * math.exp(-0.3 * i)
            y = diff_attention(h, da_w_qkv[j], da_lambda[j], da_subln_g[j], da_w_o[j], lambda_init)
        else:
            y = retention(h, ret_w_qkvg[j], ret_gn_g[j], ret_w_o[j])
        x = x + g2[:, None, :] * y
        h = modulate(rms_norm(x, norm_g[i, 2]), sh3, sc3)
        x = x + 0.5 * g3[:, None, :] * swiglu(h, ffn_w_in[i, 1], ffn_w_out[i, 1])
    return rms_norm(x, final_g)
```

```cpp
#include <hip/hip_runtime.h>
#include <cstdio>
#include <cstdint>
#include <cmath>
namespace pg8 {
#define PG8_LAS __attribute__((address_space(3)))
typedef unsigned short bf16_t;
typedef short bf16x8 __attribute__((ext_vector_type(8)));
typedef float f32x4 __attribute__((ext_vector_type(4)));
typedef unsigned u32x4 __attribute__((ext_vector_type(4)));
constexpr int XS_PANEL = 32 * 16384 + 2048;
constexpr int BM = 256, BK = 64, HALF = 128, HTB = HALF * BK * 2  , STAGE_BYTES = 8 * HTB, NXCD = 8, WGM = 4;

__host__ __device__ __forceinline__ int lds_byte(int r, int c) { const int st = (r >> 4) * 2 + (c >> 5), rr = r & 15, cc = c & 31, ob = rr * 64 + cc * 2; return st * 1024 + (ob ^ (((ob >> 9) & 1) << 5)); }
__host__ __device__ __forceinline__ void stage_rc(int b, int& R, int& C) { const int st = b / 1024, sb = b % 1024, swz = sb ^ (((sb >> 9) & 1) << 5); R = (st >> 1) * 16 + swz / 64; C = (st & 1) * 32 + (swz % 64) / 2; }
__host__ __device__ __forceinline__ int perm32(int rho) { const int n = rho >> 4, i = rho & 15; return 8 * (i >> 2) + 4 * n + (i & 3); }

struct Unit { int pm, pn; };
struct Gemm { const bf16_t* A; const bf16_t* Bt; int M, N, K, lda, ldb, atiled; };

struct StaticOrder {
    int nM, nN, nwg, G, c;
    __host__ __device__ void init(int M, int N, int G_, int c_) { nM = M / BM; nN = N / BM; nwg = nM * nN; G = G_; c = c_; }
    __host__ __device__ bool next(int i, Unit& u) const {
        const long L = (long)i * G + c; if (L >= nwg) return false;
        int wgid = (int)L; { const int q = nwg / NXCD, r = nwg % NXCD, xcd = wgid % NXCD, off = wgid / NXCD; wgid = (xcd < r ? xcd * (q + 1) : r * (q + 1) + (xcd - r) * q) + off; }
        const int nig = WGM * nN, gid = wgid / nig, fm = gid * WGM, gsz = (nM - fm) < WGM ? (nM - fm) : WGM;
        u.pm = fm + ((wgid % nig) % gsz); u.pn = (wgid % nig) / gsz; return true;
    }
    __device__ __forceinline__ void a_ready(const Unit&) const {}
    __device__ __forceinline__ void done(const Unit&) const {}
};


typedef float f32x2 __attribute__((ext_vector_type(2)));
typedef __bf16 bf16x2_t __attribute__((ext_vector_type(2)));
__device__ __forceinline__ unsigned cvt_pk_bf16(float lo, float hi) { f32x2 v = {lo, hi}; bf16x2_t b = __builtin_convertvector(v, bf16x2_t); return __builtin_bit_cast(unsigned, b); }
__device__ __forceinline__ float silu_f(float a) { return a * __builtin_amdgcn_rcpf(1.0f + __builtin_amdgcn_exp2f(a * -1.4426950408889634f)); }

__device__ __forceinline__ float rstd_of(const float* ssq, int row) { return 1.0f / sqrtf(ssq[row] * (1.0f / 2048.0f) + 1e-5f); }
constexpr int FFH = 5632;
struct EpiSwiglu {
    static constexpr bool PERM = true, AFTER_DRAIN = false;
    bf16_t* O; int ldc; const float* ssq; const float* bias; int bpitch;
    __device__ __forceinline__ void operator()(const f32x4 (&acc)[2][2][4][2], const Unit& u, int wr, int wc, int fr, int fq) const {
        const int row0 = u.pm * BM + wr * 64 + fr, col0 = u.pn * HALF + wc * 32 + 8 * fq;
        const float* bb = bias + (size_t)(u.pm >> 4) * bpitch + u.pn * BM + wc * 32 + 8 * fq;
        const f32x4 bg0 = *(const f32x4*)bb, bg1 = *(const f32x4*)(bb + 4), bu0 = *(const f32x4*)(bb + HALF), bu1 = *(const f32x4*)(bb + HALF + 4);
        float rsv[8];
#pragma unroll
        for (int i = 0; i < 8; ++i) rsv[i] = ssq[row0 + (i >> 2) * HALF + (i & 3) * 16];
#pragma unroll
        for (int i = 0; i < 8; ++i) rsv[i] = 1.0f / sqrtf(rsv[i] * (1.0f / 2048.0f) + 1e-5f);
#pragma unroll
        for (int ai = 0; ai < 2; ++ai)
#pragma unroll
            for (int m = 0; m < 4; ++m) { const int row = row0 + ai * HALF + m * 16; const float rs = rsv[ai * 4 + m];
                bf16_t* rowp = O + (size_t)u.pm * ((size_t)(FFH / 64) * 16384 + 2048) + (size_t)(col0 >> 6) * 16384 + (size_t)(row & 255) * 64 + (col0 & 63);
                const f32x4 g0 = acc[ai][0][m][0] * rs + bg0, g1 = acc[ai][0][m][1] * rs + bg1, u0 = acc[ai][1][m][0] * rs + bu0, u1 = acc[ai][1][m][1] * rs + bu1;
                u32x4 w;
                w.x = cvt_pk_bf16(silu_f(g0[0]) * u0[0], silu_f(g0[1]) * u0[1]); w.y = cvt_pk_bf16(silu_f(g0[2]) * u0[2], silu_f(g0[3]) * u0[3]);
                w.z = cvt_pk_bf16(silu_f(g1[0]) * u1[0], silu_f(g1[1]) * u1[1]); w.w = cvt_pk_bf16(silu_f(g1[2]) * u1[2], silu_f(g1[3]) * u1[3]);
                *(u32x4*)rowp = w; }
    }
};
typedef _Float16 h16x2 __attribute__((ext_vector_type(2)));
__device__ __forceinline__ unsigned cvt_pk_f16(float lo, float hi) { f32x2 v = {lo, hi}; h16x2 h = __builtin_convertvector(v, h16x2); return __builtin_bit_cast(unsigned, h); }
__device__ __forceinline__ f32x2 unpk_f16(unsigned u) { return __builtin_convertvector(__builtin_bit_cast(h16x2, u), f32x2); }
template <bool NEXT, bool FIRST> struct EpiResid {
    static constexpr bool PERM = true, AFTER_DRAIN = false;
    const void* xin; unsigned short* xout; const float* gate; bf16_t* xs; const float* gsm; float* ssq; int gpitch, ldxs; float gs; int pad_;
    __device__ __forceinline__ void operator()(const f32x4 (&acc)[2][2][4][2], const Unit& u, int wr, int wc, int fr, int fq) const {
        const int row0 = u.pm * BM + wr * 64 + fr, col0 = u.pn * BM + wc * 32 + 8 * fq, b = u.pm >> 4;
        const float* gb = gate + (size_t)b * gpitch + col0;
        f32x4 gv[2][2], sm[2][2];
#pragma unroll
        for (int bj = 0; bj < 2; ++bj)
#pragma unroll
            for (int n = 0; n < 2; ++n) { gv[bj][n] = *(const f32x4*)(gb + bj * HALF + 4 * n) * gs; if (NEXT) sm[bj][n] = *(const f32x4*)(gsm + (size_t)b * 2048 + col0 + bj * HALF + 4 * n); }
        const size_t tile = ((size_t)u.pm * 8 + u.pn) * 65536 + (size_t)(wr * 64 + fr) * 256 + wc * 32 + 8 * fq;
        const unsigned short* hin = (const unsigned short*)xin + tile; unsigned short* hout = xout + tile;
        const float* fin = (const float*)xin + (size_t)row0 * 2048 + col0;
        bf16_t* xst = xs + (size_t)u.pm * XS_PANEL + (size_t)(4 * u.pn + (wc >> 1)) * 16384 + (size_t)(wr * 64 + fr) * 64 + (wc & 1) * 32 + 8 * fq;
        float sq[8];
        if (!FIRST) {
#pragma unroll
            for (int hb = 0; hb < 2; ++hb) {
                u32x4 hx[4][2];
#pragma unroll
                for (int k = 0; k < 4; ++k) { const int rg_ = hb * HALF + k * 16; hx[k][0] = *(const u32x4*)(hin + rg_ * 256); hx[k][1] = *(const u32x4*)(hin + rg_ * 256 + HALF); }
#pragma unroll
                for (int k = 0; k < 4; ++k) { const int it = hb * 4 + k, ai = hb, m = k, rg = ai * HALF + m * 16, row = row0 + rg; float s2 = 0.f;
#pragma unroll
                    for (int bj = 0; bj < 2; ++bj) { const u32x4 h_ = hx[k][bj]; const f32x2 a_ = unpk_f16(h_.x), b_ = unpk_f16(h_.y), c_ = unpk_f16(h_.z), d_ = unpk_f16(h_.w);
                        const f32x4 x0 = (f32x4){a_.x, a_.y, b_.x, b_.y} + gv[bj][0] * acc[ai][bj][m][0], x1 = (f32x4){c_.x, c_.y, d_.x, d_.y} + gv[bj][1] * acc[ai][bj][m][1];
                        u32x4 hw; hw.x = cvt_pk_f16(x0[0], x0[1]); hw.y = cvt_pk_f16(x0[2], x0[3]); hw.z = cvt_pk_f16(x1[0], x1[1]); hw.w = cvt_pk_f16(x1[2], x1[3]);
                        *(u32x4*)(hout + rg * 256 + bj * HALF) = hw;
                        if (NEXT) { s2 += (x0[0] * x0[0] + x0[1] * x0[1]) + (x0[2] * x0[2] + x0[3] * x0[3]) + (x1[0] * x1[0] + x1[1] * x1[1]) + (x1[2] * x1[2] + x1[3] * x1[3]);
                            const f32x4 y0 = x0 * sm[bj][0], y1 = x1 * sm[bj][1]; u32x4 w; w.x = cvt_pk_bf16(y0[0], y0[1]); w.y = cvt_pk_bf16(y0[2], y0[3]); w.z = cvt_pk_bf16(y1[0], y1[1]); w.w = cvt_pk_bf16(y1[2], y1[3]);
                            *(u32x4*)(xst + (size_t)(bj * 2) * 16384 + rg * 64) = w; } }
                    sq[it] = s2; }
            }
        } else {
            f32x4 xv[2][2][2];
#define ER_LOAD(it, buf) do { const int rg_ = ((it) >> 2) * HALF + ((it) & 3) * 16; const float* p_ = fin + (size_t)rg_ * 2048; \
                xv[buf][0][0] = *(const f32x4*)p_; xv[buf][0][1] = *(const f32x4*)(p_ + 4); xv[buf][1][0] = *(const f32x4*)(p_ + HALF); xv[buf][1][1] = *(const f32x4*)(p_ + HALF + 4); } while (0)
            ER_LOAD(0, 0);
#pragma unroll
            for (int it = 0; it < 8; ++it) { const int ai = it >> 2, m = it & 3, rg = ai * HALF + m * 16, row = row0 + rg; float s2 = 0.f;
                if (it + 1 < 8) ER_LOAD(it + 1, (it + 1) & 1);
#pragma unroll
                for (int bj = 0; bj < 2; ++bj) { const f32x4 x0 = xv[it & 1][bj][0] + gv[bj][0] * acc[ai][bj][m][0], x1 = xv[it & 1][bj][1] + gv[bj][1] * acc[ai][bj][m][1];
                    u32x4 hw; hw.x = cvt_pk_f16(x0[0], x0[1]); hw.y = cvt_pk_f16(x0[2], x0[3]); hw.z = cvt_pk_f16(x1[0], x1[1]); hw.w = cvt_pk_f16(x1[2], x1[3]);
                    *(u32x4*)(hout + rg * 256 + bj * HALF) = hw;
                    if (NEXT) { s2 += (x0[0] * x0[0] + x0[1] * x0[1]) + (x0[2] * x0[2] + x0[3] * x0[3]) + (x1[0] * x1[0] + x1[1] * x1[1]) + (x1[2] * x1[2] + x1[3] * x1[3]);
                        const f32x4 y0 = x0 * sm[bj][0], y1 = x1 * sm[bj][1]; u32x4 w; w.x = cvt_pk_bf16(y0[0], y0[1]); w.y = cvt_pk_bf16(y0[2], y0[3]); w.z = cvt_pk_bf16(y1[0], y1[1]); w.w = cvt_pk_bf16(y1[2], y1[3]);
                        *(u32x4*)(xst + (size_t)(bj * 2) * 16384 + rg * 64) = w; } }
                sq[it] = s2; }
#undef ER_LOAD
        }
        if (NEXT) {
#pragma unroll
            for (int it = 0; it < 8; ++it) { float s2 = sq[it]; s2 += __shfl_xor(s2, 16); s2 += __shfl_xor(s2, 32); if (fq == 0) ssq[(size_t)(u.pn * 4 + wc) * 16384 + row0 + (it >> 2) * HALF + (it & 3) * 16] = s2; }
        }
    }
};
template <int MODE> struct EpiProj {
    static constexpr bool PERM = true, AFTER_DRAIN = false;
    bf16_t* O; int ldc; float qscale; const float* ssq; const float* bias; int bpitch;
    __device__ __forceinline__ void operator()(const f32x4 (&acc)[2][2][4][2], const Unit& u, int wr, int wc, int fr, int fq) const {
        const int row0 = u.pm * BM + wr * 64 + fr, colt = u.pn * BM, col0 = colt + wc * 32 + 8 * fq;
        float sc = 1.f; bool act = false;
        if (MODE == 0) { if (colt < 2048) sc = qscale; }
        else { if (colt >= 2048 && colt < 4096) sc = 0.0625f; act = colt >= 8192; }
        const float* bb = bias + (size_t)(u.pm >> 4) * bpitch + col0;
        f32x4 bv[2][2];
#pragma unroll
        for (int bj = 0; bj < 2; ++bj)
#pragma unroll
            for (int n = 0; n < 2; ++n) bv[bj][n] = *(const f32x4*)(bb + bj * HALF + 4 * n);
        float rsv[8];
#pragma unroll
        for (int i = 0; i < 8; ++i) rsv[i] = ssq[row0 + (i >> 2) * HALF + (i & 3) * 16];
#pragma unroll
        for (int i = 0; i < 8; ++i) rsv[i] = 1.0f / sqrtf(rsv[i] * (1.0f / 2048.0f) + 1e-5f);
#pragma unroll
        for (int ai = 0; ai < 2; ++ai)
#pragma unroll
            for (int m = 0; m < 4; ++m) { const int row = row0 + ai * HALF + m * 16; bf16_t* rowp = O + (size_t)u.pn * ((size_t)16384 * 256) + (size_t)row * 256 + (col0 - colt); const float rs = rsv[ai * 4 + m];
#pragma unroll
                for (int bj = 0; bj < 2; ++bj) { f32x4 v0 = (acc[ai][bj][m][0] * rs + bv[bj][0]) * sc, v1 = (acc[ai][bj][m][1] * rs + bv[bj][1]) * sc;
                    if (MODE == 1 && act) {
#pragma unroll
                        for (int j = 0; j < 4; ++j) { v0[j] = silu_f(v0[j]); v1[j] = silu_f(v1[j]); } }
                    u32x4 w; w.x = cvt_pk_bf16(v0[0], v0[1]); w.y = cvt_pk_bf16(v0[2], v0[3]); w.z = cvt_pk_bf16(v1[0], v1[1]); w.w = cvt_pk_bf16(v1[2], v1[3]);
                    *(u32x4*)(rowp + bj * HALF) = w; } }
    }
};

template <class Epi, class Sched, bool ALIGN_EPI = false, bool SP2 = false>
__device__ __forceinline__ void gemm_phase(PG8_LAS unsigned char* lds, const Gemm g, const Sched& S, const Epi& E) {
    const int tid = threadIdx.x, wid = __builtin_amdgcn_readfirstlane(tid >> 6), lane = tid & 63, wr = wid >> 2, wc = wid & 3, fr = lane & 15, fq = lane >> 4;
    const int K = g.K, nt = K / BK;
    unsigned voffA[2], voffB[2];
#pragma unroll
    for (int i = 0; i < 2; ++i) { int R, C; stage_rc(tid * 16 + i * 8192, R, C); const int Rb = Epi::PERM ? ((R & ~31) + perm32(R & 31)) : R;
        voffA[i] = (unsigned)(R * (g.atiled ? 64 : g.lda) + C) * 2u; voffB[i] = (unsigned)(Rb * 64 + C) * 2u; }
    const size_t kstepB = (size_t)(BM * BK * 2), kstepA = g.atiled ? (size_t)(BM * BK * 2) : (size_t)(BK * 2);
    const size_t hstepA = g.atiled ? (size_t)(HALF * BK * 2) : (size_t)HALF * g.lda * 2, hstepB = (size_t)(HALF * BK * 2);
    const size_t tstepA = g.atiled ? ((size_t)(K / BK) * (BM * BK) + 2048) * 2 : 2 * hstepA, tstepB = ((size_t)(K / BK) * (BM * BK) + 2048) * 2;
    const unsigned ldsw = (unsigned)wid * 1024u;
    const int aoff = lds_byte(wr * 64 + fr, fq * 8), boff = lds_byte(wc * 32 + fr, fq * 8);
#define PG8_SA(b, h) (((b) * 2 + (h)) * HTB)
#define PG8_SB(b, h) ((4 + (b) * 2 + (h)) * HTB)
#define PG8_STAGE(bufoff, gbase, voff) do { _Pragma("unroll") for (int _i = 0; _i < 2; ++_i) \
        __builtin_amdgcn_global_load_lds((const unsigned*)((const char*)(gbase) + (voff)[_i]), (PG8_LAS unsigned*)(lds + (bufoff) + ldsw + _i * 8192), 16, 0, 0); } while (0)
#define PG8_LDA(dst, b, h) do { _Pragma("unroll") for (int m = 0; m < 4; ++m) _Pragma("unroll") for (int k = 0; k < 2; ++k) dst[m][k] = *(const PG8_LAS bf16x8*)(lds + PG8_SA(b, h) + aoff + m * 2048 + k * 1024); } while (0)
#define PG8_LDB(dst, b, h) do { _Pragma("unroll") for (int n = 0; n < 2; ++n) _Pragma("unroll") for (int k = 0; k < 2; ++k) dst[n][k] = *(const PG8_LAS bf16x8*)(lds + PG8_SB(b, h) + boff + n * 2048 + k * 1024); } while (0)
#define PG8_MMA(ai, bj, At, Bt) do { __builtin_amdgcn_s_setprio(1); _Pragma("unroll") for (int m = 0; m < 4; ++m) _Pragma("unroll") for (int n = 0; n < 2; ++n) _Pragma("unroll") for (int k = 0; k < 2; ++k) \
        acc[ai][bj][m][n] = __builtin_amdgcn_mfma_f32_16x16x32_bf16(Bt[n][k], At[m][k], acc[ai][bj][m][n], 0, 0, 0); __builtin_amdgcn_s_setprio(0); } while (0)
#define PG8_WAIT_V(n) asm volatile("s_waitcnt vmcnt(" #n ")" ::: "memory")
#define PG8_WAIT_L(n) asm volatile("s_waitcnt lgkmcnt(" #n ")" ::: "memory")
#define PG8_BAR __builtin_amdgcn_s_barrier()
#define PG8_SCHED __builtin_amdgcn_sched_barrier(0)
    Unit cur, nxt; int ui = 0;
    if (!S.next(0, cur)) return;
    f32x4 acc[2][2][4][2];
#pragma unroll
    for (int a = 0; a < 2; ++a)
#pragma unroll
        for (int b = 0; b < 2; ++b)
#pragma unroll
            for (int m = 0; m < 4; ++m)
#pragma unroll
                for (int n = 0; n < 2; ++n) acc[a][b][m][n] = (f32x4){0.f, 0.f, 0.f, 0.f};
    bf16x8 At[4][2], B0[2][2], B1[2][2];
    const char* cA = (const char*)g.A + (size_t)cur.pm * tstepA; const char* cB = (const char*)g.Bt + (size_t)cur.pn * tstepB;
    S.a_ready(cur);
    if constexpr (SP2) {
        PG8_STAGE(PG8_SB(0, 0), cB, voffB); PG8_STAGE(PG8_SB(0, 1), cB + hstepB, voffB); PG8_STAGE(PG8_SA(0, 0), cA, voffA); PG8_STAGE(PG8_SA(0, 1), cA + hstepA, voffA);
        if (wr == 1) PG8_BAR;
        PG8_WAIT_V(2); PG8_BAR;
        PG8_STAGE(PG8_SB(1, 0), cB + kstepB, voffB); PG8_STAGE(PG8_SA(1, 0), cA + kstepA, voffA); PG8_STAGE(PG8_SB(1, 1), cB + hstepB + kstepB, voffB);
        PG8_WAIT_V(6); PG8_BAR;
    } else {
        PG8_STAGE(PG8_SB(0, 0), cB, voffB); PG8_STAGE(PG8_SA(0, 0), cA, voffA); PG8_STAGE(PG8_SB(0, 1), cB + hstepB, voffB); PG8_STAGE(PG8_SA(0, 1), cA + hstepA, voffA);
        if (wr == 1) PG8_BAR;
        PG8_WAIT_V(4); PG8_BAR;
        PG8_STAGE(PG8_SB(1, 0), cB + kstepB, voffB); PG8_STAGE(PG8_SA(1, 0), cA + kstepA, voffA); PG8_STAGE(PG8_SB(1, 1), cB + hstepB + kstepB, voffB);
        PG8_WAIT_V(6); PG8_BAR;
    }
    for (;;) {
        const bool has_next = S.next(ui + 1, nxt);
        const char* nA = has_next ? (const char*)g.A + (size_t)nxt.pm * tstepA : cA; const char* nB = has_next ? (const char*)g.Bt + (size_t)nxt.pn * tstepB : cB;
        for (int t = 0; t < nt; t += 2) {
            const bool last = (t == nt - 2);
            const char* a1 = cA + (size_t)(t + 1) * kstepA;
            const char* a2 = last ? nA : cA + (size_t)(t + 2) * kstepA; const char* b2 = last ? nB : cB + (size_t)(t + 2) * kstepB;
            const char* a3 = a2 + kstepA; const char* b3 = b2 + kstepB;
            if (last && has_next) S.a_ready(nxt);
            if constexpr (SP2) {
            PG8_LDB(B0, 0, 0); PG8_LDB(B1, 0, 1); PG8_SCHED; PG8_LDA(At, 0, 0); PG8_STAGE(PG8_SA(1, 1), a1 + hstepA, voffA);
            PG8_WAIT_V(8); PG8_WAIT_L(0); PG8_BAR; PG8_MMA(0, 0, At, B0); PG8_MMA(0, 1, At, B1); PG8_BAR; PG8_SCHED;
            PG8_LDA(At, 0, 1); PG8_STAGE(PG8_SB(0, 0), b2, voffB); PG8_STAGE(PG8_SB(0, 1), b2 + hstepB, voffB); PG8_STAGE(PG8_SA(0, 0), a2, voffA);
            PG8_WAIT_V(8); PG8_WAIT_L(0); PG8_BAR; PG8_MMA(1, 0, At, B0); PG8_MMA(1, 1, At, B1); PG8_BAR; PG8_SCHED;
            PG8_LDB(B0, 1, 0); PG8_LDB(B1, 1, 1); PG8_SCHED; PG8_LDA(At, 1, 0); PG8_STAGE(PG8_SA(0, 1), a2 + hstepA, voffA);
            PG8_WAIT_V(8); PG8_WAIT_L(0); PG8_BAR; PG8_MMA(0, 0, At, B0); PG8_MMA(0, 1, At, B1); PG8_BAR; PG8_SCHED;
            PG8_LDA(At, 1, 1); PG8_STAGE(PG8_SB(1, 0), b3, voffB); PG8_STAGE(PG8_SB(1, 1), b3 + hstepB, voffB); PG8_STAGE(PG8_SA(1, 0), a3, voffA);
            PG8_WAIT_V(8); PG8_WAIT_L(0); PG8_BAR; PG8_MMA(1, 0, At, B0); PG8_MMA(1, 1, At, B1); PG8_BAR; PG8_SCHED;
            } else {
            PG8_LDB(B0, 0, 0); PG8_SCHED; PG8_LDA(At, 0, 0); PG8_STAGE(PG8_SA(1, 1), a1 + hstepA, voffA);
            PG8_WAIT_L(8); PG8_BAR; PG8_WAIT_L(0); PG8_MMA(0, 0, At, B0); PG8_BAR; PG8_SCHED;
            PG8_LDB(B1, 0, 1); PG8_STAGE(PG8_SB(0, 0), b2, voffB);
            PG8_BAR; PG8_WAIT_L(0); PG8_MMA(0, 1, At, B1); PG8_BAR;
            PG8_LDA(At, 0, 1); PG8_STAGE(PG8_SA(0, 0), a2, voffA);
            PG8_BAR; PG8_WAIT_L(0); PG8_MMA(1, 0, At, B0); PG8_BAR; PG8_SCHED;
            PG8_STAGE(PG8_SB(0, 1), b2 + hstepB, voffB);
            PG8_WAIT_V(6); PG8_BAR; PG8_MMA(1, 1, At, B1); PG8_BAR;
            PG8_LDB(B0, 1, 0); PG8_SCHED; PG8_LDA(At, 1, 0); PG8_STAGE(PG8_SA(0, 1), a2 + hstepA, voffA);
            PG8_WAIT_L(8); PG8_BAR; PG8_WAIT_L(0); PG8_MMA(0, 0, At, B0); PG8_BAR; PG8_SCHED;
            PG8_LDB(B1, 1, 1); PG8_STAGE(PG8_SB(1, 0), b3, voffB);
            PG8_BAR; PG8_WAIT_L(0); PG8_MMA(0, 1, At, B1); PG8_BAR;
            PG8_LDA(At, 1, 1); PG8_STAGE(PG8_SA(1, 0), a3, voffA);
            PG8_BAR; PG8_WAIT_L(0); PG8_MMA(1, 0, At, B0); PG8_BAR; PG8_SCHED;
            PG8_STAGE(PG8_SB(1, 1), b3 + hstepB, voffB);
            PG8_WAIT_V(6); PG8_BAR; PG8_MMA(1, 1, At, B1); PG8_BAR;
            }
        }
        if constexpr (ALIGN_EPI) { if (wr == 0) PG8_BAR; }
        if constexpr (!Epi::AFTER_DRAIN) { E(acc, cur, wr, wc, fr, fq); S.done(cur); }
        if (!has_next) break;
#pragma unroll
        for (int a = 0; a < 2; ++a)
#pragma unroll
            for (int b = 0; b < 2; ++b)
#pragma unroll
                for (int m = 0; m < 4; ++m)
#pragma unroll
                    for (int n = 0; n < 2; ++n) acc[a][b][m][n] = (f32x4){0.f, 0.f, 0.f, 0.f};
        cur = nxt; cA = nA; cB = nB; ++ui;
        if constexpr (ALIGN_EPI) { if (wr == 1) PG8_BAR; }
    }
    PG8_WAIT_V(0);
    if constexpr (!ALIGN_EPI) { if (wr == 0) PG8_BAR; }
    PG8_BAR;
    if constexpr (Epi::AFTER_DRAIN) { E.fused(acc, cur, wr, wc, fr, fq, lds, wid, lane); S.done(cur); }
#undef PG8_SA
#undef PG8_SB
#undef PG8_STAGE
#undef PG8_LDA
#undef PG8_LDB
#undef PG8_MMA
#undef PG8_WAIT_V
#undef PG8_WAIT_L
#undef PG8_BAR
#undef PG8_SCHED
}
}

#ifndef PG8_SP2
#define PG8_SP2 true
#endif
#ifndef PG8_ALIGN
#define PG8_ALIGN true
#endif
#ifndef MK_ONE_LAUNCH
#define MK_ONE_LAUNCH 1
#endif

constexpr int NWAVES = 8;
constexpr int DM = 2048, NB = 4, SEQ = 4096, M = NB * SEQ, FF = 5632, FF2 = 2 * FF;
constexpr int NMOD = 9 * DM;
constexpr int NQKV = 6144, NPROJ = 12288, RVW = 4096;
constexpr int PADE = 64;
constexpr int LDH = DM + PADE, LDF = FF + PADE, LDR = RVW + PADE, LDQ = NQKV + PADE, LDP = NPROJ + PADE;
constexpr size_t PJT = (size_t)M * 256;
constexpr float EPS = 1e-5f;
constexpr float LOG2E = 1.4426950408889634f;
constexpr float QSCALE = 0.08838834764831845f * LOG2E;
constexpr float LAMBDA_INIT0 = 0.2f;

constexpr size_t MiB = 1u << 20;
constexpr size_t WS_CTL = 0, CTL_ZERO_BYTES = 128 * 1024;
constexpr size_t WS_SSQ = 1 * MiB;
constexpr size_t WS_MOD = 2 * MiB;
constexpr size_t WS_GSM = 3 * MiB;
constexpr size_t WS_BIAS = 3 * MiB + 256 * 1024;
constexpr size_t WS_WIN = 6 * MiB, WIN_BYTES = (size_t)FF2 * LDH * 2;
constexpr size_t WS_WOUT = WS_WIN + 4 * WIN_BYTES, WOUT_BYTES = (size_t)DM * LDF * 2;
constexpr size_t WS_WQKV = WS_WOUT + 4 * WOUT_BYTES;
constexpr size_t WS_WODA = WS_WQKV + (size_t)NQKV * LDH * 2;
constexpr size_t WS_WQKVG = WS_WODA + (size_t)DM * LDH * 2;
constexpr size_t WS_WORET = WS_WQKVG + (size_t)NPROJ * LDH * 2;
constexpr size_t WS_H = WS_WORET + (size_t)DM * LDR * 2;
constexpr size_t WS_BIG = WS_H + (size_t)M * LDH * 2;
constexpr size_t WS_AO = WS_BIG + (size_t)M * LDP * 2;
constexpr size_t WS_RO = WS_AO + (size_t)M * LDR * 2;
constexpr size_t WS_XH = WS_RO + (size_t)M * LDR * 2;
constexpr size_t WS_END = WS_XH + (size_t)M * DM * 2;
static_assert(WS_END <= (size_t)1152 * MiB && WS_WIN % 256 == 0 && WIN_BYTES % 256 == 0 && WOUT_BYTES % 256 == 0 && WS_H % 256 == 0 && WS_BIG % 256 == 0 && WS_AO % 256 == 0 && WS_RO % 256 == 0, "ws map");
constexpr int CW_TMO = 0, CW_CODE = 1, CW_BAR = 4096;

constexpr int LDS_BYTES = 163840;
constexpr int MISC_OFF = LDS_BYTES - 256;
constexpr int RING_OFF = 0;

#define GAS __attribute__((address_space(1)))
#define LAS __attribute__((address_space(3)))
typedef unsigned short bf16;
typedef unsigned v4u __attribute__((ext_vector_type(4)));
typedef unsigned v2u __attribute__((ext_vector_type(2)));
typedef float f32x4 __attribute__((ext_vector_type(4)));
typedef GAS unsigned gu32;
#define RLX_AGENT __ATOMIC_RELAXED, __HIP_MEMORY_SCOPE_AGENT
#define LDS_WAIT() asm volatile("s_waitcnt lgkmcnt(0)" ::: "memory")
#define VM_WAIT() asm volatile("s_waitcnt vmcnt(0)" ::: "memory")
__device__ __forceinline__ unsigned pk2(float lo, float hi) { return pg8::cvt_pk_bf16(lo, hi); }
__device__ __forceinline__ float bflo(unsigned u) { return __uint_as_float(u << 16); }
__device__ __forceinline__ float bfhi(unsigned u) { return __uint_as_float(u & 0xffff0000u); }
__device__ __forceinline__ float bf2f(unsigned short b) { return __uint_as_float(((unsigned)b) << 16); }
__device__ __forceinline__ v4u make_srd(const void* base, unsigned nbytes) {
    const unsigned long long a = (unsigned long long)(uintptr_t)base;
    v4u d; d.x = __builtin_amdgcn_readfirstlane((unsigned)a); d.y = __builtin_amdgcn_readfirstlane((unsigned)(a >> 32) & 0xffffu); d.z = nbytes; d.w = 0x00020000u; return d;
}
__device__ __forceinline__ void bstore8(const v4u& srd, v2u data, unsigned voff, int soff) {
    asm volatile("buffer_store_dwordx2 %0, %1, %2, %3 offen" :: "v"(data), "v"(voff), "s"(srd), "s"(soff) : "memory");
}
__device__ __forceinline__ v4u bload16(const v4u& srd, unsigned voff, int soff) {
    v4u r; asm volatile("buffer_load_dwordx4 %0, %1, %2, %3 offen" : "=&v"(r) : "v"(voff), "s"(srd), "s"(soff) : "memory"); return r;
}
__device__ __forceinline__ void dma16(const v4u& srd, unsigned voff, int soff, LAS void* ldsp) {
    unsigned keep; const unsigned la = (unsigned)(uintptr_t)ldsp;
    asm volatile("s_mov_b32 %0, m0\n\ts_mov_b32 m0, %4\n\ts_nop 0\n\tbuffer_load_dwordx4 %1, %2, %3 offen lds\n\ts_mov_b32 m0, %0"
                 : "=&s"(keep) : "v"(voff), "s"(srd), "s"(soff), "s"(la) : "memory");
}

#define XB_TMO      128
#define XB_XCNT(j)  (256  + 64 * (j))
#define XB_XSUB(j)  (1280 + 64 * (j))
#define XB_XGEN(j)  (2304 + 64 * (j))
#define XB_TOP      3328
#define XB_TOPGEN   3392
#define XCD_BAR_WORDS 3456
#define XB_SPIN_CAP (1u << 18)

__device__ __forceinline__ unsigned xb_ld(unsigned* p)              { return __hip_atomic_load(p, __ATOMIC_RELAXED, __HIP_MEMORY_SCOPE_AGENT); }
__device__ __forceinline__ unsigned xb_add(unsigned* p, unsigned v) { return __hip_atomic_fetch_add(p, v, __ATOMIC_RELAXED, __HIP_MEMORY_SCOPE_AGENT); }
__device__ __forceinline__ unsigned xb_xcc_id() { return (unsigned)__builtin_amdgcn_s_getreg((3 << 11) | 20) & 0xFu; }
#define XB_SPIN(cond, bar) do { unsigned _sp = 0; while (cond) { __builtin_amdgcn_s_sleep(1); \
    if ((++_sp & 255u) == 0u) { if (xb_ld(&(bar)[XB_TMO])) break; if (_sp > XB_SPIN_CAP) { atomicAdd(&(bar)[XB_TMO], 1u); break; } } } } while (0)

struct XcdBarrier {
    unsigned* bar; unsigned x;
    volatile LAS unsigned* st;
};

__device__ __forceinline__ XcdBarrier xcd_barrier_post(unsigned* bar, volatile LAS unsigned* st) {
    XcdBarrier b; b.bar = bar; b.x = xb_xcc_id(); b.st = st;
    if (threadIdx.x == 0) (void)xb_add(&bar[XB_XCNT(b.x)], 1u);
    return b;
}
__device__ __forceinline__ void xcd_barrier_complete(unsigned* bar, unsigned x, unsigned& nloc, unsigned& nx) {
    const unsigned G = gridDim.x * gridDim.y * gridDim.z;
    unsigned sum, cnt, mine, sp = 0u;
    for (;;) {
        sum = 0u; cnt = 0u; mine = 0u;
#pragma unroll
        for (unsigned j = 0; j < 16; ++j) { const unsigned c = xb_ld(&bar[XB_XCNT(j)]); sum += c; cnt += (c > 0u) ? 1u : 0u; mine = (j == x) ? c : mine; }
        if (sum == G) break;
        __builtin_amdgcn_s_sleep(1);
        if ((++sp & 255u) == 0u) { if (xb_ld(&bar[XB_TMO])) break; if (sp > XB_SPIN_CAP) { atomicAdd(&bar[XB_TMO], 1u); break; } }
    }
    nloc = mine > 0u ? mine : 1u; nx = cnt > 0u ? cnt : 1u;
}

__device__ __forceinline__ void xcd_barrier(const XcdBarrier& b) {
    asm volatile("s_waitcnt vmcnt(0)" ::: "memory");
    __syncthreads();
    if (threadIdx.x == 0) {
        unsigned* bar = b.bar;
        __builtin_amdgcn_s_waitcnt(0);
        unsigned nloc = b.st[0], nx = b.st[1];
        if (nloc == 0u) { xcd_barrier_complete(bar, b.x, nloc, nx); b.st[0] = nloc; b.st[1] = nx; }
        const unsigned old = xb_add(&bar[XB_XSUB(b.x)], 1u);
        const unsigned gen = old / nloc;
        if (old + 1u == (gen + 1u) * nloc) {
            __builtin_amdgcn_fence(__ATOMIC_RELEASE, "agent");
            asm volatile("s_waitcnt vmcnt(0)" ::: "memory");
            const unsigned og = xb_add(&bar[XB_TOP], 1u);
            const unsigned tg = og / nx;
            if (og + 1u == (tg + 1u) * nx) xb_add(&bar[XB_TOPGEN], 1u);
            else XB_SPIN(xb_ld(&bar[XB_TOPGEN]) == tg, bar);
            __builtin_amdgcn_fence(__ATOMIC_ACQUIRE, "agent");
            xb_add(&bar[XB_XGEN(b.x)], 1u);
            asm volatile("s_waitcnt vmcnt(0)" ::: "memory");
        } else {
            XB_SPIN(xb_ld(&bar[XB_XGEN(b.x)]) == gen, bar);
            __builtin_amdgcn_fence(__ATOMIC_ACQUIRE, "agent");
            asm volatile("s_waitcnt vmcnt(0)" ::: "memory");
        }
    }
    __syncthreads();
}


struct Frame {
    LAS unsigned char* lds;
    volatile LAS unsigned* MISC;
    gu32* ctl;
    int tid, lane, wave, G;
};
__device__ __forceinline__ float wave_sum(float v) {
#pragma unroll
    for (int o = 1; o < 64; o <<= 1) v += __shfl_xor(v, o);
    return v;
}

__device__ __forceinline__ void mod_phase(Frame& F, const float* c, const float* ada_w, const float* ada_b, float* mod) {
    LAS float* cs = (LAS float*)F.lds;
    LAS float* red = (LAS float*)(F.lds + 32768);
    for (int i = F.tid; i < NB * DM; i += NWAVES * 64) { const float v = c[i]; cs[i] = v / (1.0f + __expf(-v)); }
    __syncthreads();
    const int cg = F.tid % 36, ks = F.tid / 36;
    for (int cb = blockIdx.x; cb < 256; cb += F.G) {
        const int layer = cb >> 7, col0 = (cb & 127) * 144;
        if (ks < 14) {
            const float* W = ada_w + (size_t)layer * DM * NMOD + col0 + cg * 4;
            f32x4 a0 = {0.f, 0.f, 0.f, 0.f}, a1 = a0, a2 = a0, a3 = a0;
#pragma unroll 4
            for (int k = ks; k < DM; k += 14) {
                const f32x4 w = *(const f32x4*)(W + (size_t)k * NMOD);
                a0 += w * cs[k]; a1 += w * cs[DM + k]; a2 += w * cs[2 * DM + k]; a3 += w * cs[3 * DM + k];
            }
            LAS f32x4* r = (LAS f32x4*)(red + (ks * 4) * 144 + cg * 4);
            r[0] = a0; r[36] = a1; r[72] = a2; r[108] = a3;
        }
        __syncthreads();
        for (int o = F.tid; o < 4 * 144; o += NWAVES * 64) {
            const int b = o / 144, cc = o % 144; float s = 0.f;
#pragma unroll
            for (int k2 = 0; k2 < 14; ++k2) s += red[(k2 * 4 + b) * 144 + cc];
            mod[(size_t)(layer * NB + b) * NMOD + col0 + cc] = s + ada_b[(size_t)layer * NMOD + col0 + cc];
        }
        __syncthreads();
    }
}
__device__ __forceinline__ size_t wt_off(int n, int k, int K) { return (size_t)(n >> 8) * ((size_t)(K >> 6) * 16384 + 2048) + (size_t)(k >> 6) * 16384 + (size_t)(n & 255) * 64 + (k & 63); }
__device__ __forceinline__ void transpose_item(const float* W, int K, int N, bf16* WT, int ldk, int mode, LAS float* scr, int item, int lane) {
    const int nblk = N / 32, kb = item / nblk, nb = item % nblk, k0 = 64 * kb, n0 = 32 * nb;
#pragma unroll 8
    for (int i = 0; i < 32; ++i) { const int kk = 2 * i + (lane >> 5); scr[kk * 33 + (lane & 31)] = W[(size_t)(k0 + kk) * N + n0 + (lane & 31)]; }
    LDS_WAIT(); asm volatile("" ::: "memory");
    int r0 = n0;
    if (mode == 1) { const int up = n0 >= FF ? 1 : 0, j = n0 - up * FF; r0 = (j >> 7) * 256 + up * 128 + (j & 127); }
    const int c = lane & 7;
#pragma unroll
    for (int j = 0; j < 4; ++j) { const int n = (lane >> 3) + 8 * j; const LAS float* s = scr + (8 * c) * 33 + n;
        v4u o; o.x = pk2(s[0 * 33], s[1 * 33]); o.y = pk2(s[2 * 33], s[3 * 33]); o.z = pk2(s[4 * 33], s[5 * 33]); o.w = pk2(s[6 * 33], s[7 * 33]);
        *(GAS v4u*)(WT + wt_off(r0 + n, k0 + 8 * c, K)) = o; }
    LDS_WAIT(); asm volatile("" ::: "memory");
}
struct WPtrs { const float *w_in, *w_out, *w_qkv, *w_oda, *w_qkvg, *w_oret; unsigned char* ws; };
__device__ __forceinline__ void convert_phase(Frame& F, const WPtrs& P) {
    LAS float* scr = (LAS float*)(F.lds + F.wave * 16384);
    const int gw = blockIdx.x * NWAVES + F.wave, NGW = F.G * NWAVES;
    constexpr int I_IN = (DM / 64) * (FF2 / 32), I_OUT = (FF / 64) * (DM / 32), I_QKV = (DM / 64) * (NQKV / 32), I_ODA = (DM / 64) * (DM / 32), I_QKVG = (DM / 64) * (NPROJ / 32), I_ORET = (RVW / 64) * (DM / 32);
    constexpr int NITEMS = 4 * I_IN + 4 * I_OUT + I_QKV + I_ODA + I_QKVG + I_ORET;
    for (int it = gw; it < NITEMS; it += NGW) {
        int r = it;
        if (r < 4 * I_IN) { const int f = r / I_IN; transpose_item(P.w_in + (size_t)f * DM * FF2, DM, FF2, (bf16*)(P.ws + WS_WIN + f * WIN_BYTES), LDH, 1, scr, r % I_IN, F.lane); continue; } r -= 4 * I_IN;
        if (r < 4 * I_OUT) { const int f = r / I_OUT; transpose_item(P.w_out + (size_t)f * FF * DM, FF, DM, (bf16*)(P.ws + WS_WOUT + f * WOUT_BYTES), LDF, 0, scr, r % I_OUT, F.lane); continue; } r -= 4 * I_OUT;
        if (r < I_QKV) { transpose_item(P.w_qkv, DM, NQKV, (bf16*)(P.ws + WS_WQKV), LDH, 0, scr, r, F.lane); continue; } r -= I_QKV;
        if (r < I_ODA) { transpose_item(P.w_oda, DM, DM, (bf16*)(P.ws + WS_WODA), LDH, 0, scr, r, F.lane); continue; } r -= I_ODA;
        if (r < I_QKVG) { transpose_item(P.w_qkvg, DM, NPROJ, (bf16*)(P.ws + WS_WQKVG), LDH, 0, scr, r, F.lane); continue; } r -= I_QKVG;
        transpose_item(P.w_oret, RVW, DM, (bf16*)(P.ws + WS_WORET), LDR, 0, scr, r, F.lane);
    }
}
constexpr int BIASP = 12288;
__device__ __forceinline__ void pre_phase(Frame& F, const float* A_x_in, const float* A_norm_g, const float* A_mod, unsigned char* A_ws) {
    float* gsm = (float*)(A_ws + WS_GSM); float* bias = (float*)(A_ws + WS_BIAS); float* ssq = (float*)(A_ws + WS_SSQ); bf16* Hb = (bf16*)(A_ws + WS_H);
    const int gw = blockIdx.x * NWAVES + F.wave, NGW = F.G * NWAVES;
    for (int i = blockIdx.x * (NWAVES * 64) + F.tid; i < 6 * NB * DM; i += F.G * NWAVES * 64) {
        const int s = i / (NB * DM), b = (i / DM) % NB, col = i % DM, layer = s / 3, j = s % 3;
        gsm[i] = A_norm_g[(size_t)s * DM + col] * (1.0f + A_mod[(size_t)(layer * NB + b) * NMOD + (3 * j + 1) * DM + col]);
    }
    for (int m = gw; m < M; m += NGW) {
        const int b = m >> 12;
        const f32x4* sc4 = (const f32x4*)(A_mod + (size_t)b * NMOD + DM); const f32x4* g4 = (const f32x4*)A_norm_g;
        const f32x4* xr = (const f32x4*)(A_x_in + (size_t)m * DM);
        f32x4 v[8]; float ss = 0.f;
#pragma unroll
        for (int j = 0; j < 8; ++j) { v[j] = xr[F.lane + 64 * j]; ss += (v[j].x * v[j].x + v[j].y * v[j].y) + (v[j].z * v[j].z + v[j].w * v[j].w); }
        ss = wave_sum(ss);
        if (F.lane == 0) ssq[m] = ss;
        bf16* o = Hb + (size_t)(m >> 8) * pg8::XS_PANEL + (size_t)(m & 255) * 64;
#pragma unroll
        for (int j = 0; j < 8; ++j) { const int c4 = F.lane + 64 * j, col = 4 * c4; const f32x4 y = v[j] * (g4[c4] * (sc4[c4] + 1.0f));
            v2u w; w.x = pk2(y.x, y.y); w.y = pk2(y.z, y.w); *(v2u*)(o + (size_t)(col >> 6) * 16384 + (col & 63)) = w; }
    }
    for (int s = 0; s < 6; ++s) {
        const int layer = s / 3, j = s % 3;
        const bf16* Wt; int N;
        if (s == 1) { Wt = (const bf16*)(A_ws + WS_WQKV); N = NQKV; } else if (s == 4) { Wt = (const bf16*)(A_ws + WS_WQKVG); N = NPROJ; }
        else { const int f = (s == 0) ? 0 : (s == 2) ? 1 : (s == 3) ? 2 : 3; Wt = (const bf16*)(A_ws + WS_WIN + (size_t)f * WIN_BYTES); N = FF2; }
        float sh[4][32];
#pragma unroll
        for (int b = 0; b < 4; ++b)
#pragma unroll
            for (int jj = 0; jj < 4; ++jj) { const float* sp = A_mod + (size_t)(layer * NB + b) * NMOD + (3 * j) * DM + 8 * F.lane + 512 * jj;
                const f32x4 a = *(const f32x4*)sp, c = *(const f32x4*)(sp + 4);
                sh[b][8 * jj + 0] = a.x; sh[b][8 * jj + 1] = a.y; sh[b][8 * jj + 2] = a.z; sh[b][8 * jj + 3] = a.w; sh[b][8 * jj + 4] = c.x; sh[b][8 * jj + 5] = c.y; sh[b][8 * jj + 6] = c.z; sh[b][8 * jj + 7] = c.w; }
        for (int n = gw; n < N; n += NGW) {
            const bf16* wr = Wt + wt_off(n, 8 * (F.lane & 7), DM) + (size_t)(F.lane >> 3) * 16384;
            float a0 = 0.f, a1 = 0.f, a2 = 0.f, a3 = 0.f;
#pragma unroll
            for (int jj = 0; jj < 4; ++jj) { const v4u wv = *(const v4u*)(wr + (size_t)(8 * jj) * 16384);
                const float w0 = bflo(wv.x), w1 = bfhi(wv.x), w2 = bflo(wv.y), w3 = bfhi(wv.y), w4 = bflo(wv.z), w5 = bfhi(wv.z), w6 = bflo(wv.w), w7 = bfhi(wv.w);
#define PRE_DOT(acc, b) acc += w0 * sh[b][8 * jj] + w1 * sh[b][8 * jj + 1] + w2 * sh[b][8 * jj + 2] + w3 * sh[b][8 * jj + 3] + w4 * sh[b][8 * jj + 4] + w5 * sh[b][8 * jj + 5] + w6 * sh[b][8 * jj + 6] + w7 * sh[b][8 * jj + 7]
                PRE_DOT(a0, 0); PRE_DOT(a1, 1); PRE_DOT(a2, 2); PRE_DOT(a3, 3);
#undef PRE_DOT
            }
            a0 = wave_sum(a0); a1 = wave_sum(a1); a2 = wave_sum(a2); a3 = wave_sum(a3);
            if (F.lane == 0) { float* bo = bias + (size_t)(s * NB) * BIASP + n; bo[0] = a0; bo[BIASP] = a1; bo[2 * BIASP] = a2; bo[3 * BIASP] = a3; }
        }
    }
}
__device__ __forceinline__ void ssq_reduce(Frame& F, const float* part, float* ssq) {
    for (int row = blockIdx.x * (NWAVES * 64) + F.tid; row < M; row += F.G * NWAVES * 64) { float s = 0.f;
#pragma unroll
        for (int k = 0; k < 32; ++k) s += part[(size_t)k * M + row];
        ssq[row] = s; }
}
__device__ __forceinline__ void final_phase(Frame& F, const unsigned short* xh, float* out, const float* g) {
    const int gw = blockIdx.x * NWAVES + F.wave, NGW = F.G * NWAVES;
    for (int m = gw; m < M; m += NGW) {
        const unsigned short* xr = xh + (size_t)(m >> 8) * 8 * 65536 + (size_t)(m & 255) * 256 + 4 * F.lane;
        f32x4 v[8]; float ss = 0.f;
#pragma unroll
        for (int j = 0; j < 8; ++j) { const v2u h = *(const v2u*)(xr + (size_t)j * 65536); const pg8::f32x2 a = pg8::unpk_f16(h.x), c = pg8::unpk_f16(h.y);
            v[j] = (f32x4){a.x, a.y, c.x, c.y}; ss += (v[j].x * v[j].x + v[j].y * v[j].y) + (v[j].z * v[j].z + v[j].w * v[j].w); }
        const float rstd = 1.0f / sqrtf(wave_sum(ss) * (1.0f / DM) + EPS);
        f32x4* orow = (f32x4*)(out + (size_t)m * DM); const f32x4* g4 = (const f32x4*)g;
#pragma unroll
        for (int j = 0; j < 8; ++j) orow[F.lane + 64 * j] = (v[j] * rstd) * g4[F.lane + 64 * j];
    }
}

constexpr size_t WS_KMAX = 65536;
__device__ __forceinline__ void att_kmax_phase(Frame& F, const bf16* qkv, unsigned* kmax) {
    const int gw = blockIdx.x * NWAVES + F.wave, NGW = F.G * NWAVES;
    for (int r8 = gw; r8 < M / 8; r8 += NGW) {
        float mx = 0.f;
        for (int j = 0; j < 8; ++j) { const v4u* kp = (const v4u*)(qkv + (size_t)(8 + (F.lane >> 3)) * PJT + (size_t)(r8 * 8 + j) * 256 + 32 * (F.lane & 7)); float ss = 0.f;
#pragma unroll
            for (int u = 0; u < 4; ++u) { const v4u kk = kp[u];
                ss += bflo(kk.x) * bflo(kk.x) + bfhi(kk.x) * bfhi(kk.x) + bflo(kk.y) * bflo(kk.y) + bfhi(kk.y) * bfhi(kk.y) + bflo(kk.z) * bflo(kk.z) + bfhi(kk.z) * bfhi(kk.z) + bflo(kk.w) * bflo(kk.w) + bfhi(kk.w) * bfhi(kk.w); }
            ss += __shfl_xor(ss, 1); ss += __shfl_xor(ss, 2); mx = fmaxf(mx, ss); }
        if ((F.lane & 3) == 0) atomicMax(kmax + ((r8 * 8) >> 12) * 16 + (F.lane >> 2), __float_as_uint(mx));
    }
}
namespace attp {
typedef short bf16x8 __attribute__((ext_vector_type(8)));
typedef short s16x4 __attribute__((ext_vector_type(4)));
typedef float f32x16 __attribute__((ext_vector_type(16)));
constexpr int KTILE = 2 * 32 * 256;
constexpr int VSTR = 1088, VTILE = 16 * VSTR;
constexpr int PSTREAM = 2 * 1024 + 256 + 16;
constexpr int K_OFF = 0, V_OFF = 3 * KTILE, P_OFF = V_OFF + 4 * VTILE, LQ_OFF = P_OFF + 2 * 4 * PSTREAM, SUBG_OFF = LQ_OFF + 4 * 32 * 4, MARG_OFF = SUBG_OFF + 1024, END_OFF = MARG_OFF + 16;
static_assert(END_OFF <= MISC_OFF && 2 * 128 * 64 * 4 <= P_OFF, "attention LDS map");
__device__ __forceinline__ s16x4 vtr(const LAS char* p) { return __builtin_bit_cast(s16x4, __builtin_amdgcn_ds_read_tr16_b64_v4i16((LAS s16x4*)p)); }
__device__ __forceinline__ float hmax(float v) { auto rr = __builtin_amdgcn_permlane32_swap(__float_as_uint(v), __float_as_uint(v), false, false); return fmaxf(__uint_as_float(rr[0]), __uint_as_float(rr[1])); }
__device__ __forceinline__ float hsum(float v) { auto rr = __builtin_amdgcn_permlane32_swap(__float_as_uint(v), __float_as_uint(v), false, false); return __uint_as_float(rr[0]) + __uint_as_float(rr[1]); }
__device__ __forceinline__ bf16x8 pack8(const f32x16& p, int s) {
    v4u w; w.x = pg8::cvt_pk_bf16(p[8 * s + 0], p[8 * s + 1]); w.y = pg8::cvt_pk_bf16(p[8 * s + 2], p[8 * s + 3]); w.z = pg8::cvt_pk_bf16(p[8 * s + 4], p[8 * s + 5]); w.w = pg8::cvt_pk_bf16(p[8 * s + 6], p[8 * s + 7]);
    return __builtin_bit_cast(bf16x8, w);
}
}
__device__ __forceinline__ void att_pc_phase(Frame& F, const bf16* qkv, bf16* ao, const float* lam, const float* subg, const float* kmax) {
    using namespace attp;
    __builtin_amdgcn_s_waitcnt(0x0F70);
    LAS char* L = (LAS char*)F.lds;
    const int lane = F.lane, r = lane & 31, hh = lane >> 5, w = F.wave;
    const bool producer = w < 4; const int st = w & 3, map = st >> 1, rg = st & 1;
    if (w == 0) {
        const float s1 = wave_sum(lam[lane] * lam[128 + lane] + lam[64 + lane] * lam[192 + lane]);
        const float s2 = wave_sum(lam[256 + lane] * lam[384 + lane] + lam[320 + lane] * lam[448 + lane]);
        if (lane == 0) F.MISC[16] = __float_as_uint(expf(s1) - expf(s2) + LAMBDA_INIT0);
    }
    if (F.tid < 256) ((LAS float*)(L + SUBG_OFF))[F.tid] = subg[F.tid] * (1.0f - LAMBDA_INIT0);
    __syncthreads();
    const float lamv = __uint_as_float(F.MISC[16]);
    const int vcu = (F.G % 8 == 0) ? (int)(blockIdx.x & 7) * (F.G >> 3) + (int)(blockIdx.x >> 3) : (int)blockIdx.x;
    const unsigned ksrc_b = (unsigned)((lane >> 4) * 512 + (((lane & 15) ^ ((4 * (w & 3) + (lane >> 4)) & 15)) * 16));
    const unsigned vsrc_b = (unsigned)((lane >> 5) * 16 * 512 + (lane & 31) * 16);
    const unsigned qsrc_b = (unsigned)((32 * rg + r) * 256 + 8 * hh) * 2u;
    const __amdgpu_buffer_rsrc_t rs_qkv = __builtin_amdgcn_make_buffer_rsrc((void*)qkv, 0, (int)(24 * PJT * 2), 0x00020000);
    const __amdgpu_buffer_rsrc_t rs_ao = __builtin_amdgcn_make_buffer_rsrc((void*)ao, 0, M * LDH * 2, 0x00020000);
    const v4u sd_qkv = make_srd(qkv, (unsigned)(24 * PJT * 2));
    const unsigned kc16 = (unsigned)(16 * (hh ^ (r & 15)));
    const int kfrag_l = map * 8192 + r * 256;
    const int vfrag_l = (4 * hh + ((lane & 15) >> 2)) * VSTR + ((lane >> 4) & 1) * 32 + (lane & 3) * 8;
    const int pst_l = st * PSTREAM;
    for (int p = vcu; p < 1024; p += F.G) {
        const int pr = p & 31, b = (p >> 8) & 3, xs_ = (p >> 5) & 7, kr = (p >> 8) & 3, h = (kr == 0) ? xs_ : (kr == 1) ? 7 - xs_ : (kr == 2) ? (xs_ ^ 4) : 7 - (xs_ ^ 4);
        const int rowbase = b * SEQ;
        const float slope2 = exp2f(-(float)(h + 1)) * LOG2E;
        const int kbase_b = (int)(((size_t)(8 + h) * PJT + (size_t)rowbase * 256) * 2), vbase_b = (int)(((size_t)(16 + h) * PJT + (size_t)rowbase * 256) * 2);
        for (int half2 = 0; half2 < 2; ++half2) {
            const int c = half2 ? 63 - pr : pr;
            const int tq = c * 64 + 32 * rg + r;
            const int n32 = 2 * (c + 1);
            f32x16 o[8];
#define ATP_QF(ks) __builtin_bit_cast(bf16x8, (f32x4){o[(ks) >> 2][4 * ((ks) & 3)], o[(ks) >> 2][4 * ((ks) & 3) + 1], o[(ks) >> 2][4 * ((ks) & 3) + 2], o[(ks) >> 2][4 * ((ks) & 3) + 3]})
            float mrun = 0.f, lsum = 0.f; bool fresh = true;
            if (producer) { const int qoff = (int)(((size_t)h * PJT + (size_t)(rowbase + c * 64) * 256 + map * 128) * 2);
#pragma unroll
                for (int ks = 0; ks < 8; ++ks) { const f32x4 q4 = __builtin_bit_cast(f32x4, __builtin_amdgcn_raw_buffer_load_b128(rs_qkv, qsrc_b, qoff + 32 * ks, 0));
                    o[ks >> 2][4 * (ks & 3)] = q4[0]; o[ks >> 2][4 * (ks & 3) + 1] = q4[1]; o[ks >> 2][4 * (ks & 3) + 2] = q4[2]; o[ks >> 2][4 * (ks & 3) + 3] = q4[3]; } }
            else {
#pragma unroll
                for (int eb = 0; eb < 8; ++eb)
#pragma unroll
                    for (int i = 0; i < 16; ++i) o[eb][i] = 0.f; }
            float qnk = 0.f;
            if (producer) { float qq = 0.f;
#pragma unroll
                for (int e = 0; e < 32; ++e) { const unsigned u_ = __float_as_uint(o[e >> 4][e & 15]); qq += bflo(u_) * bflo(u_) + bfhi(u_) * bfhi(u_); }
                qnk = sqrtf(hsum(qq)) * sqrtf(kmax[b * 16 + h * 2 + map]) * 1.004f; }
            int nend = n32;
            __builtin_amdgcn_s_waitcnt(0x0F70);
#define ATP_ISSUE(kt32, ti) do { const int k0_ = (kt32) * 32; \
        _Pragma("unroll") for (int i_ = 0; i_ < 2; ++i_) { const int pc_ = (w & 3) + 4 * i_; \
            dma16(sd_qkv, ksrc_b, kbase_b + (k0_ + 4 * pc_) * 512 + (w >> 2) * 256, (LAS void*)(L + K_OFF + ((ti) % 3) * KTILE + (w >> 2) * 8192 + pc_ * 1024)); } \
        _Pragma("unroll") for (int i_ = 0; i_ < 2; ++i_) { const int pc_ = 2 * w + i_; \
            dma16(sd_qkv, vsrc_b, vbase_b + (k0_ + pc_) * 512, (LAS void*)(L + V_OFF + ((ti) & 3) * VTILE + pc_ * VSTR)); } } while (0)
            ATP_ISSUE(n32 - 1, 0); ATP_ISSUE(n32 - 2, 1);
            int issued = 2;
            for (int i = 0; i <= nend; ++i) {
                if (issued > i + 1) asm volatile("s_waitcnt vmcnt(4)" ::: "memory"); else VM_WAIT();
                __syncthreads();
                if (i == 2) { const LAS float* mg = (const LAS float*)(L + MARG_OFF); const float need = fmaxf(fmaxf(mg[0], mg[1]), fmaxf(mg[2], mg[3]));
                    const float xcut = (need + 161.0f) / (32.0f * slope2) + 1.97f; const int idead = (xcut < 4096.0f ? (int)xcut : 4096) + 2; nend = idead < n32 ? idead : n32; if (nend < 2) nend = 2; }
                if (i + 2 < nend) { ATP_ISSUE(n32 - 3 - i, i + 2); issued = i + 3; }
                if (producer) {
                    if (i < nend) {
                        const int kt32 = n32 - 1 - i;
                        const LAS char* Kb = L + K_OFF + (i % 3) * KTILE + kfrag_l;
                        f32x16 S;
                        const int j0 = kt32 * 32 + 4 * hh - tq;
                        if (kt32 < 2 * c) {
                            const float b0 = slope2 * (float)j0 - mrun, b1 = b0 + slope2, b2 = b1 + slope2, b3 = b2 + slope2, s8 = 8.0f * slope2, s16 = 16.0f * slope2, s24 = 24.0f * slope2;
                            S[0] = b0; S[1] = b1; S[2] = b2; S[3] = b3; S[4] = b0 + s8; S[5] = b1 + s8; S[6] = b2 + s8; S[7] = b3 + s8;
                            S[8] = b0 + s16; S[9] = b1 + s16; S[10] = b2 + s16; S[11] = b3 + s16; S[12] = b0 + s24; S[13] = b1 + s24; S[14] = b2 + s24; S[15] = b3 + s24;
                        } else {
#pragma unroll
                            for (int i_ = 0; i_ < 16; ++i_) S[i_] = fmaf(-slope2, fabsf((float)(j0 + ((i_ & 3) + 8 * (i_ >> 2)))), -mrun);
                        }
                        { const unsigned kb_ = (unsigned)(uintptr_t)Kb;
                          asm volatile("s_nop 4\n\tv_xor_b32 v220, 0, %[c]\n\tv_add_u32 v220, v220, %[b]\n\tds_read_b128 v[220:223], v220\n\tv_xor_b32 v224, 32, %[c]\n\tv_add_u32 v224, v224, %[b]\n\tds_read_b128 v[224:227], v224\n\tv_xor_b32 v228, 64, %[c]\n\tv_add_u32 v228, v228, %[b]\n\tds_read_b128 v[228:231], v228\n\tv_xor_b32 v232, 96, %[c]\n\tv_add_u32 v232, v232, %[b]\n\tds_read_b128 v[232:235], v232\n\tv_xor_b32 v236, 128, %[c]\n\tv_add_u32 v236, v236, %[b]\n\tds_read_b128 v[236:239], v236\n\tv_xor_b32 v240, 160, %[c]\n\tv_add_u32 v240, v240, %[b]\n\tds_read_b128 v[240:243], v240\n\tv_xor_b32 v244, 192, %[c]\n\tv_add_u32 v244, v244, %[b]\n\tds_read_b128 v[244:247], v244\n\tv_xor_b32 v248, 224, %[c]\n\tv_add_u32 v248, v248, %[b]\n\tds_read_b128 v[248:251], v248\n\ts_waitcnt lgkmcnt(7)\n\tv_mfma_f32_32x32x16_bf16 %[s], v[220:223], %[q0], %[s]\n\ts_waitcnt lgkmcnt(6)\n\tv_mfma_f32_32x32x16_bf16 %[s], v[224:227], %[q1], %[s]\n\ts_waitcnt lgkmcnt(5)\n\tv_mfma_f32_32x32x16_bf16 %[s], v[228:231], %[q2], %[s]\n\ts_waitcnt lgkmcnt(4)\n\tv_mfma_f32_32x32x16_bf16 %[s], v[232:235], %[q3], %[s]\n\ts_waitcnt lgkmcnt(3)\n\tv_mfma_f32_32x32x16_bf16 %[s], v[236:239], %[q4], %[s]\n\ts_waitcnt lgkmcnt(2)\n\tv_mfma_f32_32x32x16_bf16 %[s], v[240:243], %[q5], %[s]\n\ts_waitcnt lgkmcnt(1)\n\tv_mfma_f32_32x32x16_bf16 %[s], v[244:247], %[q6], %[s]\n\ts_waitcnt lgkmcnt(0)\n\tv_mfma_f32_32x32x16_bf16 %[s], v[248:251], %[q7], %[s]\n\ts_nop 15"
                              : [s] "+v"(S) : [b] "v"(kb_), [c] "v"(kc16), [q0] "v"(ATP_QF(0)), [q1] "v"(ATP_QF(1)), [q2] "v"(ATP_QF(2)), [q3] "v"(ATP_QF(3)), [q4] "v"(ATP_QF(4)), [q5] "v"(ATP_QF(5)), [q6] "v"(ATP_QF(6)), [q7] "v"(ATP_QF(7))
                              : "memory", "v220", "v221", "v222", "v223", "v224", "v225", "v226", "v227", "v228", "v229", "v230", "v231", "v232", "v233", "v234", "v235", "v236", "v237", "v238", "v239", "v240", "v241", "v242", "v243", "v244", "v245", "v246", "v247", "v248", "v249", "v250", "v251"); }
                        float mx = fmaxf(S[0], S[1]);
#pragma unroll
                        for (int i_ = 2; i_ < 16; ++i_) mx = fmaxf(mx, S[i_]);
                        const bool live = fresh || !__all(mx < -160.0f);
                        LAS char* pb = L + P_OFF + (i & 1) * (4 * PSTREAM) + pst_l;
                        float alpha = 1.0f;
                        if (live) {
                            mx = hmax(mx);
                            if (fresh || __any(mx > 8.0f)) { const float sh = fresh ? mx : fmaxf(mx, 0.0f);
#pragma unroll
                                for (int i_ = 0; i_ < 16; ++i_) S[i_] -= sh;
                                mrun += sh; if (!fresh) alpha = __builtin_amdgcn_exp2f(-sh); fresh = false; }
                            float ls = 0.f;
#pragma unroll
                            for (int i_ = 0; i_ < 16; ++i_) { S[i_] = __builtin_amdgcn_exp2f(S[i_]); ls += S[i_]; }
                            lsum = lsum * alpha + ls;
                            *(LAS bf16x8*)(pb + lane * 16) = pack8(S, 0); *(LAS bf16x8*)(pb + 1024 + lane * 16) = pack8(S, 1);
                            *(LAS float*)(pb + 2048 + lane * 4) = alpha;
                        }
                        if (lane == 0) *(LAS unsigned*)(pb + 2304) = live ? 1u : 0u;
                        if (i == 1) { float mg = qnk - mrun;
#pragma unroll
                            for (int o_ = 1; o_ < 64; o_ <<= 1) mg = fmaxf(mg, __shfl_xor(mg, o_));
                            if (lane == 0) ((LAS float*)(L + MARG_OFF))[st] = mg; }
                    }
                } else if (i >= 1) {
                    const LAS char* pb = L + P_OFF + ((i - 1) & 1) * (4 * PSTREAM) + pst_l;
                    const unsigned live = __builtin_amdgcn_readfirstlane(*(const LAS unsigned*)(pb + 2304));
                    if (live) {
                        const float alpha = *(const LAS float*)(pb + 2048 + lane * 4);
                        const bf16x8 pf0 = *(const LAS bf16x8*)(pb + lane * 16), pf1 = *(const LAS bf16x8*)(pb + 1024 + lane * 16);
                        if (__any(alpha != 1.0f)) {
#pragma unroll
                            for (int eb = 0; eb < 8; ++eb) o[eb] = o[eb] * alpha; }
                        { const unsigned va_ = (unsigned)(uintptr_t)(L + V_OFF + ((i - 1) & 3) * VTILE + vfrag_l);
                          asm volatile("s_nop 4\n\tds_read_b64_tr_b16 v[228:229], %[a] offset:0\n\tds_read_b64_tr_b16 v[230:231], %[a] offset:8704\n\tds_read_b64_tr_b16 v[232:233], %[a] offset:512\n\tds_read_b64_tr_b16 v[234:235], %[a] offset:9216\n\tds_read_b64_tr_b16 v[236:237], %[a] offset:64\n\tds_read_b64_tr_b16 v[238:239], %[a] offset:8768\n\tds_read_b64_tr_b16 v[240:241], %[a] offset:576\n\tds_read_b64_tr_b16 v[242:243], %[a] offset:9280\n\tds_read_b64_tr_b16 v[244:245], %[a] offset:128\n\tds_read_b64_tr_b16 v[246:247], %[a] offset:8832\n\tds_read_b64_tr_b16 v[248:249], %[a] offset:640\n\tds_read_b64_tr_b16 v[250:251], %[a] offset:9344\n\ts_waitcnt lgkmcnt(10)\n\tv_mfma_f32_32x32x16_bf16 %[o0], v[228:231], %[p0], %[o0]\n\tds_read_b64_tr_b16 v[228:229], %[a] offset:192\n\tds_read_b64_tr_b16 v[230:231], %[a] offset:8896\n\ts_waitcnt lgkmcnt(10)\n\tv_mfma_f32_32x32x16_bf16 %[o0], v[232:235], %[p1], %[o0]\n\tds_read_b64_tr_b16 v[232:233], %[a] offset:704\n\tds_read_b64_tr_b16 v[234:235], %[a] offset:9408\n\ts_waitcnt lgkmcnt(10)\n\tv_mfma_f32_32x32x16_bf16 %[o1], v[236:239], %[p0], %[o1]\n\tds_read_b64_tr_b16 v[236:237], %[a] offset:256\n\tds_read_b64_tr_b16 v[238:239], %[a] offset:8960\n\ts_waitcnt lgkmcnt(10)\n\tv_mfma_f32_32x32x16_bf16 %[o1], v[240:243], %[p1], %[o1]\n\tds_read_b64_tr_b16 v[240:241], %[a] offset:768\n\tds_read_b64_tr_b16 v[242:243], %[a] offset:9472\n\ts_waitcnt lgkmcnt(10)\n\tv_mfma_f32_32x32x16_bf16 %[o2], v[244:247], %[p0], %[o2]\n\tds_read_b64_tr_b16 v[244:245], %[a] offset:320\n\tds_read_b64_tr_b16 v[246:247], %[a] offset:9024\n\ts_waitcnt lgkmcnt(10)\n\tv_mfma_f32_32x32x16_bf16 %[o2], v[248:251], %[p1], %[o2]\n\tds_read_b64_tr_b16 v[248:249], %[a] offset:832\n\tds_read_b64_tr_b16 v[250:251], %[a] offset:9536\n\ts_waitcnt lgkmcnt(10)\n\tv_mfma_f32_32x32x16_bf16 %[o3], v[228:231], %[p0], %[o3]\n\tds_read_b64_tr_b16 v[228:229], %[a] offset:384\n\tds_read_b64_tr_b16 v[230:231], %[a] offset:9088\n\ts_waitcnt lgkmcnt(10)\n\tv_mfma_f32_32x32x16_bf16 %[o3], v[232:235], %[p1], %[o3]\n\tds_read_b64_tr_b16 v[232:233], %[a] offset:896\n\tds_read_b64_tr_b16 v[234:235], %[a] offset:9600\n\ts_waitcnt lgkmcnt(10)\n\tv_mfma_f32_32x32x16_bf16 %[o4], v[236:239], %[p0], %[o4]\n\tds_read_b64_tr_b16 v[236:237], %[a] offset:448\n\tds_read_b64_tr_b16 v[238:239], %[a] offset:9152\n\ts_waitcnt lgkmcnt(10)\n\tv_mfma_f32_32x32x16_bf16 %[o4], v[240:243], %[p1], %[o4]\n\tds_read_b64_tr_b16 v[240:241], %[a] offset:960\n\tds_read_b64_tr_b16 v[242:243], %[a] offset:9664\n\ts_waitcnt lgkmcnt(10)\n\tv_mfma_f32_32x32x16_bf16 %[o5], v[244:247], %[p0], %[o5]\n\ts_waitcnt lgkmcnt(8)\n\tv_mfma_f32_32x32x16_bf16 %[o5], v[248:251], %[p1], %[o5]\n\ts_waitcnt lgkmcnt(6)\n\tv_mfma_f32_32x32x16_bf16 %[o6], v[228:231], %[p0], %[o6]\n\ts_waitcnt lgkmcnt(4)\n\tv_mfma_f32_32x32x16_bf16 %[o6], v[232:235], %[p1], %[o6]\n\ts_waitcnt lgkmcnt(2)\n\tv_mfma_f32_32x32x16_bf16 %[o7], v[236:239], %[p0], %[o7]\n\ts_waitcnt lgkmcnt(0)\n\tv_mfma_f32_32x32x16_bf16 %[o7], v[240:243], %[p1], %[o7]\n\ts_nop 15"
                              : [o0] "+v"(o[0]), [o1] "+v"(o[1]), [o2] "+v"(o[2]), [o3] "+v"(o[3]), [o4] "+v"(o[4]), [o5] "+v"(o[5]), [o6] "+v"(o[6]), [o7] "+v"(o[7])
                              : [a] "v"(va_), [p0] "v"(pf0), [p1] "v"(pf1)
                              : "memory", "v228", "v229", "v230", "v231", "v232", "v233", "v234", "v235", "v236", "v237", "v238", "v239", "v240", "v241", "v242", "v243", "v244", "v245", "v246", "v247", "v248", "v249", "v250", "v251"); }
                    }
                }
            }
#undef ATP_ISSUE
#undef ATP_QF
            int lane2 = F.lane; asm volatile("" : "+v"(lane2));
            const int hh2 = lane2 >> 5;
            LAS float* LQ = (LAS float*)(L + LQ_OFF) + st * 32 + (lane2 & 31);
            if (producer) { const float lt = hsum(lsum); if (hh2 == 0) *LQ = lt; }
            VM_WAIT();
            __syncthreads();
            LAS float* X = (LAS float*)L + (rg * 128) * 64 + lane2;
            float inv = 0.f;
            if (!producer) { inv = 1.0f / *LQ;
                if (map == 1) { const float f = inv * lamv;
#pragma unroll
                    for (int eb = 0; eb < 8; ++eb)
#pragma unroll
                        for (int i = 0; i < 16; ++i) X[(eb * 16 + i) * 64] = o[eb][i] * f; } }
            __syncthreads();
            if (!producer && map == 0) {
                float ssq = 0.f;
#pragma unroll
                for (int eb = 0; eb < 8; ++eb)
#pragma unroll
                    for (int i = 0; i < 16; ++i) { const float d = o[eb][i] * inv - X[(eb * 16 + i) * 64]; o[eb][i] = d; ssq += d * d; }
                ssq = hsum(ssq);
                const float rs = 1.0f / sqrtf(ssq * (1.0f / 256.0f) + EPS);
                const unsigned ovoff = (unsigned)((32 * rg + (lane2 & 31)) * LDH + 4 * hh2) * 2u; const int osoff = ((rowbase + c * 64) * LDH + h * 256) * 2;
                const LAS float* sg = (const LAS float*)(L + SUBG_OFF) + 4 * hh2;
#pragma unroll
                for (int eb = 0; eb < 8; ++eb)
#pragma unroll
                    for (int g = 0; g < 4; ++g) { const f32x4 gg = *(const LAS f32x4*)(sg + 32 * eb + 8 * g);
                        v2u wv; wv.x = pk2(o[eb][4 * g + 0] * rs * gg.x, o[eb][4 * g + 1] * rs * gg.y); wv.y = pk2(o[eb][4 * g + 2] * rs * gg.z, o[eb][4 * g + 3] * rs * gg.w);
                        __builtin_amdgcn_raw_buffer_store_b64(wv, rs_ao, ovoff, osoff + (32 * eb + 8 * g) * 2, 0); }
            }
            __syncthreads();
        }
    }
}

namespace ret {
typedef short bf16x8 __attribute__((ext_vector_type(8)));
typedef short s16x4 __attribute__((ext_vector_type(4)));
typedef float f32x16 __attribute__((ext_vector_type(16)));
constexpr int TS = 1040, TILE = 32 * TS, VS = 1088, VTILE = 8 * VS, PS = 272, PTILE = 32 * PS, SG = 264, SPLANE = 64 * SG, STILE = 2 * SPLANE;
constexpr int QB_OFF = 0, KB_OFF = TILE, VB_OFF = 3 * TILE, ST_OFF = VB_OFF + 2 * VTILE, P_OFF = ST_OFF + STILE, END_OFF = P_OFF + PTILE;
static_assert(END_OFF <= MISC_OFF && ST_OFF % 16 == 0 && P_OFF % 16 == 0, "retention LDS map");
__device__ __forceinline__ s16x4 vtr(const LAS char* p) { return __builtin_bit_cast(s16x4, __builtin_amdgcn_ds_read_tr16_b64_v4i16((LAS s16x4*)p)); }
}
#define RET_BAR0() asm volatile("s_waitcnt vmcnt(0) lgkmcnt(0)\n\ts_barrier" ::: "memory")
#define RET_BAR1() asm volatile("s_waitcnt lgkmcnt(0)\n\ts_barrier" ::: "memory")
__device__ __forceinline__ void ret_phase(Frame& F, const bf16* proj, bf16* ro) {
    using namespace ret;
    __builtin_amdgcn_s_waitcnt(0x0F70);
    LAS char* L = (LAS char*)F.lds;
    const int lane = F.lane, r = lane & 31, hh = lane >> 5, w = F.wave;
    const int q4 = (lane & 15) >> 2, p4 = lane & 3, blk = (lane >> 4) & 1;
    const v4u sd_proj = make_srd(proj, (unsigned)(48 * PJT * 2));
    const v4u sd_ro = make_srd(ro, (unsigned)(16 * PJT * 2));
    const unsigned lo_qk = (unsigned)((lane >> 5) * 32 * 512 + (lane & 31) * 16);
    const unsigned lo_v = (unsigned)((lane >> 3) * 8 * 512 + (lane & 7) * 16);
    const int jb = w & 1, ib = (w >> 1) & 1, eb = w & 1;
    const int rb = r * TS + hh * 16;
    const int ktr_l = (8 * hh + q4) * TS + 32 * blk + 8 * p4 + 64 * w;
    const int vtr_l = q4 * VS + hh * 128 + 32 * blk + 8 * p4;
    const int str_l = ST_OFF + 2 * hh * SG + q4 * 64 + 32 * blk + 8 * p4;
    const int stw_l = ST_OFF + (8 * w + (r >> 2)) * SG + (r & 3) * 64 + 8 * hh;
    const int pw_l = P_OFF + r * PS + 8 * hh, pr_l = P_OFF + r * PS + 16 * hh;
    const int vsc_l = w * VS + lane * 16;
    for (int it = blockIdx.x; it < NB * 8 * 8; it += F.G) {
        const int sl = (it >> 3) & 7, bh_ = ((it & 7) << 2) | (it >> 6), h = bh_ & 7, b = bh_ >> 3;
        const int rowbase = b * SEQ;
        const float lg2 = log2f(1.0f - exp2f(-5.0f - (float)h));
        const float g64 = exp2f(lg2 * 64.0f);
        float Dk[16];
#pragma unroll
        for (int i = 0; i < 16; ++i) { const int jj = 32 * jb + (i & 3) + 8 * (i >> 2) + 4 * hh, dj = (32 * ib + r) - jj; Dk[i] = exp2f(lg2 * (float)((dj < 0 ? -dj : dj) + jj - 64)); }
        const float qdec = exp2f(lg2 * (float)(32 * ib + r));
        const float vdec = exp2f(lg2 * (float)(64 - (w + 8 * (lane >> 3))));
        f32x16 acc[2];
#pragma unroll
        for (int e2 = 0; e2 < 2; ++e2)
#pragma unroll
            for (int i = 0; i < 16; ++i) acc[e2][i] = 0.f;
        const int qtile_b = (int)(((size_t)h * PJT + (size_t)rowbase * 256) * 2), ktile_b = (int)(((size_t)(8 + h) * PJT + (size_t)rowbase * 256) * 2),
                  vtile_b = (int)(((size_t)(16 + 2 * h + (sl >> 2)) * PJT + (size_t)rowbase * 256 + (sl & 3) * 64) * 2);
        const unsigned ovoff = (unsigned)((32 * ib + r) * 256 + 4 * hh) * 2u;
#define RET_ISSUE_QK(tile_b, n, bufoff) do { _Pragma("unroll") for (int i_ = 0; i_ < 4; ++i_) { const int pc_ = 4 * w + i_; \
        dma16(sd_proj, lo_qk, (tile_b) + ((n) * 64 + pc_) * 512, (LAS void*)(L + (bufoff) + pc_ * TS)); } } while (0)
#define RET_ISSUE_V(n, bufoff) dma16(sd_proj, lo_v, vtile_b + ((n) * 64 + w) * 512, (LAS void*)(L + (bufoff) + w * VS))
#define RET_ST_WRITE() do { _Pragma("unroll") for (int e2_ = 0; e2_ < 2; ++e2_) _Pragma("unroll") for (int g_ = 0; g_ < 4; ++g_) { v2u sv_; \
            sv_.x = pk2(acc[e2_][4 * g_ + 0], acc[e2_][4 * g_ + 1]); sv_.y = pk2(acc[e2_][4 * g_ + 2], acc[e2_][4 * g_ + 3]); *(LAS v2u*)(L + stw_l + e2_ * SPLANE + 16 * g_) = sv_; } } while (0)
        RET_BAR0();
        RET_ISSUE_QK(qtile_b, 0, QB_OFF); RET_ISSUE_QK(ktile_b, 0, KB_OFF); RET_ISSUE_V(0, VB_OFF);
        v4u qr[4];
#define RET_QLOAD(n) do { const int n_ = (n) < 64 ? (n) : 63; _Pragma("unroll") for (int i_ = 0; i_ < 4; ++i_) qr[i_] = bload16(sd_proj, lo_qk, qtile_b + (n_ * 64 + 4 * w + i_) * 512); } while (0)
        RET_QLOAD(1);
        RET_ST_WRITE();
        for (int n = 0; n < 64; ++n) {
            if (w >= 4 && n > 0) asm volatile("s_waitcnt vmcnt(8) lgkmcnt(0)\n\ts_barrier" ::: "memory"); else asm volatile("s_waitcnt vmcnt(4) lgkmcnt(0)\n\ts_barrier" ::: "memory");
            const int kb_off = KB_OFF + (n & 1) * TILE, vb_off = VB_OFF + (n & 1) * VTILE;
            const int n1 = n + 1 < 64 ? n + 1 : 63;
#define RET_ISSUE_PIECE(j) do { if ((j) < 4) dma16(sd_proj, lo_qk, ktile_b + (n1 * 64 + 4 * w + (j)) * 512, (LAS void*)(L + KB_OFF + ((n + 1) & 1) * TILE + (4 * w + (j)) * TS)); \
                                else RET_ISSUE_V(n1, VB_OFF + ((n + 1) & 1) * VTILE); } while (0)
            {
                LAS v4u* vp = (LAS v4u*)(L + vb_off + vsc_l);
                const v4u vv = *vp;
                acc[0] = acc[0] * g64; acc[1] = acc[1] * g64;
                v4u vo; vo.x = pk2(bflo(vv.x) * vdec, bfhi(vv.x) * vdec); vo.y = pk2(bflo(vv.y) * vdec, bfhi(vv.y) * vdec); vo.z = pk2(bflo(vv.z) * vdec, bfhi(vv.z) * vdec); vo.w = pk2(bflo(vv.w) * vdec, bfhi(vv.w) * vdec);
                *vp = vo;
            }
            f32x16 t;
#pragma unroll
            for (int j = 0; j < 5; ++j) RET_ISSUE_PIECE(j);
            if (w < 4) {
                const unsigned ap_ = (unsigned)(uintptr_t)(L + kb_off + rb + jb * 512), bp_ = (unsigned)(uintptr_t)(L + QB_OFF + rb + ib * 512);
                asm volatile("s_nop 4\n\tds_read_b128 v[200:203], %[a] offset:0\n\tds_read_b128 v[204:207], %[b] offset:0\n\tds_read_b128 v[208:211], %[a] offset:32\n\tds_read_b128 v[212:215], %[b] offset:32\n\tds_read_b128 v[216:219], %[a] offset:64\n\tds_read_b128 v[220:223], %[b] offset:64\n\tds_read_b128 v[224:227], %[a] offset:96\n\tds_read_b128 v[228:231], %[b] offset:96\n\tds_read_b128 v[232:235], %[a] offset:128\n\tds_read_b128 v[236:239], %[b] offset:128\n\ts_waitcnt lgkmcnt(8)\n\tv_mfma_f32_32x32x16_bf16 %[t], v[200:203], v[204:207], 0\n\tds_read_b128 v[200:203], %[a] offset:160\n\tds_read_b128 v[204:207], %[b] offset:160\n\ts_waitcnt lgkmcnt(8)\n\tv_mfma_f32_32x32x16_bf16 %[t], v[208:211], v[212:215], %[t]\n\tds_read_b128 v[208:211], %[a] offset:192\n\tds_read_b128 v[212:215], %[b] offset:192\n\ts_waitcnt lgkmcnt(8)\n\tv_mfma_f32_32x32x16_bf16 %[t], v[216:219], v[220:223], %[t]\n\tds_read_b128 v[216:219], %[a] offset:224\n\tds_read_b128 v[220:223], %[b] offset:224\n\ts_waitcnt lgkmcnt(8)\n\tv_mfma_f32_32x32x16_bf16 %[t], v[224:227], v[228:231], %[t]\n\tds_read_b128 v[224:227], %[a] offset:256\n\tds_read_b128 v[228:231], %[b] offset:256\n\ts_waitcnt lgkmcnt(8)\n\tv_mfma_f32_32x32x16_bf16 %[t], v[232:235], v[236:239], %[t]\n\tds_read_b128 v[232:235], %[a] offset:288\n\tds_read_b128 v[236:239], %[b] offset:288\n\ts_waitcnt lgkmcnt(8)\n\tv_mfma_f32_32x32x16_bf16 %[t], v[200:203], v[204:207], %[t]\n\tds_read_b128 v[200:203], %[a] offset:320\n\tds_read_b128 v[204:207], %[b] offset:320\n\ts_waitcnt lgkmcnt(8)\n\tv_mfma_f32_32x32x16_bf16 %[t], v[208:211], v[212:215], %[t]\n\tds_read_b128 v[208:211], %[a] offset:352\n\tds_read_b128 v[212:215], %[b] offset:352\n\ts_waitcnt lgkmcnt(8)\n\tv_mfma_f32_32x32x16_bf16 %[t], v[216:219], v[220:223], %[t]\n\tds_read_b128 v[216:219], %[a] offset:384\n\tds_read_b128 v[220:223], %[b] offset:384\n\ts_waitcnt lgkmcnt(8)\n\tv_mfma_f32_32x32x16_bf16 %[t], v[224:227], v[228:231], %[t]\n\tds_read_b128 v[224:227], %[a] offset:416\n\tds_read_b128 v[228:231], %[b] offset:416\n\ts_waitcnt lgkmcnt(8)\n\tv_mfma_f32_32x32x16_bf16 %[t], v[232:235], v[236:239], %[t]\n\tds_read_b128 v[232:235], %[a] offset:448\n\tds_read_b128 v[236:239], %[b] offset:448\n\ts_waitcnt lgkmcnt(8)\n\tv_mfma_f32_32x32x16_bf16 %[t], v[200:203], v[204:207], %[t]\n\tds_read_b128 v[200:203], %[a] offset:480\n\tds_read_b128 v[204:207], %[b] offset:480\n\ts_waitcnt lgkmcnt(8)\n\tv_mfma_f32_32x32x16_bf16 %[t], v[208:211], v[212:215], %[t]\n\ts_waitcnt lgkmcnt(6)\n\tv_mfma_f32_32x32x16_bf16 %[t], v[216:219], v[220:223], %[t]\n\ts_waitcnt lgkmcnt(4)\n\tv_mfma_f32_32x32x16_bf16 %[t], v[224:227], v[228:231], %[t]\n\ts_waitcnt lgkmcnt(2)\n\tv_mfma_f32_32x32x16_bf16 %[t], v[232:235], v[236:239], %[t]\n\ts_waitcnt lgkmcnt(0)\n\tv_mfma_f32_32x32x16_bf16 %[t], v[200:203], v[204:207], %[t]\n\ts_nop 15" : [t] "=&v"(t) : [a] "v"(ap_), [b] "v"(bp_) : "memory", "v200", "v201", "v202", "v203", "v204", "v205", "v206", "v207", "v208", "v209", "v210", "v211", "v212", "v213", "v214", "v215", "v216", "v217", "v218", "v219", "v220", "v221", "v222", "v223", "v224", "v225", "v226", "v227", "v228", "v229", "v230", "v231", "v232", "v233", "v234", "v235", "v236", "v237", "v238", "v239");
#pragma unroll
                for (int g = 0; g < 4; ++g) { v2u wv; wv.x = pk2(t[4 * g + 0] * Dk[4 * g + 0], t[4 * g + 1] * Dk[4 * g + 1]); wv.y = pk2(t[4 * g + 2] * Dk[4 * g + 2], t[4 * g + 3] * Dk[4 * g + 3]);
                    *(LAS v2u*)(L + pw_l + ib * 128 + jb * 64 + 16 * g) = wv; }
            } else {
                const unsigned ap_ = (unsigned)(uintptr_t)(L + str_l + eb * SPLANE), bp_ = (unsigned)(uintptr_t)(L + QB_OFF + rb + ib * 512);
                asm volatile("s_nop 4\n\tds_read_b64_tr_b16 v[200:201], %[a] offset:0\n\tds_read_b64_tr_b16 v[202:203], %[a] offset:264\n\tds_read_b128 v[204:207], %[b] offset:0\n\tds_read_b64_tr_b16 v[208:209], %[a] offset:1056\n\tds_read_b64_tr_b16 v[210:211], %[a] offset:1320\n\tds_read_b128 v[212:215], %[b] offset:32\n\tds_read_b64_tr_b16 v[216:217], %[a] offset:2112\n\tds_read_b64_tr_b16 v[218:219], %[a] offset:2376\n\tds_read_b128 v[220:223], %[b] offset:64\n\tds_read_b64_tr_b16 v[224:225], %[a] offset:3168\n\tds_read_b64_tr_b16 v[226:227], %[a] offset:3432\n\tds_read_b128 v[228:231], %[b] offset:96\n\tds_read_b64_tr_b16 v[232:233], %[a] offset:4224\n\tds_read_b64_tr_b16 v[234:235], %[a] offset:4488\n\tds_read_b128 v[236:239], %[b] offset:128\n\ts_waitcnt lgkmcnt(12)\n\tv_mfma_f32_32x32x16_bf16 %[t], v[200:203], v[204:207], 0\n\tds_read_b64_tr_b16 v[200:201], %[a] offset:5280\n\tds_read_b64_tr_b16 v[202:203], %[a] offset:5544\n\tds_read_b128 v[204:207], %[b] offset:160\n\ts_waitcnt lgkmcnt(12)\n\tv_mfma_f32_32x32x16_bf16 %[t], v[208:211], v[212:215], %[t]\n\tds_read_b64_tr_b16 v[208:209], %[a] offset:6336\n\tds_read_b64_tr_b16 v[210:211], %[a] offset:6600\n\tds_read_b128 v[212:215], %[b] offset:192\n\ts_waitcnt lgkmcnt(12)\n\tv_mfma_f32_32x32x16_bf16 %[t], v[216:219], v[220:223], %[t]\n\tds_read_b64_tr_b16 v[216:217], %[a] offset:7392\n\tds_read_b64_tr_b16 v[218:219], %[a] offset:7656\n\tds_read_b128 v[220:223], %[b] offset:224\n\ts_waitcnt lgkmcnt(12)\n\tv_mfma_f32_32x32x16_bf16 %[t], v[224:227], v[228:231], %[t]\n\tds_read_b64_tr_b16 v[224:225], %[a] offset:8448\n\tds_read_b64_tr_b16 v[226:227], %[a] offset:8712\n\tds_read_b128 v[228:231], %[b] offset:256\n\ts_waitcnt lgkmcnt(12)\n\tv_mfma_f32_32x32x16_bf16 %[t], v[232:235], v[236:239], %[t]\n\tds_read_b64_tr_b16 v[232:233], %[a] offset:9504\n\tds_read_b64_tr_b16 v[234:235], %[a] offset:9768\n\tds_read_b128 v[236:239], %[b] offset:288\n\ts_waitcnt lgkmcnt(12)\n\tv_mfma_f32_32x32x16_bf16 %[t], v[200:203], v[204:207], %[t]\n\tds_read_b64_tr_b16 v[200:201], %[a] offset:10560\n\tds_read_b64_tr_b16 v[202:203], %[a] offset:10824\n\tds_read_b128 v[204:207], %[b] offset:320\n\ts_waitcnt lgkmcnt(12)\n\tv_mfma_f32_32x32x16_bf16 %[t], v[208:211], v[212:215], %[t]\n\tds_read_b64_tr_b16 v[208:209], %[a] offset:11616\n\tds_read_b64_tr_b16 v[210:211], %[a] offset:11880\n\tds_read_b128 v[212:215], %[b] offset:352\n\ts_waitcnt lgkmcnt(12)\n\tv_mfma_f32_32x32x16_bf16 %[t], v[216:219], v[220:223], %[t]\n\tds_read_b64_tr_b16 v[216:217], %[a] offset:12672\n\tds_read_b64_tr_b16 v[218:219], %[a] offset:12936\n\tds_read_b128 v[220:223], %[b] offset:384\n\ts_waitcnt lgkmcnt(12)\n\tv_mfma_f32_32x32x16_bf16 %[t], v[224:227], v[228:231], %[t]\n\tds_read_b64_tr_b16 v[224:225], %[a] offset:13728\n\tds_read_b64_tr_b16 v[226:227], %[a] offset:13992\n\tds_read_b128 v[228:231], %[b] offset:416\n\ts_waitcnt lgkmcnt(12)\n\tv_mfma_f32_32x32x16_bf16 %[t], v[232:235], v[236:239], %[t]\n\tds_read_b64_tr_b16 v[232:233], %[a] offset:14784\n\tds_read_b64_tr_b16 v[234:235], %[a] offset:15048\n\tds_read_b128 v[236:239], %[b] offset:448\n\ts_waitcnt lgkmcnt(12)\n\tv_mfma_f32_32x32x16_bf16 %[t], v[200:203], v[204:207], %[t]\n\tds_read_b64_tr_b16 v[200:201], %[a] offset:15840\n\tds_read_b64_tr_b16 v[202:203], %[a] offset:16104\n\tds_read_b128 v[204:207], %[b] offset:480\n\ts_waitcnt lgkmcnt(12)\n\tv_mfma_f32_32x32x16_bf16 %[t], v[208:211], v[212:215], %[t]\n\ts_waitcnt lgkmcnt(9)\n\tv_mfma_f32_32x32x16_bf16 %[t], v[216:219], v[220:223], %[t]\n\ts_waitcnt lgkmcnt(6)\n\tv_mfma_f32_32x32x16_bf16 %[t], v[224:227], v[228:231], %[t]\n\ts_waitcnt lgkmcnt(3)\n\tv_mfma_f32_32x32x16_bf16 %[t], v[232:235], v[236:239], %[t]\n\ts_waitcnt lgkmcnt(0)\n\tv_mfma_f32_32x32x16_bf16 %[t], v[200:203], v[204:207], %[t]\n\ts_nop 15" : [t] "=&v"(t) : [a] "v"(ap_), [b] "v"(bp_) : "memory", "v200", "v201", "v202", "v203", "v204", "v205", "v206", "v207", "v208", "v209", "v210", "v211", "v212", "v213", "v214", "v215", "v216", "v217", "v218", "v219", "v220", "v221", "v222", "v223", "v224", "v225", "v226", "v227", "v228", "v229", "v230", "v231", "v232", "v233", "v234", "v235", "v236", "v237", "v238", "v239");
                t = t * qdec;
            }
            RET_BAR1();
            asm volatile("s_waitcnt vmcnt(5)" : "+v"(qr[0]), "+v"(qr[1]), "+v"(qr[2]), "+v"(qr[3]) :: "memory");
#pragma unroll
            for (int i = 0; i < 4; ++i) *(LAS v4u*)(L + QB_OFF + (4 * w + i) * TS + lane * 16) = qr[i];
            const int n2 = n + 2 < 64 ? n + 2 : 63;
            if (w >= 4) {
                { const unsigned va_ = (unsigned)(uintptr_t)(L + vb_off + vtr_l + eb * 64), pa_ = (unsigned)(uintptr_t)(L + pr_l + ib * 128);
                  asm volatile("s_nop 4\n\tds_read_b64_tr_b16 v[200:201], %[v] offset:0\n\tds_read_b64_tr_b16 v[202:203], %[v] offset:4352\n\tds_read_b128 v[204:207], %[p] offset:0\n\tds_read_b64_tr_b16 v[208:209], %[v] offset:256\n\tds_read_b64_tr_b16 v[210:211], %[v] offset:4608\n\tds_read_b128 v[212:215], %[p] offset:32\n\tds_read_b64_tr_b16 v[216:217], %[v] offset:512\n\tds_read_b64_tr_b16 v[218:219], %[v] offset:4864\n\tds_read_b128 v[220:223], %[p] offset:64\n\tds_read_b64_tr_b16 v[224:225], %[v] offset:768\n\tds_read_b64_tr_b16 v[226:227], %[v] offset:5120\n\tds_read_b128 v[228:231], %[p] offset:96\n\ts_waitcnt lgkmcnt(9)\n\tv_mfma_f32_32x32x16_bf16 %[t], v[200:203], v[204:207], %[t]\n\ts_waitcnt lgkmcnt(6)\n\tv_mfma_f32_32x32x16_bf16 %[t], v[208:211], v[212:215], %[t]\n\ts_waitcnt lgkmcnt(3)\n\tv_mfma_f32_32x32x16_bf16 %[t], v[216:219], v[220:223], %[t]\n\ts_waitcnt lgkmcnt(0)\n\tv_mfma_f32_32x32x16_bf16 %[t], v[224:227], v[228:231], %[t]\n\ts_nop 15" : [t] "+v"(t) : [v] "v"(va_), [p] "v"(pa_) : "memory", "v200", "v201", "v202", "v203", "v204", "v205", "v206", "v207", "v208", "v209", "v210", "v211", "v212", "v213", "v214", "v215", "v216", "v217", "v218", "v219", "v220", "v221", "v222", "v223", "v224", "v225", "v226", "v227", "v228", "v229", "v230", "v231"); }
                const int osoff = (int)(((size_t)(2 * h + (sl >> 2)) * PJT + (size_t)(rowbase + 64 * n) * 256 + (sl & 3) * 64 + 32 * eb) * 2);
#pragma unroll
                for (int g = 0; g < 4; ++g) { v2u wv; wv.x = pk2(t[4 * g + 0], t[4 * g + 1]); wv.y = pk2(t[4 * g + 2], t[4 * g + 3]);
                    bstore8(sd_ro, wv, ovoff, osoff + 16 * g); }
            }
#pragma unroll
            for (int ks = 0; ks < 4; ++ks) qr[ks] = bload16(sd_proj, lo_qk, qtile_b + (n2 * 64 + 4 * w + ks) * 512);
            { const unsigned ka_ = (unsigned)(uintptr_t)(L + kb_off + ktr_l), va_ = (unsigned)(uintptr_t)(L + vb_off + vtr_l);
              asm volatile("s_nop 4\n\tds_read_b64_tr_b16 v[200:201], %[k] offset:0\n\tds_read_b64_tr_b16 v[202:203], %[k] offset:4160\n\tds_read_b64_tr_b16 v[204:205], %[v] offset:0\n\tds_read_b64_tr_b16 v[206:207], %[v] offset:4352\n\tds_read_b64_tr_b16 v[208:209], %[v] offset:64\n\tds_read_b64_tr_b16 v[210:211], %[v] offset:4416\n\tds_read_b64_tr_b16 v[212:213], %[k] offset:16640\n\tds_read_b64_tr_b16 v[214:215], %[k] offset:20800\n\tds_read_b64_tr_b16 v[216:217], %[v] offset:256\n\tds_read_b64_tr_b16 v[218:219], %[v] offset:4608\n\tds_read_b64_tr_b16 v[220:221], %[v] offset:320\n\tds_read_b64_tr_b16 v[222:223], %[v] offset:4672\n\ts_waitcnt lgkmcnt(6)\n\tv_mfma_f32_32x32x16_bf16 %[c0], v[204:207], v[200:203], %[c0]\n\tv_mfma_f32_32x32x16_bf16 %[c1], v[208:211], v[200:203], %[c1]\n\tds_read_b64_tr_b16 v[224:225], %[k] offset:512\n\tds_read_b64_tr_b16 v[226:227], %[k] offset:4672\n\tds_read_b64_tr_b16 v[228:229], %[v] offset:512\n\tds_read_b64_tr_b16 v[230:231], %[v] offset:4864\n\tds_read_b64_tr_b16 v[232:233], %[v] offset:576\n\tds_read_b64_tr_b16 v[234:235], %[v] offset:4928\n\ts_waitcnt lgkmcnt(6)\n\tv_mfma_f32_32x32x16_bf16 %[c0], v[216:219], v[212:215], %[c0]\n\tv_mfma_f32_32x32x16_bf16 %[c1], v[220:223], v[212:215], %[c1]\n\tds_read_b64_tr_b16 v[200:201], %[k] offset:17152\n\tds_read_b64_tr_b16 v[202:203], %[k] offset:21312\n\tds_read_b64_tr_b16 v[204:205], %[v] offset:768\n\tds_read_b64_tr_b16 v[206:207], %[v] offset:5120\n\tds_read_b64_tr_b16 v[208:209], %[v] offset:832\n\tds_read_b64_tr_b16 v[210:211], %[v] offset:5184\n\ts_waitcnt lgkmcnt(6)\n\tv_mfma_f32_32x32x16_bf16 %[c0], v[228:231], v[224:227], %[c0]\n\tv_mfma_f32_32x32x16_bf16 %[c1], v[232:235], v[224:227], %[c1]\n\ts_waitcnt lgkmcnt(0)\n\tv_mfma_f32_32x32x16_bf16 %[c0], v[204:207], v[200:203], %[c0]\n\tv_mfma_f32_32x32x16_bf16 %[c1], v[208:211], v[200:203], %[c1]\n\ts_nop 15" : [c0] "+v"(acc[0]), [c1] "+v"(acc[1]) : [k] "v"(ka_), [v] "v"(va_) : "memory", "v200", "v201", "v202", "v203", "v204", "v205", "v206", "v207", "v208", "v209", "v210", "v211", "v212", "v213", "v214", "v215", "v216", "v217", "v218", "v219", "v220", "v221", "v222", "v223", "v224", "v225", "v226", "v227", "v228", "v229", "v230", "v231", "v232", "v233", "v234", "v235"); }
            RET_ST_WRITE();
        }
#undef RET_ST_WRITE
#undef RET_ISSUE_V
#undef RET_ISSUE_QK
#undef RET_QLOAD
#undef RET_ISSUE_PIECE
    }
    RET_BAR0();
}

__device__ __forceinline__ void retfin_phase(Frame& F, const bf16* ro, const bf16* proj, const float* gn, bf16* rg) {
    const int gw = blockIdx.x * NWAVES + F.wave, NGW = F.G * NWAVES;
    const f32x4 g0 = *(const f32x4*)(gn + F.lane * 8), g1 = *(const f32x4*)(gn + F.lane * 8 + 4);
    for (int m = gw; m < M; m += NGW) {
        v4u ov[8], gv[8];
#pragma unroll
        for (int h = 0; h < 8; ++h) { ov[h] = *(const v4u*)(ro + (size_t)(2 * h + (F.lane >> 5)) * PJT + (size_t)m * 256 + (F.lane & 31) * 8); gv[h] = *(const v4u*)(proj + (size_t)(32 + 2 * h + (F.lane >> 5)) * PJT + (size_t)m * 256 + (F.lane & 31) * 8); }
#pragma unroll
        for (int h = 0; h < 8; ++h) {
            float x[8] = {bflo(ov[h].x), bfhi(ov[h].x), bflo(ov[h].y), bfhi(ov[h].y), bflo(ov[h].z), bfhi(ov[h].z), bflo(ov[h].w), bfhi(ov[h].w)};
            const float gt[8] = {bflo(gv[h].x), bfhi(gv[h].x), bflo(gv[h].y), bfhi(gv[h].y), bflo(gv[h].z), bfhi(gv[h].z), bflo(gv[h].w), bfhi(gv[h].w)};
            float s = 0.f;
#pragma unroll
            for (int k = 0; k < 8; ++k) s += x[k];
            const float mu = wave_sum(s) * (1.0f / 512.0f); float q = 0.f;
#pragma unroll
            for (int k = 0; k < 8; ++k) { x[k] -= mu; q += x[k] * x[k]; }
            const float rstd = 1.0f / sqrtf(wave_sum(q) * (1.0f / 512.0f) + EPS);
            v4u w; w.x = pk2(x[0] * rstd * g0.x * gt[0], x[1] * rstd * g0.y * gt[1]); w.y = pk2(x[2] * rstd * g0.z * gt[2], x[3] * rstd * g0.w * gt[3]);
            w.z = pk2(x[4] * rstd * g1.x * gt[4], x[5] * rstd * g1.y * gt[5]); w.w = pk2(x[6] * rstd * g1.z * gt[6], x[7] * rstd * g1.w * gt[7]);
            *(v4u*)(rg + (size_t)m * LDR + h * 512 + F.lane * 8) = w;
        }
    }
}

constexpr int NPH = 18;
struct Args { const float* in[15]; float* out; unsigned char* ws; int ph_lo, ph_hi; };
static_assert(sizeof(Args) == 17 * 8 + 8, "Args has no padding");
__global__ void __launch_bounds__(NWAVES * 64, 2) mk_fwd(Args args) {
    extern __shared__ __attribute__((aligned(16))) unsigned char lds[];
    Frame F;
    F.lds = (LAS unsigned char*)lds;
    F.MISC = (volatile LAS unsigned*)(F.lds + MISC_OFF);
    F.tid = threadIdx.x; F.lane = F.tid & 63; F.wave = __builtin_amdgcn_readfirstlane(F.tid >> 6);
    F.G = gridDim.x;
    unsigned char* ws = args.ws;
    F.ctl = (gu32*)(ws + WS_CTL);
    if (F.tid < 64) F.MISC[F.tid] = 0u;
    __syncthreads();
    XcdBarrier bar; bar.bar = (unsigned*)(F.ctl + CW_BAR); bar.x = 0; bar.st = nullptr;
    if (MK_ONE_LAUNCH) bar = xcd_barrier_post((unsigned*)(F.ctl + CW_BAR), F.MISC + 8);
    const int lo = args.ph_lo, hi = args.ph_hi;
#define IN(k) (lo <= (k) && (k) < hi)
#define SEAM(k) do { if (IN(k) && IN((k) + 1)) xcd_barrier(bar); } while (0)
    const float* x_in = args.in[0]; const float* c_in = args.in[1]; const float* ada_w = args.in[2]; const float* ada_b = args.in[3]; const float* norm_g = args.in[4];
    const float* da_lambda = args.in[8]; const float* da_subln = args.in[9]; const float* ret_gn = args.in[12]; const float* final_g = args.in[14];
    float* xres = args.out;
    unsigned short* XH = (unsigned short*)(ws + WS_XH);
    float* mod = (float*)(ws + WS_MOD);
    bf16* Hb = (bf16*)(ws + WS_H); bf16* BIG = (bf16*)(ws + WS_BIG); bf16* AO = (bf16*)(ws + WS_AO); bf16* RO = (bf16*)(ws + WS_RO);
    LAS unsigned char* glds = F.lds + RING_OFF;

    if (IN(0)) {
        mod_phase(F, c_in, ada_w, ada_b, mod);
        WPtrs P{args.in[5], args.in[6], args.in[7], args.in[10], args.in[11], args.in[13], ws};
        convert_phase(F, P);
    }
    SEAM(0);
    if (IN(1)) pre_phase(F, x_in, norm_g, mod, ws);
    SEAM(1);
    float* gsm = (float*)(ws + WS_GSM); float* biasv = (float*)(ws + WS_BIAS); float* ssq = (float*)(ws + WS_SSQ);
    float* PART = (float*)(ws + WS_AO - 2 * MiB);
#define GATE_OF(s) (mod + (size_t)((s) / 3) * NB * NMOD + (3 * ((s) % 3) + 2) * DM)
#define FFN_BLOCK(PH, f, s, XIN, NEXT, SN, FIRST) \
    if (IN(PH)) { if ((s) != 0) { ssq_reduce(F, PART, ssq + (size_t)(s) * M); xcd_barrier(bar); } pg8::Gemm g{Hb, (const bf16*)(ws + WS_WIN + (f) * WIN_BYTES), M, FF2, DM, LDH, LDH, 1}; pg8::StaticOrder S; S.init(M, FF2, F.G, (int)blockIdx.x); \
        pg8::EpiSwiglu E{BIG, LDF, ssq + (size_t)(s) * M, biasv + (size_t)(s) * NB * BIASP, BIASP}; pg8::gemm_phase<pg8::EpiSwiglu, pg8::StaticOrder, PG8_ALIGN, PG8_SP2>(glds, g, S, E); } \
    SEAM(PH); \
    if (IN((PH) + 1)) { pg8::Gemm g{BIG, (const bf16*)(ws + WS_WOUT + (f) * WOUT_BYTES), M, DM, FF, LDF, LDF, 1}; pg8::StaticOrder S; S.init(M, DM, F.G, (int)blockIdx.x); \
        pg8::EpiResid<NEXT, FIRST> E{(XIN), XH, GATE_OF(s), Hb, gsm + (size_t)(SN) * NB * DM, PART, NMOD, LDH, 0.5f, 0}; \
        pg8::gemm_phase<pg8::EpiResid<NEXT, FIRST>, pg8::StaticOrder, PG8_ALIGN, PG8_SP2>(glds, g, S, E); } \
    SEAM((PH) + 1);

    FFN_BLOCK(2, 0, 0, x_in, true, 1, true)
    if (IN(4)) { ssq_reduce(F, PART, ssq + (size_t)1 * M); xcd_barrier(bar); pg8::Gemm g{Hb, (const bf16*)(ws + WS_WQKV), M, NQKV, DM, LDH, LDH, 1}; pg8::StaticOrder S; S.init(M, NQKV, F.G, (int)blockIdx.x);
        pg8::EpiProj<0> E{BIG, LDQ, QSCALE, ssq + (size_t)1 * M, biasv + (size_t)1 * NB * BIASP, BIASP}; pg8::gemm_phase<pg8::EpiProj<0>, pg8::StaticOrder, PG8_ALIGN, PG8_SP2>(glds, g, S, E); }
    SEAM(4);
    if (IN(5)) { att_kmax_phase(F, BIG, (unsigned*)(ws + WS_KMAX)); xcd_barrier(bar); att_pc_phase(F, BIG, AO, da_lambda, da_subln, (const float*)(ws + WS_KMAX)); }
    SEAM(5);
    if (IN(6)) { pg8::Gemm g{AO, (const bf16*)(ws + WS_WODA), M, DM, DM, LDH, LDH, 0}; pg8::StaticOrder S; S.init(M, DM, F.G, (int)blockIdx.x);
        pg8::EpiResid<true, false> E{XH, XH, GATE_OF(1), Hb, gsm + (size_t)2 * NB * DM, PART, NMOD, LDH, 1.0f, 0};
        pg8::gemm_phase<pg8::EpiResid<true, false>, pg8::StaticOrder, PG8_ALIGN, PG8_SP2>(glds, g, S, E); }
    SEAM(6);
    FFN_BLOCK(7, 1, 2, XH, true, 3, false)
    FFN_BLOCK(9, 2, 3, XH, true, 4, false)
    if (IN(11)) { ssq_reduce(F, PART, ssq + (size_t)4 * M); xcd_barrier(bar); pg8::Gemm g{Hb, (const bf16*)(ws + WS_WQKVG), M, NPROJ, DM, LDH, LDH, 1}; pg8::StaticOrder S; S.init(M, NPROJ, F.G, (int)blockIdx.x);
        pg8::EpiProj<1> E{BIG, LDP, 1.0f, ssq + (size_t)4 * M, biasv + (size_t)4 * NB * BIASP, BIASP}; pg8::gemm_phase<pg8::EpiProj<1>, pg8::StaticOrder, PG8_ALIGN, PG8_SP2>(glds, g, S, E); }
    SEAM(11);
    if (IN(12)) ret_phase(F, BIG, RO);
    SEAM(12);
    if (IN(13)) retfin_phase(F, RO, BIG, ret_gn, AO);
    SEAM(13);
    if (IN(14)) { pg8::Gemm g{AO, (const bf16*)(ws + WS_WORET), M, DM, RVW, LDR, LDR, 0}; pg8::StaticOrder S; S.init(M, DM, F.G, (int)blockIdx.x);
        pg8::EpiResid<true, false> E{XH, XH, GATE_OF(4), Hb, gsm + (size_t)5 * NB * DM, PART, NMOD, LDH, 1.0f, 0};
        pg8::gemm_phase<pg8::EpiResid<true, false>, pg8::StaticOrder, PG8_ALIGN, PG8_SP2>(glds, g, S, E); }
    SEAM(14);
    FFN_BLOCK(15, 3, 5, XH, false, 0, false)
    if (IN(17)) final_phase(F, XH, xres, final_g);
#undef IN
#undef SEAM
#undef GATE_OF
#undef FFN_BLOCK
}

extern "C" void kernel_launch(void* const* d_in, const int* in_sizes, int n_in, void* d_out, int out_size, void* d_ws, size_t ws_size, hipStream_t stream) {
    static int grid = 0;
    if (grid == 0) {
        if (n_in != 15 || in_sizes[0] != M * DM || out_size != M * DM || ws_size < WS_END) { fprintf(stderr, "kernel_launch: unexpected shapes: n_in %d in0 %d out %d ws %zu (need %zu)\n", n_in, n_in > 0 ? in_sizes[0] : -1, out_size, ws_size, (size_t)WS_END); grid = -1; return; }
        int dev = 0, cus = 0, per_cu = 0;
        if (hipGetDevice(&dev) != hipSuccess || hipDeviceGetAttribute(&cus, hipDeviceAttributeMultiprocessorCount, dev) != hipSuccess) { fprintf(stderr, "kernel_launch: device query failed\n"); grid = -1; return; }
        if (hipFuncSetAttribute((const void*)mk_fwd, hipFuncAttributeMaxDynamicSharedMemorySize, LDS_BYTES) != hipSuccess) { fprintf(stderr, "kernel_launch: hipFuncSetAttribute failed\n"); grid = -1; return; }
        if (hipOccupancyMaxActiveBlocksPerMultiprocessor(&per_cu, (const void*)mk_fwd, NWAVES * 64, LDS_BYTES) != hipSuccess || per_cu < 1) fprintf(stderr, "kernel_launch: note: occupancy query reports %d workgroups per CU\n", per_cu);
        (void)hipGetLastError();
        grid = cus;
    }
    if (grid < 0) return;
    if (hipMemsetAsync((char*)d_ws + WS_CTL, 0, CTL_ZERO_BYTES, stream) != hipSuccess) { fprintf(stderr, "kernel_launch: memset failed\n"); return; }
    Args a{};
    for (int i = 0; i < 15; ++i) a.in[i] = (const float*)d_in[i];
    a.out = (float*)d_out; a.ws = (unsigned char*)d_ws;
#if MK_ONE_LAUNCH
    a.ph_lo = 0; a.ph_hi = NPH;
    hipLaunchKernelGGL(mk_fwd, dim3(grid), dim3(NWAVES * 64), LDS_BYTES, stream, a);
#else
    for (int p = 0; p < NPH; ++p) { a.ph_lo = p; a.ph_hi = p + 1; hipLaunchKernelGGL(mk_fwd, dim3(grid), dim3(NWAVES * 64), LDS_BYTES, stream, a); }
#endif
    const hipError_t le = hipPeekAtLastError();
    if (le != hipSuccess) fprintf(stderr, "kernel_launch: launch failed: %s\n", hipGetErrorName(le));
}
```

```cpp
#include <hip/hip_runtime.h>
#include <cstdio>
#include <cstdint>
#include <cmath>
namespace pg8 {
#define PG8_LAS __attribute__((address_space(3)))
typedef unsigned short bf16_t;
typedef short bf16x8 __attribute__((ext_vector_type(8)));
typedef float f32x4 __attribute__((ext_vector_type(4)));
typedef unsigned u32x4 __attribute__((ext_vector_type(4)));
constexpr int XS_PANEL = 32 * 16384 + 2048;
constexpr int BM = 256, BK = 64, HALF = 128, HTB = HALF * BK * 2  , STAGE_BYTES = 8 * HTB, NXCD = 8, WGM = 4;

__host__ __device__ __forceinline__ int lds_byte(int r, int c) { const int st = (r >> 4) * 2 + (c >> 5), rr = r & 15, cc = c & 31, ob = rr * 64 + cc * 2; return st * 1024 + (ob ^ (((ob >> 9) & 1) << 5)); }
__host__ __device__ __forceinline__ void stage_rc(int b, int& R, int& C) { const int st = b / 1024, sb = b % 1024, swz = sb ^ (((sb >> 9) & 1) << 5); R = (st >> 1) * 16 + swz / 64; C = (st & 1) * 32 + (swz % 64) / 2; }
__host__ __device__ __forceinline__ int perm32(int rho) { const int n = rho >> 4, i = rho & 15; return 8 * (i >> 2) + 4 * n + (i & 3); }

struct Unit { int pm, pn; };
struct Gemm { const bf16_t* A; const bf16_t* Bt; int M, N, K, lda, ldb, atiled; };

struct StaticOrder {
    int nM, nN, nwg, G, c;
    __host__ __device__ void init(int M, int N, int G_, int c_) { nM = M / BM; nN = N / BM; nwg = nM * nN; G = G_; c = c_; }
    __host__ __device__ bool next(int i, Unit& u) const {
        const long L = (long)i * G + c; if (L >= nwg) return false;
        int wgid = (int)L; { const int q = nwg / NXCD, r = nwg % NXCD, xcd = wgid % NXCD, off = wgid / NXCD; wgid = (xcd < r ? xcd * (q + 1) : r * (q + 1) + (xcd - r) * q) + off; }
        const int nig = WGM * nN, gid = wgid / nig, fm = gid * WGM, gsz = (nM - fm) < WGM ? (nM - fm) : WGM;
        u.pm = fm + ((wgid % nig) % gsz); u.pn = (wgid % nig) / gsz; return true;
    }
    __device__ __forceinline__ void a_ready(const Unit&) const {}
    __device__ __forceinline__ void done(const Unit&) const {}
};


typedef float f32x2 __attribute__((ext_vector_type(2)));
typedef __bf16 bf16x2_t __attribute__((ext_vector_type(2)));
__device__ __forceinline__ unsigned cvt_pk_bf16(float lo, float hi) { f32x2 v = {lo, hi}; bf16x2_t b = __builtin_convertvector(v, bf16x2_t); return __builtin_bit_cast(unsigned, b); }
__device__ __forceinline__ float silu_f(float a) { return a * __builtin_amdgcn_rcpf(1.0f + __builtin_amdgcn_exp2f(a * -1.4426950408889634f)); }

__device__ __forceinline__ float rstd_of(const float* ssq, int row) { return 1.0f / sqrtf(ssq[row] * (1.0f / 2048.0f) + 1e-5f); }
constexpr int FFH = 5632;
struct EpiSwiglu {
    static constexpr bool PERM = true, AFTER_DRAIN = false;
    bf16_t* O; int ldc; const float* ssq; const float* bias; int bpitch;
    __device__ __forceinline__ void operator()(const f32x4 (&acc)[2][2][4][2], const Unit& u, int wr, int wc, int fr, int fq) const {
        const int row0 = u.pm * BM + wr * 64 + fr, col0 = u.pn * HALF + wc * 32 + 8 * fq;
        const float* bb = bias + (size_t)(u.pm >> 4) * bpitch + u.pn * BM + wc * 32 + 8 * fq;
        const f32x4 bg0 = *(const f32x4*)bb, bg1 = *(const f32x4*)(bb + 4), bu0 = *(const f32x4*)(bb + HALF), bu1 = *(const f32x4*)(bb + HALF + 4);
        float rsv[8];
#pragma unroll
        for (int i = 0; i < 8; ++i) rsv[i] = ssq[row0 + (i >> 2) * HALF + (i & 3) * 16];
#pragma unroll
        for (int i = 0; i < 8; ++i) rsv[i] = 1.0f / sqrtf(rsv[i] * (1.0f / 2048.0f) + 1e-5f);
#pragma unroll
        for (int ai = 0; ai < 2; ++ai)
#pragma unroll
            for (int m = 0; m < 4; ++m) { const int row = row0 + ai * HALF + m * 16; const float rs = rsv[ai * 4 + m];
                bf16_t* rowp = O + (size_t)u.pm * ((size_t)(FFH / 64) * 16384 + 2048) + (size_t)(col0 >> 6) * 16384 + (size_t)(row & 255) * 64 + (col0 & 63);
                const f32x4 g0 = acc[ai][0][m][0] * rs + bg0, g1 = acc[ai][0][m][1] * rs + bg1, u0 = acc[ai][1][m][0] * rs + bu0, u1 = acc[ai][1][m][1] * rs + bu1;
                u32x4 w;
                w.x = cvt_pk_bf16(silu_f(g0[0]) * u0[0], silu_f(g0[1]) * u0[1]); w.y = cvt_pk_bf16(silu_f(g0[2]) * u0[2], silu_f(g0[3]) * u0[3]);
                w.z = cvt_pk_bf16(silu_f(g1[0]) * u1[0], silu_f(g1[1]) * u1[1]); w.w = cvt_pk_bf16(silu_f(g1[2]) * u1[2], silu_f(g1[3]) * u1[3]);
                *(u32x4*)rowp = w; }
    }
};
typedef _Float16 h16x2 __attribute__((ext_vector_type(2)));
__device__ __forceinline__ unsigned cvt_pk_f16(float lo, float hi) { f32x2 v = {lo, hi}; h16x2 h = __builtin_convertvector(v, h16x2); return __builtin_bit_cast(unsigned, h); }
__device__ __forceinline__ f32x2 unpk_f16(unsigned u) { return __builtin_convertvector(__builtin_bit_cast(h16x2, u), f32x2); }
template <bool NEXT, bool FIRST> struct EpiResid {
    static constexpr bool PERM = true, AFTER_DRAIN = false;
    const void* xin; unsigned short* xout; const float* gate; bf16_t* xs; const float* gsm; float* ssq; int gpitch, ldxs; float gs; int pad_;
    __device__ __forceinline__ void operator()(const f32x4 (&acc)[2][2][4][2], const Unit& u, int wr, int wc, int fr, int fq) const {
        const int row0 = u.pm * BM + wr * 64 + fr, col0 = u.pn * BM + wc * 32 + 8 * fq, b = u.pm >> 4;
        const float* gb = gate + (size_t)b * gpitch + col0;
        f32x4 gv[2][2], sm[2][2];
#pragma unroll
        for (int bj = 0; bj < 2; ++bj)
#pragma unroll
            for (int n = 0; n < 2; ++n) { gv[bj][n] = *(const f32x4*)(gb + bj * HALF + 4 * n) * gs; if (NEXT) sm[bj][n] = *(const f32x4*)(gsm + (size_t)b * 2048 + col0 + bj * HALF + 4 * n); }
        const size_t tile = ((size_t)u.pm * 8 + u.pn) * 65536 + (size_t)(wr * 64 + fr) * 256 + wc * 32 + 8 * fq;
        const unsigned short* hin = (const unsigned short*)xin + tile; unsigned short* hout = xout + tile;
        const float* fin = (const float*)xin + (size_t)row0 * 2048 + col0;
        bf16_t* xst = xs + (size_t)u.pm * XS_PANEL + (size_t)(4 * u.pn + (wc >> 1)) * 16384 + (size_t)(wr * 64 + fr) * 64 + (wc & 1) * 32 + 8 * fq;
        float sq[8];
        if (!FIRST) {
#pragma unroll
            for (int hb = 0; hb < 2; ++hb) {
                u32x4 hx[4][2];
#pragma unroll
                for (int k = 0; k < 4; ++k) { const int rg_ = hb * HALF + k * 16; hx[k][0] = *(const u32x4*)(hin + rg_ * 256); hx[k][1] = *(const u32x4*)(hin + rg_ * 256 + HALF); }
#pragma unroll
                for (int k = 0; k < 4; ++k) { const int it = hb * 4 + k, ai = hb, m = k, rg = ai * HALF + m * 16, row = row0 + rg; float s2 = 0.f;
#pragma unroll
                    for (int bj = 0; bj < 2; ++bj) { const u32x4 h_ = hx[k][bj]; const f32x2 a_ = unpk_f16(h_.x), b_ = unpk_f16(h_.y), c_ = unpk_f16(h_.z), d_ = unpk_f16(h_.w);
                        const f32x4 x0 = (f32x4){a_.x, a_.y, b_.x, b_.y} + gv[bj][0] * acc[ai][bj][m][0], x1 = (f32x4){c_.x, c_.y, d_.x, d_.y} + gv[bj][1] * acc[ai][bj][m][1];
                        u32x4 hw; hw.x = cvt_pk_f16(x0[0], x0[1]); hw.y = cvt_pk_f16(x0[2], x0[3]); hw.z = cvt_pk_f16(x1[0], x1[1]); hw.w = cvt_pk_f16(x1[2], x1[3]);
                        *(u32x4*)(hout + rg * 256 + bj * HALF) = hw;
                        if (NEXT) { s2 += (x0[0] * x0[0] + x0[1] * x0[1]) + (x0[2] * x0[2] + x0[3] * x0[3]) + (x1[0] * x1[0] + x1[1] * x1[1]) + (x1[2] * x1[2] + x1[3] * x1[3]);
                            const f32x4 y0 = x0 * sm[bj][0], y1 = x1 * sm[bj][1]; u32x4 w; w.x = cvt_pk_bf16(y0[0], y0[1]); w.y = cvt_pk_bf16(y0[2], y0[3]); w.z = cvt_pk_bf16(y1[0], y1[1]); w.w = cvt_pk_bf16(y1[2], y1[3]);
                            *(u32x4*)(xst + (size_t)(bj * 2) * 16384 + rg * 64) = w; } }
                    sq[it] = s2; }
            }
        } else {
            f32x4 xv[2][2][2];
#define ER_LOAD(it, buf) do { const int rg_ = ((it) >> 2) * HALF + ((it) & 3) * 16; const float* p_ = fin + (size_t)rg_ * 2048; \
                xv[buf][0][0] = *(const f32x4*)p_; xv[buf][0][1] = *(const f32x4*)(p_ + 4); xv[buf][1][0] = *(const f32x4*)(p_ + HALF); xv[buf][1][1] = *(const f32x4*)(p_ + HALF + 4); } while (0)
            ER_LOAD(0, 0);
#pragma unroll
            for (int it = 0; it < 8; ++it) { const int ai = it >> 2, m = it & 3, rg = ai * HALF + m * 16, row = row0 + rg; float s2 = 0.f;
                if (it + 1 < 8) ER_LOAD(it + 1, (it + 1) & 1);
#pragma unroll
                for (int bj = 0; bj < 2; ++bj) { const f32x4 x0 = xv[it & 1][bj][0] + gv[bj][0] * acc[ai][bj][m][0], x1 = xv[it & 1][bj][1] + gv[bj][1] * acc[ai][bj][m][1];
                    u32x4 hw; hw.x = cvt_pk_f16(x0[0], x0[1]); hw.y = cvt_pk_f16(x0[2], x0[3]); hw.z = cvt_pk_f16(x1[0], x1[1]); hw.w = cvt_pk_f16(x1[2], x1[3]);
                    *(u32x4*)(hout + rg * 256 + bj * HALF) = hw;
                    if (NEXT) { s2 += (x0[0] * x0[0] + x0[1] * x0[1]) + (x0[2] * x0[2] + x0[3] * x0[3]) + (x1[0] * x1[0] + x1[1] * x1[1]) + (x1[2] * x1[2] + x1[3] * x1[3]);
                        const f32x4 y0 = x0 * sm[bj][0], y1 = x1 * sm[bj][1]; u32x4 w; w.x = cvt_pk_bf16(y0[0], y0[1]); w.y = cvt_pk_bf16(y0[2], y0[3]); w.z = cvt_pk_bf16(y1[0], y1[1]); w.w = cvt_pk_bf16(y1[2], y1[3]);
                        *(u32x4*)(xst + (size_t)(bj * 2) * 16384 + rg * 64) = w; } }
                sq[it] = s2; }
#undef ER_LOAD
        }
        if (NEXT) {
#pragma unroll
            for (int it = 0; it < 8; ++it) { float s2 = sq[it]; s2 += __shfl_xor(s2, 16); s2 += __shfl_xor(s2, 32); if (fq == 0) ssq[(size_t)(u.pn * 4 + wc) * 16384 + row0 + (it >> 2) * HALF + (it & 3) * 16] = s2; }
        }
    }
};
template <int MODE> struct EpiProj {
    static constexpr bool PERM = true, AFTER_DRAIN = false;
    bf16_t* O; int ldc; float qscale; const float* ssq; const float* bias; int bpitch;
    __device__ __forceinline__ void operator()(const f32x4 (&acc)[2][2][4][2], const Unit& u, int wr, int wc, int fr, int fq) const {
        const int row0 = u.pm * BM + wr * 64 + fr, colt = u.pn * BM, col0 = colt + wc * 32 + 8 * fq;
        float sc = 1.f; bool act = false;
        if (MODE == 0) { if (colt < 2048) sc = qscale; }
        else { if (colt >= 2048 && colt < 4096) sc = 0.0625f; act = colt >= 8192; }
        const float* bb = bias + (size_t)(u.pm >> 4) * bpitch + col0;
        f32x4 bv[2][2];
#pragma unroll
        for (int bj = 0; bj < 2; ++bj)
#pragma unroll
            for (int n = 0; n < 2; ++n) bv[bj][n] = *(const f32x4*)(bb + bj * HALF + 4 * n);
        float rsv[8];
#pragma unroll
        for (int i = 0; i < 8; ++i) rsv[i] = ssq[row0 + (i >> 2) * HALF + (i & 3) * 16];
#pragma unroll
        for (int i = 0; i < 8; ++i) rsv[i] = 1.0f / sqrtf(rsv[i] * (1.0f / 2048.0f) + 1e-5f);
#pragma unroll
        for (int ai = 0; ai < 2; ++ai)
#pragma unroll
            for (int m = 0; m < 4; ++m) { const int row = row0 + ai * HALF + m * 16; bf16_t* rowp = O + (size_t)u.pn * ((size_t)16384 * 256) + (size_t)row * 256 + (col0 - colt); const float rs = rsv[ai * 4 + m];
#pragma unroll
                for (int bj = 0; bj < 2; ++bj) { f32x4 v0 = (acc[ai][bj][m][0] * rs + bv[bj][0]) * sc, v1 = (acc[ai][bj][m][1] * rs + bv[bj][1]) * sc;
                    if (MODE == 1 && act) {
#pragma unroll
                        for (int j = 0; j < 4; ++j) { v0[j] = silu_f(v0[j]); v1[j] = silu_f(v1[j]); } }
                    u32x4 w; w.x = cvt_pk_bf16(v0[0], v0[1]); w.y = cvt_pk_bf16(v0[2], v0[3]); w.z = cvt_pk_bf16(v1[0], v1[1]); w.w = cvt_pk_bf16(v1[2], v1[3]);
                    *(u32x4*)(rowp + bj * HALF) = w; } }
    }
};

template <class Epi, class Sched, bool ALIGN_EPI = false, bool SP2 = false>
__device__ __forceinline__ void gemm_phase(PG8_LAS unsigned char* lds, const Gemm g, const Sched& S, const Epi& E) {
    const int tid = threadIdx.x, wid = __builtin_amdgcn_readfirstlane(tid >> 6), lane = tid & 63, wr = wid >> 2, wc = wid & 3, fr = lane & 15, fq = lane >> 4;
    const int K = g.K, nt = K / BK;
    unsigned voffA[2], voffB[2];
#pragma unroll
    for (int i = 0; i < 2; ++i) { int R, C; stage_rc(tid * 16 + i * 8192, R, C); const int Rb = Epi::PERM ? ((R & ~31) + perm32(R & 31)) : R;
        voffA[i] = (unsigned)(R * (g.atiled ? 64 : g.lda) + C) * 2u; voffB[i] = (unsigned)(Rb * 64 + C) * 2u; }
    const size_t kstepB = (size_t)(BM * BK * 2), kstepA = g.atiled ? (size_t)(BM * BK * 2) : (size_t)(BK * 2);
    const size_t hstepA = g.atiled ? (size_t)(HALF * BK * 2) : (size_t)HALF * g.lda * 2, hstepB = (size_t)(HALF * BK * 2);
    const size_t tstepA = g.atiled ? ((size_t)(K / BK) * (BM * BK) + 2048) * 2 : 2 * hstepA, tstepB = ((size_t)(K / BK) * (BM * BK) + 2048) * 2;
    const unsigned ldsw = (unsigned)wid * 1024u;
    const int aoff = lds_byte(wr * 64 + fr, fq * 8), boff = lds_byte(wc * 32 + fr, fq * 8);
#define PG8_SA(b, h) (((b) * 2 + (h)) * HTB)
#define PG8_SB(b, h) ((4 + (b) * 2 + (h)) * HTB)
#define PG8_STAGE(bufoff, gbase, voff) do { _Pragma("unroll") for (int _i = 0; _i < 2; ++_i) \
        __builtin_amdgcn_global_load_lds((const unsigned*)((const char*)(gbase) + (voff)[_i]), (PG8_LAS unsigned*)(lds + (bufoff) + ldsw + _i * 8192), 16, 0, 0); } while (0)
#define PG8_LDA(dst, b, h) do { _Pragma("unroll") for (int m = 0; m < 4; ++m) _Pragma("unroll") for (int k = 0; k < 2; ++k) dst[m][k] = *(const PG8_LAS bf16x8*)(lds + PG8_SA(b, h) + aoff + m * 2048 + k * 1024); } while (0)
#define PG8_LDB(dst, b, h) do { _Pragma("unroll") for (int n = 0; n < 2; ++n) _Pragma("unroll") for (int k = 0; k < 2; ++k) dst[n][k] = *(const PG8_LAS bf16x8*)(lds + PG8_SB(b, h) + boff + n * 2048 + k * 1024); } while (0)
#define PG8_MMA(ai, bj, At, Bt) do { __builtin_amdgcn_s_setprio(1); _Pragma("unroll") for (int m = 0; m < 4; ++m) _Pragma("unroll") for (int n = 0; n < 2; ++n) _Pragma("unroll") for (int k = 0; k < 2; ++k) \
        acc[ai][bj][m][n] = __builtin_amdgcn_mfma_f32_16x16x32_bf16(Bt[n][k], At[m][k], acc[ai][bj][m][n], 0, 0, 0); __builtin_amdgcn_s_setprio(0); } while (0)
#define PG8_WAIT_V(n) asm volatile("s_waitcnt vmcnt(" #n ")" ::: "memory")
#define PG8_WAIT_L(n) asm volatile("s_waitcnt lgkmcnt(" #n ")" ::: "memory")
#define PG8_BAR __builtin_amdgcn_s_barrier()
#define PG8_SCHED __builtin_amdgcn_sched_barrier(0)
    Unit cur, nxt; int ui = 0;
    if (!S.next(0, cur)) return;
    f32x4 acc[2][2][4][2];
#pragma unroll
    for (int a = 0; a < 2; ++a)
#pragma unroll
        for (int b = 0; b < 2; ++b)
#pragma unroll
            for (int m = 0; m < 4; ++m)
#pragma unroll
                for (int n = 0; n < 2; ++n) acc[a][b][m][n] = (f32x4){0.f, 0.f, 0.f, 0.f};
    bf16x8 At[4][2], B0[2][2], B1[2][2];
    const char* cA = (const char*)g.A + (size_t)cur.pm * tstepA; const char* cB = (const char*)g.Bt + (size_t)cur.pn * tstepB;
    S.a_ready(cur);
    if constexpr (SP2) {
        PG8_STAGE(PG8_SB(0, 0), cB, voffB); PG8_STAGE(PG8_SB(0, 1), cB + hstepB, voffB); PG8_STAGE(PG8_SA(0, 0), cA, voffA); PG8_STAGE(PG8_SA(0, 1), cA + hstepA, voffA);
        if (wr == 1) PG8_BAR;
        PG8_WAIT_V(2); PG8_BAR;
        PG8_STAGE(PG8_SB(1, 0), cB + kstepB, voffB); PG8_STAGE(PG8_SA(1, 0), cA + kstepA, voffA); PG8_STAGE(PG8_SB(1, 1), cB + hstepB + kstepB, voffB);
        PG8_WAIT_V(6); PG8_BAR;
    } else {
        PG8_STAGE(PG8_SB(0, 0), cB, voffB); PG8_STAGE(PG8_SA(0, 0), cA, voffA); PG8_STAGE(PG8_SB(0, 1), cB + hstepB, voffB); PG8_STAGE(PG8_SA(0, 1), cA + hstepA, voffA);
        if (wr == 1) PG8_BAR;
        PG8_WAIT_V(4); PG8_BAR;
        PG8_STAGE(PG8_SB(1, 0), cB + kstepB, voffB); PG8_STAGE(PG8_SA(1, 0), cA + kstepA, voffA); PG8_STAGE(PG8_SB(1, 1), cB + hstepB + kstepB, voffB);
        PG8_WAIT_V(6); PG8_BAR;
    }
    for (;;) {
        const bool has_next = S.next(ui + 1, nxt);
        const char* nA = has_next ? (const char*)g.A + (size_t)nxt.pm * tstepA : cA; const char* nB = has_next ? (const char*)g.Bt + (size_t)nxt.pn * tstepB : cB;
        for (int t = 0; t < nt; t += 2) {
            const bool last = (t == nt - 2);
            const char* a1 = cA + (size_t)(t + 1) * kstepA;
            const char* a2 = last ? nA : cA + (size_t)(t + 2) * kstepA; const char* b2 = last ? nB : cB + (size_t)(t + 2) * kstepB;
            const char* a3 = a2 + kstepA; const char* b3 = b2 + kstepB;
            if (last && has_next) S.a_ready(nxt);
            if constexpr (SP2) {
            PG8_LDB(B0, 0, 0); PG8_LDB(B1, 0, 1); PG8_SCHED; PG8_LDA(At, 0, 0); PG8_STAGE(PG8_SA(1, 1), a1 + hstepA, voffA);
            PG8_WAIT_V(8); PG8_WAIT_L(0); PG8_BAR; PG8_MMA(0, 0, At, B0); PG8_MMA(0, 1, At, B1); PG8_BAR; PG8_SCHED;
            PG8_LDA(At, 0, 1); PG8_STAGE(PG8_SB(0, 0), b2, voffB); PG8_STAGE(PG8_SB(0, 1), b2 + hstepB, voffB); PG8_STAGE(PG8_SA(0, 0), a2, voffA);
            PG8_WAIT_V(8); PG8_WAIT_L(0); PG8_BAR; PG8_MMA(1, 0, At, B0); PG8_MMA(1, 1, At, B1); PG8_BAR; PG8_SCHED;
            PG8_LDB(B0, 1, 0); PG8_LDB(B1, 1, 1); PG8_SCHED; PG8_LDA(At, 1, 0); PG8_STAGE(PG8_SA(0, 1), a2 + hstepA, voffA);
            PG8_WAIT_V(8); PG8_WAIT_L(0); PG8_BAR; PG8_MMA(0, 0, At, B0); PG8_MMA(0, 1, At, B1); PG8_BAR; PG8_SCHED;
            PG8_LDA(At, 1, 1); PG8_STAGE(PG8_SB(1, 0), b3, voffB); PG8_STAGE(PG8_SB(1, 1), b3 + hstepB, voffB); PG8_STAGE(PG8_SA(1, 0), a3, voffA);
            PG8_WAIT_V(8); PG8_WAIT_L(0); PG8_BAR; PG8_MMA(1, 0, At, B0); PG8_MMA(1, 1, At, B1); PG8_BAR; PG8_SCHED;
            } else {
            PG8_LDB(B0, 0, 0); PG8_SCHED; PG8_LDA(At, 0, 0); PG8_STAGE(PG8_SA(1, 1), a1 + hstepA, voffA);
            PG8_WAIT_L(8); PG8_BAR; PG8_WAIT_L(0); PG8_MMA(0, 0, At, B0); PG8_BAR; PG8_SCHED;
            PG8_LDB(B1, 0, 1); PG8_STAGE(PG8_SB(0, 0), b2, voffB);
            PG8_BAR; PG8_WAIT_L(0); PG8_MMA(0, 1, At, B1); PG8_BAR;
            PG8_LDA(At, 0, 1); PG8_STAGE(PG8_SA(0, 0), a2, voffA);
            PG8_BAR; PG8_WAIT_L(0); PG8_MMA(1, 0, At, B0); PG8_BAR; PG8_SCHED;
            PG8_STAGE(PG8_SB(0, 1), b2 + hstepB, voffB);
            PG8_WAIT_V(6); PG8_BAR; PG8_MMA(1, 1, At, B1); PG8_BAR;
            PG8_LDB(B0, 1, 0); PG8_SCHED; PG8_LDA(At, 1, 0); PG8_STAGE(PG8_SA(0, 1), a2 + hstepA, voffA);
            PG8_WAIT_L(8); PG8_BAR; PG8_WAIT_L(0); PG8_MMA(0, 0, At, B0); PG8_BAR; PG8_SCHED;
            PG8_LDB(B1, 1, 1); PG8_STAGE(PG8_SB(1, 0), b3, voffB);
            PG8_BAR; PG8_WAIT_L(0); PG8_MMA(0, 1, At, B1); PG8_BAR;
            PG8_LDA(At, 1, 1); PG8_STAGE(PG8_SA(1, 0), a3, voffA);
            PG8_BAR; PG8_WAIT_L(0); PG8_MMA(1, 0, At, B0); PG8_BAR; PG8_SCHED;
            PG8_STAGE(PG8_SB(1, 1), b3 + hstepB, voffB);
            PG8_WAIT_V(6); PG8_BAR; PG8_MMA(1, 1, At, B1); PG8_BAR;
            }
        }
        if constexpr (ALIGN_EPI) { if (wr == 0) PG8_BAR; }
        if constexpr (!Epi::AFTER_DRAIN) { E(acc, cur, wr, wc, fr, fq); S.done(cur); }
        if (!has_next) break;
#pragma unroll
        for (int a = 0; a < 2; ++a)
#pragma unroll
            for (int b = 0; b < 2; ++b)
#pragma unroll
                for (int m = 0; m < 4; ++m)
#pragma unroll
                    for (int n = 0; n < 2; ++n) acc[a][b][m][n] = (f32x4){0.f, 0.f, 0.f, 0.f};
        cur = nxt; cA = nA; cB = nB; ++ui;
        if constexpr (ALIGN_EPI) { if (wr == 1) PG8_BAR; }
    }
    PG8_WAIT_V(0);
    if constexpr (!ALIGN_EPI) { if (wr == 0) PG8_BAR; }
    PG8_BAR;
    if constexpr (Epi::AFTER_DRAIN) { E.fused(acc, cur, wr, wc, fr, fq, lds, wid, lane); S.done(cur); }
#undef PG8_SA
#undef PG8_SB
#undef PG8_STAGE
#undef PG8_LDA
#undef PG8_LDB
#undef PG8_MMA
#undef PG8_WAIT_V
#undef PG8_WAIT_L
#undef PG8_BAR
#undef PG8_SCHED
}
}

#ifndef PG8_SP2
#define PG8_SP2 true
#endif
#ifndef PG8_ALIGN
#define PG8_ALIGN true
#endif
#ifndef MK_ONE_LAUNCH
#define MK_ONE_LAUNCH 1
#endif

constexpr int NWAVES = 8;
constexpr int DM = 2048, NB = 4, SEQ = 4096, M = NB * SEQ, FF = 5632, FF2 = 2 * FF;
constexpr int NMOD = 9 * DM;
constexpr int NQKV = 6144, NPROJ = 12288, RVW = 4096;
constexpr int PADE = 64;
constexpr int LDH = DM + PADE, LDF = FF + PADE, LDR = RVW + PADE, LDQ = NQKV + PADE, LDP = NPROJ + PADE;
constexpr size_t PJT = (size_t)M * 256;
constexpr float EPS = 1e-5f;
constexpr float LOG2E = 1.4426950408889634f;
constexpr float QSCALE = 0.08838834764831845f * LOG2E;
constexpr float LAMBDA_INIT0 = 0.2f;

constexpr size_t MiB = 1u << 20;
constexpr size_t WS_CTL = 0, CTL_ZERO_BYTES = 128 * 1024;
constexpr size_t WS_SSQ = 1 * MiB;
constexpr size_t WS_MOD = 2 * MiB;
constexpr size_t WS_GSM = 3 * MiB;
constexpr size_t WS_BIAS = 3 * MiB + 256 * 1024;
constexpr size_t WS_WIN = 6 * MiB, WIN_BYTES = (size_t)FF2 * LDH * 2;
constexpr size_t WS_WOUT = WS_WIN + 4 * WIN_BYTES, WOUT_BYTES = (size_t)DM * LDF * 2;
constexpr size_t WS_WQKV = WS_WOUT + 4 * WOUT_BYTES;
constexpr size_t WS_WODA = WS_WQKV + (size_t)NQKV * LDH * 2;
constexpr size_t WS_WQKVG = WS_WODA + (size_t)DM * LDH * 2;
constexpr size_t WS_WORET = WS_WQKVG + (size_t)NPROJ * LDH * 2;
constexpr size_t WS_H = WS_WORET + (size_t)DM * LDR * 2;
constexpr size_t WS_BIG = WS_H + (size_t)M * LDH * 2;
constexpr size_t WS_AO = WS_BIG + (size_t)M * LDP * 2;
constexpr size_t WS_RO = WS_AO + (size_t)M * LDR * 2;
constexpr size_t WS_XH = WS_RO + (size_t)M * LDR * 2;
constexpr size_t WS_END = WS_XH + (size_t)M * DM * 2;
static_assert(WS_END <= (size_t)1152 * MiB && WS_WIN % 256 == 0 && WIN_BYTES % 256 == 0 && WOUT_BYTES % 256 == 0 && WS_H % 256 == 0 && WS_BIG % 256 == 0 && WS_AO % 256 == 0 && WS_RO % 256 == 0, "ws map");
constexpr int CW_TMO = 0, CW_CODE = 1, CW_BAR = 4096;

constexpr int LDS_BYTES = 163840;
constexpr int MISC_OFF = LDS_BYTES - 256;
constexpr int RING_OFF = 0;

#define GAS __attribute__((address_space(1)))
#define LAS __attribute__((address_space(3)))
typedef unsigned short bf16;
typedef unsigned v4u __attribute__((ext_vector_type(4)));
typedef unsigned v2u __attribute__((ext_vector_type(2)));
typedef float f32x4 __attribute__((ext_vector_type(4)));
typedef GAS unsigned gu32;
#define RLX_AGENT __ATOMIC_RELAXED, __HIP_MEMORY_SCOPE_AGENT
#define LDS_WAIT() asm volatile("s_waitcnt lgkmcnt(0)" ::: "memory")
#define VM_WAIT() asm volatile("s_waitcnt vmcnt(0)" ::: "memory")
__device__ __forceinline__ unsigned pk2(float lo, float hi) { return pg8::cvt_pk_bf16(lo, hi); }
__device__ __forceinline__ float bflo(unsigned u) { return __uint_as_float(u << 16); }
__device__ __forceinline__ float bfhi(unsigned u) { return __uint_as_float(u & 0xffff0000u); }
__device__ __forceinline__ float bf2f(unsigned short b) { return __uint_as_float(((unsigned)b) << 16); }
__device__ __forceinline__ v4u make_srd(const void* base, unsigned nbytes) {
    const unsigned long long a = (unsigned long long)(uintptr_t)base;
    v4u d; d.x = __builtin_amdgcn_readfirstlane((unsigned)a); d.y = __builtin_amdgcn_readfirstlane((unsigned)(a >> 32) & 0xffffu); d.z = nbytes; d.w = 0x00020000u; return d;
}
__device__ __forceinline__ void bstore8(const v4u& srd, v2u data, unsigned voff, int soff) {
    asm volatile("buffer_store_dwordx2 %0, %1, %2, %3 offen" :: "v"(data), "v"(voff), "s"(srd), "s"(soff) : "memory");
}
__device__ __forceinline__ v4u bload16(const v4u& srd, unsigned voff, int soff) {
    v4u r; asm volatile("buffer_load_dwordx4 %0, %1, %2, %3 offen" : "=&v"(r) : "v"(voff), "s"(srd), "s"(soff) : "memory"); return r;
}
__device__ __forceinline__ void dma16(const v4u& srd, unsigned voff, int soff, LAS void* ldsp) {
    unsigned keep; const unsigned la = (unsigned)(uintptr_t)ldsp;
    asm volatile("s_mov_b32 %0, m0\n\ts_mov_b32 m0, %4\n\ts_nop 0\n\tbuffer_load_dwordx4 %1, %2, %3 offen lds\n\ts_mov_b32 m0, %0"
                 : "=&s"(keep) : "v"(voff), "s"(srd), "s"(soff), "s"(la) : "memory");
}

#define XB_TMO      128
#define XB_XCNT(j)  (256  + 64 * (j))
#define XB_XSUB(j)  (1280 + 64 * (j))
#define XB_XGEN(j)  (2304 + 64 * (j))
#define XB_TOP      3328
#define XB_TOPGEN   3392
#define XCD_BAR_WORDS 3456
#define XB_SPIN_CAP (1u << 18)

__device__ __forceinline__ unsigned xb_ld(unsigned* p)              { return __hip_atomic_load(p, __ATOMIC_RELAXED, __HIP_MEMORY_SCOPE_AGENT); }
__device__ __forceinline__ unsigned xb_add(unsigned* p, unsigned v) { return __hip_atomic_fetch_add(p, v, __ATOMIC_RELAXED, __HIP_MEMORY_SCOPE_AGENT); }
__device__ __forceinline__ unsigned xb_xcc_id() { return (unsigned)__builtin_amdgcn_s_getreg((3 << 11) | 20) & 0xFu; }
#define XB_SPIN(cond, bar) do { unsigned _sp = 0; while (cond) { __builtin_amdgcn_s_sleep(1); \
    if ((++_sp & 255u) == 0u) { if (xb_ld(&(bar)[XB_TMO])) break; if (_sp > XB_SPIN_CAP) { atomicAdd(&(bar)[XB_TMO], 1u); break; } } } } while (0)

struct XcdBarrier {
    unsigned* bar; unsigned x;
    volatile LAS unsigned* st;
};

__device__ __forceinline__ XcdBarrier xcd_barrier_post(unsigned* bar, volatile LAS unsigned* st) {
    XcdBarrier b; b.bar = bar; b.x = xb_xcc_id(); b.st = st;
    if (threadIdx.x == 0) (void)xb_add(&bar[XB_XCNT(b.x)], 1u);
    return b;
}
__device__ __forceinline__ void xcd_barrier_complete(unsigned* bar, unsigned x, unsigned& nloc, unsigned& nx) {
    const unsigned G = gridDim.x * gridDim.y * gridDim.z;
    unsigned sum, cnt, mine, sp = 0u;
    for (;;) {
        sum = 0u; cnt = 0u; mine = 0u;
#pragma unroll
        for (unsigned j = 0; j < 16; ++j) { const unsigned c = xb_ld(&bar[XB_XCNT(j)]); sum += c; cnt += (c > 0u) ? 1u : 0u; mine = (j == x) ? c : mine; }
        if (sum == G) break;
        __builtin_amdgcn_s_sleep(1);
        if ((++sp & 255u) == 0u) { if (xb_ld(&bar[XB_TMO])) break; if (sp > XB_SPIN_CAP) { atomicAdd(&bar[XB_TMO], 1u); break; } }
    }
    nloc = mine > 0u ? mine : 1u; nx = cnt > 0u ? cnt : 1u;
}

__device__ __forceinline__ void xcd_barrier(const XcdBarrier& b) {
    asm volatile("s_waitcnt vmcnt(0)" ::: "memory");
    __syncthreads();
    if (threadIdx.x == 0) {
        unsigned* bar = b.bar;
        __builtin_amdgcn_s_waitcnt(0);
        unsigned nloc = b.st[0], nx = b.st[1];
        if (nloc == 0u) { xcd_barrier_complete(bar, b.x, nloc, nx); b.st[0] = nloc; b.st[1] = nx; }
        const unsigned old = xb_add(&bar[XB_XSUB(b.x)], 1u);
        const unsigned gen = old / nloc;
        if (old + 1u == (gen + 1u) * nloc) {
            __builtin_amdgcn_fence(__ATOMIC_RELEASE, "agent");
            asm volatile("s_waitcnt vmcnt(0)" ::: "memory");
            const unsigned og = xb_add(&bar[XB_TOP], 1u);
            const unsigned tg = og / nx;
            if (og + 1u == (tg + 1u) * nx) xb_add(&bar[XB_TOPGEN], 1u);
            else XB_SPIN(xb_ld(&bar[XB_TOPGEN]) == tg, bar);
            __builtin_amdgcn_fence(__ATOMIC_ACQUIRE, "agent");
            xb_add(&bar[XB_XGEN(b.x)], 1u);
            asm volatile("s_waitcnt vmcnt(0)" ::: "memory");
        } else {
            XB_SPIN(xb_ld(&bar[XB_XGEN(b.x)]) == gen, bar);
            __builtin_amdgcn_fence(__ATOMIC_ACQUIRE, "agent");
            asm volatile("s_waitcnt vmcnt(0)" ::: "memory");
        }
    }
    __syncthreads();
}


struct Frame {
    LAS unsigned char* lds;
    volatile LAS unsigned* MISC;
    gu32* ctl;
    int tid, lane, wave, G;
};
__device__ __forceinline__ float wave_sum(float v) {
#pragma unroll
    for (int o = 1; o < 64; o <<= 1) v += __shfl_xor(v, o);
    return v;
}

__device__ __forceinline__ void mod_phase(Frame& F, const float* c, const float* ada_w, const float* ada_b, float* mod) {
    LAS float* cs = (LAS float*)F.lds;
    LAS float* red = (LAS float*)(F.lds + 32768);
    for (int i = F.tid; i < NB * DM; i += NWAVES * 64) { const float v = c[i]; cs[i] = v / (1.0f + __expf(-v)); }
    __syncthreads();
    const int cg = F.tid % 36, ks = F.tid / 36;
    for (int cb = blockIdx.x; cb < 256; cb += F.G) {
        const int layer = cb >> 7, col0 = (cb & 127) * 144;
        if (ks < 14) {
            const float* W = ada_w + (size_t)layer * DM * NMOD + col0 + cg * 4;
            f32x4 a0 = {0.f, 0.f, 0.f, 0.f}, a1 = a0, a2 = a0, a3 = a0;
#pragma unroll 4
            for (int k = ks; k < DM; k += 14) {
                const f32x4 w = *(const f32x4*)(W + (size_t)k * NMOD);
                a0 += w * cs[k]; a1 += w * cs[DM + k]; a2 += w * cs[2 * DM + k]; a3 += w * cs[3 * DM + k];
            }
            LAS f32x4* r = (LAS f32x4*)(red + (ks * 4) * 144 + cg * 4);
            r[0] = a0; r[36] = a1; r[72] = a2; r[108] = a3;
        }
        __syncthreads();
        for (int o = F.tid; o < 4 * 144; o += NWAVES * 64) {
            const int b = o / 144, cc = o % 144; float s = 0.f;
#pragma unroll
            for (int k2 = 0; k2 < 14; ++k2) s += red[(k2 * 4 + b) * 144 + cc];
            mod[(size_t)(layer * NB + b) * NMOD + col0 + cc] = s + ada_b[(size_t)layer * NMOD + col0 + cc];
        }
        __syncthreads();
    }
}
__device__ __forceinline__ size_t wt_off(int n, int k, int K) { return (size_t)(n >> 8) * ((size_t)(K >> 6) * 16384 + 2048) + (size_t)(k >> 6) * 16384 + (size_t)(n & 255) * 64 + (k & 63); }
__device__ __forceinline__ void transpose_item(const float* W, int K, int N, bf16* WT, int ldk, int mode, LAS float* scr, int item, int lane) {
    const int nblk = N / 32, kb = item / nblk, nb = item % nblk, k0 = 64 * kb, n0 = 32 * nb;
#pragma unroll 8
    for (int i = 0; i < 32; ++i) { const int kk = 2 * i + (lane >> 5); scr[kk * 33 + (lane & 31)] = W[(size_t)(k0 + kk) * N + n0 + (lane & 31)]; }
    LDS_WAIT(); asm volatile("" ::: "memory");
    int r0 = n0;
    if (mode == 1) { const int up = n0 >= FF ? 1 : 0, j = n0 - up * FF; r0 = (j >> 7) * 256 + up * 128 + (j & 127); }
    const int c = lane & 7;
#pragma unroll
    for (int j = 0; j < 4; ++j) { const int n = (lane >> 3) + 8 * j; const LAS float* s = scr + (8 * c) * 33 + n;
        v4u o; o.x = pk2(s[0 * 33], s[1 * 33]); o.y = pk2(s[2 * 33], s[3 * 33]); o.z = pk2(s[4 * 33], s[5 * 33]); o.w = pk2(s[6 * 33], s[7 * 33]);
        *(GAS v4u*)(WT + wt_off(r0 + n, k0 + 8 * c, K)) = o; }
    LDS_WAIT(); asm volatile("" ::: "memory");
}
struct WPtrs { const float *w_in, *w_out, *w_qkv, *w_oda, *w_qkvg, *w_oret; unsigned char* ws; };
__device__ __forceinline__ void convert_phase(Frame& F, const WPtrs& P) {
    LAS float* scr = (LAS float*)(F.lds + F.wave * 16384);
    const int gw = blockIdx.x * NWAVES + F.wave, NGW = F.G * NWAVES;
    constexpr int I_IN = (DM / 64) * (FF2 / 32), I_OUT = (FF / 64) * (DM / 32), I_QKV = (DM / 64) * (NQKV / 32), I_ODA = (DM / 64) * (DM / 32), I_QKVG = (DM / 64) * (NPROJ / 32), I_ORET = (RVW / 64) * (DM / 32);
    constexpr int NITEMS = 4 * I_IN + 4 * I_OUT + I_QKV + I_ODA + I_QKVG + I_ORET;
    for (int it = gw; it < NITEMS; it += NGW) {
        int r = it;
        if (r < 4 * I_IN) { const int f = r / I_IN; transpose_item(P.w_in + (size_t)f * DM * FF2, DM, FF2, (bf16*)(P.ws + WS_WIN + f * WIN_BYTES), LDH, 1, scr, r % I_IN, F.lane); continue; } r -= 4 * I_IN;
        if (r < 4 * I_OUT) { const int f = r / I_OUT; transpose_item(P.w_out + (size_t)f * FF * DM, FF, DM, (bf16*)(P.ws + WS_WOUT + f * WOUT_BYTES), LDF, 0, scr, r % I_OUT, F.lane); continue; } r -= 4 * I_OUT;
        if (r < I_QKV) { transpose_item(P.w_qkv, DM, NQKV, (bf16*)(P.ws + WS_WQKV), LDH, 0, scr, r, F.lane); continue; } r -= I_QKV;
        if (r < I_ODA) { transpose_item(P.w_oda, DM, DM, (bf16*)(P.ws + WS_WODA), LDH, 0, scr, r, F.lane); continue; } r -= I_ODA;
        if (r < I_QKVG) { transpose_item(P.w_qkvg, DM, NPROJ, (bf16*)(P.ws + WS_WQKVG), LDH, 0, scr, r, F.lane); continue; } r -= I_QKVG;
        transpose_item(P.w_oret, RVW, DM, (bf16*)(P.ws + WS_WORET), LDR, 0, scr, r, F.lane);
    }
}
constexpr int BIASP = 12288;
__device__ __forceinline__ void pre_phase(Frame& F, const float* A_x_in, const float* A_norm_g, const float* A_mod, unsigned char* A_ws) {
    float* gsm = (float*)(A_ws + WS_GSM); float* bias = (float*)(A_ws + WS_BIAS); float* ssq = (float*)(A_ws + WS_SSQ); bf16* Hb = (bf16*)(A_ws + WS_H);
    const int gw = blockIdx.x * NWAVES + F.wave, NGW = F.G * NWAVES;
    for (int i = blockIdx.x * (NWAVES * 64) + F.tid; i < 6 * NB * DM; i += F.G * NWAVES * 64) {
        const int s = i / (NB * DM), b = (i / DM) % NB, col = i % DM, layer = s / 3, j = s % 3;
        gsm[i] = A_norm_g[(size_t)s * DM + col] * (1.0f + A_mod[(size_t)(layer * NB + b) * NMOD + (3 * j + 1) * DM + col]);
    }
    for (int m = gw; m < M; m += NGW) {
        const int b = m >> 12;
        const f32x4* sc4 = (const f32x4*)(A_mod + (size_t)b * NMOD + DM); const f32x4* g4 = (const f32x4*)A_norm_g;
        const f32x4* xr = (const f32x4*)(A_x_in + (size_t)m * DM);
        f32x4 v[8]; float ss = 0.f;
#pragma unroll
        for (int j = 0; j < 8; ++j) { v[j] = xr[F.lane + 64 * j]; ss += (v[j].x * v[j].x + v[j].y * v[j].y) + (v[j].z * v[j].z + v[j].w * v[j].w); }
        ss = wave_sum(ss);
        if (F.lane == 0) ssq[m] = ss;
        bf16* o = Hb + (size_t)(m >> 8) * pg8::XS_PANEL + (size_t)(m & 255) * 64;
#pragma unroll
        for (int j = 0; j < 8; ++j) { const int c4 = F.lane + 64 * j, col = 4 * c4; const f32x4 y = v[j] * (g4[c4] * (sc4[c4] + 1.0f));
            v2u w; w.x = pk2(y.x, y.y); w.y = pk2(y.z, y.w); *(v2u*)(o + (size_t)(col >> 6) * 16384 + (col & 63)) = w; }
    }
    for (int s = 0; s < 6; ++s) {
        const int layer = s / 3, j = s % 3;
        const bf16* Wt; int N;
        if (s == 1) { Wt = (const bf16*)(A_ws + WS_WQKV); N = NQKV; } else if (s == 4) { Wt = (const bf16*)(A_ws + WS_WQKVG); N = NPROJ; }
        else { const int f = (s == 0) ? 0 : (s == 2) ? 1 : (s == 3) ? 2 : 3; Wt = (const bf16*)(A_ws + WS_WIN + (size_t)f * WIN_BYTES); N = FF2; }
        float sh[4][32];
#pragma unroll
        for (int b = 0; b < 4; ++b)
#pragma unroll
            for (int jj = 0; jj < 4; ++jj) { const float* sp = A_mod + (size_t)(layer * NB + b) * NMOD + (3 * j) * DM + 8 * F.lane + 512 * jj;
                const f32x4 a = *(const f32x4*)sp, c = *(const f32x4*)(sp + 4);
                sh[b][8 * jj + 0] = a.x; sh[b][8 * jj + 1] = a.y; sh[b][8 * jj + 2] = a.z; sh[b][8 * jj + 3] = a.w; sh[b][8 * jj + 4] = c.x; sh[b][8 * jj + 5] = c.y; sh[b][8 * jj + 6] = c.z; sh[b][8 * jj + 7] = c.w; }
        for (int n = gw; n < N; n += NGW) {
            const bf16* wr = Wt + wt_off(n, 8 * (F.lane & 7), DM) + (size_t)(F.lane >> 3) * 16384;
            float a0 = 0.f, a1 = 0.f, a2 = 0.f, a3 = 0.f;
#pragma unroll
            for (int jj = 0; jj < 4; ++jj) { const v4u wv = *(const v4u*)(wr + (size_t)(8 * jj) * 16384);
                const float w0 = bflo(wv.x), w1 = bfhi(wv.x), w2 = bflo(wv.y), w3 = bfhi(wv.y), w4 = bflo(wv.z), w5 = bfhi(wv.z), w6 = bflo(wv.w), w7 = bfhi(wv.w);
#define PRE_DOT(acc, b) acc += w0 * sh[b][8 * jj] + w1 * sh[b][8 * jj + 1] + w2 * sh[b][8 * jj + 2] + w3 * sh[b][8 * jj + 3] + w4 * sh[b][8 * jj + 4] + w5 * sh[b][8 * jj + 5] + w6 * sh[b][8 * jj + 6] + w7 * sh[b][8 * jj + 7]
                PRE_DOT(a0, 0); PRE_DOT(a1, 1); PRE_DOT(a2, 2); PRE_DOT(a3, 3);
#undef PRE_DOT
            }
            a0 = wave_sum(a0); a1 = wave_sum(a1); a2 = wave_sum(a2); a3 = wave_sum(a3);
            if (F.lane == 0) { float* bo = bias + (size_t)(s * NB) * BIASP + n; bo[0] = a0; bo[BIASP] = a1; bo[2 * BIASP] = a2; bo[3 * BIASP] = a3; }
        }
    }
}
__device__ __forceinline__ void ssq_reduce(Frame& F, const float* part, float* ssq) {
    for (int row = blockIdx.x * (NWAVES * 64) + F.tid; row < M; row += F.G * NWAVES * 64) { float s = 0.f;
#pragma unroll
        for (int k = 0; k < 32; ++k) s += part[(size_t)k * M + row];
        ssq[row] = s; }
}
__device__ __forceinline__ void ssq_pair(Frame& F, const float* part, float* ssq, int pa, int pb) {
    const int pm = (F.tid < 256) ? pa : pb;
    if (pm >= 0) { const int row = pm * 256 + (F.tid & 255); float s = 0.f;
#pragma unroll
        for (int k = 0; k < 32; ++k) s += part[(size_t)k * M + row];
        ssq[row] = s; }
}
template <class Sched> __device__ __forceinline__ void ssq_local(Frame& F, const Sched& S, const float* part, float* ssq) {
    int p0 = -1, p1 = -1; pg8::Unit u;
    for (int i = 0; S.next(i, u); ++i) {
        if (u.pm == p0 || u.pm == p1) continue;
        if (p0 < 0) p0 = u.pm; else if (p1 < 0) p1 = u.pm; else { ssq_pair(F, part, ssq, p0, p1); p0 = u.pm; p1 = -1; }
    }
    ssq_pair(F, part, ssq, p0, p1);
    asm volatile("s_waitcnt vmcnt(0)" ::: "memory");
    __syncthreads();
}
__device__ __forceinline__ void final_phase(Frame& F, const unsigned short* xh, float* out, const float* g) {
    const int gw = blockIdx.x * NWAVES + F.wave, NGW = F.G * NWAVES;
    for (int m = gw; m < M; m += NGW) {
        const unsigned short* xr = xh + (size_t)(m >> 8) * 8 * 65536 + (size_t)(m & 255) * 256 + 4 * F.lane;
        f32x4 v[8]; float ss = 0.f;
#pragma unroll
        for (int j = 0; j < 8; ++j) { const v2u h = *(const v2u*)(xr + (size_t)j * 65536); const pg8::f32x2 a = pg8::unpk_f16(h.x), c = pg8::unpk_f16(h.y);
            v[j] = (f32x4){a.x, a.y, c.x, c.y}; ss += (v[j].x * v[j].x + v[j].y * v[j].y) + (v[j].z * v[j].z + v[j].w * v[j].w); }
        const float rstd = 1.0f / sqrtf(wave_sum(ss) * (1.0f / DM) + EPS);
        f32x4* orow = (f32x4*)(out + (size_t)m * DM); const f32x4* g4 = (const f32x4*)g;
#pragma unroll
        for (int j = 0; j < 8; ++j) orow[F.lane + 64 * j] = (v[j] * rstd) * g4[F.lane + 64 * j];
    }
}

constexpr size_t WS_KMAX = 65536;
__device__ __forceinline__ void att_kmax_phase(Frame& F, const bf16* qkv, unsigned* kmax) {
    const int gw = blockIdx.x * NWAVES + F.wave, NGW = F.G * NWAVES;
    for (int r8 = gw; r8 < M / 8; r8 += NGW) {
        float mx = 0.f;
        for (int j = 0; j < 8; ++j) { const v4u* kp = (const v4u*)(qkv + (size_t)(8 + (F.lane >> 3)) * PJT + (size_t)(r8 * 8 + j) * 256 + 32 * (F.lane & 7)); float ss = 0.f;
#pragma unroll
            for (int u = 0; u < 4; ++u) { const v4u kk = kp[u];
                ss += bflo(kk.x) * bflo(kk.x) + bfhi(kk.x) * bfhi(kk.x) + bflo(kk.y) * bflo(kk.y) + bfhi(kk.y) * bfhi(kk.y) + bflo(kk.z) * bflo(kk.z) + bfhi(kk.z) * bfhi(kk.z) + bflo(kk.w) * bflo(kk.w) + bfhi(kk.w) * bfhi(kk.w); }
            ss += __shfl_xor(ss, 1); ss += __shfl_xor(ss, 2); mx = fmaxf(mx, ss); }
        if ((F.lane & 3) == 0) atomicMax(kmax + ((r8 * 8) >> 12) * 16 + (F.lane >> 2), __float_as_uint(mx));
    }
}
namespace attp {
typedef short bf16x8 __attribute__((ext_vector_type(8)));
typedef short s16x4 __attribute__((ext_vector_type(4)));
typedef float f32x16 __attribute__((ext_vector_type(16)));
constexpr int KTILE = 2 * 32 * 256;
constexpr int VSTR = 1088, VTILE = 16 * VSTR;
constexpr int PSTREAM = 2 * 1024 + 256 + 16;
constexpr int K_OFF = 0, V_OFF = 3 * KTILE, P_OFF = V_OFF + 4 * VTILE, LQ_OFF = P_OFF + 2 * 4 * PSTREAM, SUBG_OFF = LQ_OFF + 4 * 32 * 4, MARG_OFF = SUBG_OFF + 1024, END_OFF = MARG_OFF + 16;
static_assert(END_OFF <= MISC_OFF && 2 * 128 * 64 * 4 <= P_OFF, "attention LDS map");
__device__ __forceinline__ s16x4 vtr(const LAS char* p) { return __builtin_bit_cast(s16x4, __builtin_amdgcn_ds_read_tr16_b64_v4i16((LAS s16x4*)p)); }
__device__ __forceinline__ float hmax(float v) { auto rr = __builtin_amdgcn_permlane32_swap(__float_as_uint(v), __float_as_uint(v), false, false); return fmaxf(__uint_as_float(rr[0]), __uint_as_float(rr[1])); }
__device__ __forceinline__ float hsum(float v) { auto rr = __builtin_amdgcn_permlane32_swap(__float_as_uint(v), __float_as_uint(v), false, false); return __uint_as_float(rr[0]) + __uint_as_float(rr[1]); }
__device__ __forceinline__ bf16x8 pack8(const f32x16& p, int s) {
    v4u w; w.x = pg8::cvt_pk_bf16(p[8 * s + 0], p[8 * s + 1]); w.y = pg8::cvt_pk_bf16(p[8 * s + 2], p[8 * s + 3]); w.z = pg8::cvt_pk_bf16(p[8 * s + 4], p[8 * s + 5]); w.w = pg8::cvt_pk_bf16(p[8 * s + 6], p[8 * s + 7]);
    return __builtin_bit_cast(bf16x8, w);
}
}
__device__ __forceinline__ void att_pc_phase(Frame& F, const bf16* qkv, bf16* ao, const float* lam, const float* subg, const float* kmax) {
    using namespace attp;
    __builtin_amdgcn_s_waitcnt(0x0F70);
    LAS char* L = (LAS char*)F.lds;
    const int lane = F.lane, r = lane & 31, hh = lane >> 5, w = F.wave;
    const bool producer = w < 4; const int st = w & 3, map = st >> 1, rg = st & 1;
    if (w == 0) {
        const float s1 = wave_sum(lam[lane] * lam[128 + lane] + lam[64 + lane] * lam[192 + lane]);
        const float s2 = wave_sum(lam[256 + lane] * lam[384 + lane] + lam[320 + lane] * lam[448 + lane]);
        if (lane == 0) F.MISC[16] = __float_as_uint(expf(s1) - expf(s2) + LAMBDA_INIT0);
    }
    if (F.tid < 256) ((LAS float*)(L + SUBG_OFF))[F.tid] = subg[F.tid] * (1.0f - LAMBDA_INIT0);
    __syncthreads();
    const float lamv = __uint_as_float(F.MISC[16]);
    const int vcu = (F.G % 8 == 0) ? (int)(blockIdx.x & 7) * (F.G >> 3) + (int)(blockIdx.x >> 3) : (int)blockIdx.x;
    const unsigned ksrc_b = (unsigned)((lane >> 4) * 512 + (((lane & 15) ^ ((4 * (w & 3) + (lane >> 4)) & 15)) * 16));
    const unsigned vsrc_b = (unsigned)((lane >> 5) * 16 * 512 + (lane & 31) * 16);
    const unsigned qsrc_b = (unsigned)((32 * rg + r) * 256 + 8 * hh) * 2u;
    const __amdgpu_buffer_rsrc_t rs_qkv = __builtin_amdgcn_make_buffer_rsrc((void*)qkv, 0, (int)(24 * PJT * 2), 0x00020000);
    const __amdgpu_buffer_rsrc_t rs_ao = __builtin_amdgcn_make_buffer_rsrc((void*)ao, 0, M * LDH * 2, 0x00020000);
    const v4u sd_qkv = make_srd(qkv, (unsigned)(24 * PJT * 2));
    const unsigned kc16 = (unsigned)(16 * (hh ^ (r & 15)));
    const int kfrag_l = map * 8192 + r * 256;
    const int vfrag_l = (4 * hh + ((lane & 15) >> 2)) * VSTR + ((lane >> 4) & 1) * 32 + (lane & 3) * 8;
    const int pst_l = st * PSTREAM;
    for (int p = vcu; p < 1024; p += F.G) {
        const int pr = p & 31, b = (p >> 8) & 3, xs_ = (p >> 5) & 7, kr = (p >> 8) & 3, h = (kr == 0) ? xs_ : (kr == 1) ? 7 - xs_ : (kr == 2) ? (xs_ ^ 4) : 7 - (xs_ ^ 4);
        const int rowbase = b * SEQ;
        const float slope2 = exp2f(-(float)(h + 1)) * LOG2E;
        const int kbase_b = (int)(((size_t)(8 + h) * PJT + (size_t)rowbase * 256) * 2), vbase_b = (int)(((size_t)(16 + h) * PJT + (size_t)rowbase * 256) * 2);
        for (int half2 = 0; half2 < 2; ++half2) {
            const int c = half2 ? 63 - pr : pr;
            const int tq = c * 64 + 32 * rg + r;
            const int n32 = 2 * (c + 1);
            f32x16 o[8];
#define ATP_QF(ks) __builtin_bit_cast(bf16x8, (f32x4){o[(ks) >> 2][4 * ((ks) & 3)], o[(ks) >> 2][4 * ((ks) & 3) + 1], o[(ks) >> 2][4 * ((ks) & 3) + 2], o[(ks) >> 2][4 * ((ks) & 3) + 3]})
            float mrun = 0.f, lsum = 0.f; bool fresh = true;
            if (producer) { const int qoff = (int)(((size_t)h * PJT + (size_t)(rowbase + c * 64) * 256 + map * 128) * 2);
#pragma unroll
                for (int ks = 0; ks < 8; ++ks) { const f32x4 q4 = __builtin_bit_cast(f32x4, __builtin_amdgcn_raw_buffer_load_b128(rs_qkv, qsrc_b, qoff + 32 * ks, 0));
                    o[ks >> 2][4 * (ks & 3)] = q4[0]; o[ks >> 2][4 * (ks & 3) + 1] = q4[1]; o[ks >> 2][4 * (ks & 3) + 2] = q4[2]; o[ks >> 2][4 * (ks & 3) + 3] = q4[3]; } }
            else {
#pragma unroll
                for (int eb = 0; eb < 8; ++eb)
#pragma unroll
                    for (int i = 0; i < 16; ++i) o[eb][i] = 0.f; }
            float qnk = 0.f;
            if (producer) { float qq = 0.f;
#pragma unroll
                for (int e = 0; e < 32; ++e) { const unsigned u_ = __float_as_uint(o[e >> 4][e & 15]); qq += bflo(u_) * bflo(u_) + bfhi(u_) * bfhi(u_); }
                qnk = sqrtf(hsum(qq)) * sqrtf(kmax[b * 16 + h * 2 + map]) * 1.004f; }
            int nend = n32;
            __builtin_amdgcn_s_waitcnt(0x0F70);
#define ATP_ISSUE(kt32, ti) do { const int k0_ = (kt32) * 32; \
        _Pragma("unroll") for (int i_ = 0; i_ < 2; ++i_) { const int pc_ = (w & 3) + 4 * i_; \
            dma16(sd_qkv, ksrc_b, kbase_b + (k0_ + 4 * pc_) * 512 + (w >> 2) * 256, (LAS void*)(L + K_OFF + ((ti) % 3) * KTILE + (w >> 2) * 8192 + pc_ * 1024)); } \
        _Pragma("unroll") for (int i_ = 0; i_ < 2; ++i_) { const int pc_ = 2 * w + i_; \
            dma16(sd_qkv, vsrc_b, vbase_b + (k0_ + pc_) * 512, (LAS void*)(L + V_OFF + ((ti) & 3) * VTILE + pc_ * VSTR)); } } while (0)
            ATP_ISSUE(n32 - 1, 0); ATP_ISSUE(n32 - 2, 1);
            int issued = 2;
            for (int i = 0; i <= nend; ++i) {
                if (issued > i + 1) asm volatile("s_waitcnt vmcnt(4)" ::: "memory"); else VM_WAIT();
                __syncthreads();
                if (i == 2) { const LAS float* mg = (const LAS float*)(L + MARG_OFF); const float need = fmaxf(fmaxf(mg[0], mg[1]), fmaxf(mg[2], mg[3]));
                    const float xcut = (need + 161.0f) / (32.0f * slope2) + 1.97f; const int idead = (xcut < 4096.0f ? (int)xcut : 4096) + 2; nend = idead < n32 ? idead : n32; if (nend < 2) nend = 2; }
                if (i + 2 < nend) { ATP_ISSUE(n32 - 3 - i, i + 2); issued = i + 3; }
                if (producer) {
                    if (i < nend) {
                        const int kt32 = n32 - 1 - i;
                        const LAS char* Kb = L + K_OFF + (i % 3) * KTILE + kfrag_l;
                        f32x16 S;
                        const int j0 = kt32 * 32 + 4 * hh - tq;
                        if (kt32 < 2 * c) {
                            const float b0 = slope2 * (float)j0 - mrun, b1 = b0 + slope2, b2 = b1 + slope2, b3 = b2 + slope2, s8 = 8.0f * slope2, s16 = 16.0f * slope2, s24 = 24.0f * slope2;
                            S[0] = b0; S[1] = b1; S[2] = b2; S[3] = b3; S[4] = b0 + s8; S[5] = b1 + s8; S[6] = b2 + s8; S[7] = b3 + s8;
                            S[8] = b0 + s16; S[9] = b1 + s16; S[10] = b2 + s16; S[11] = b3 + s16; S[12] = b0 + s24; S[13] = b1 + s24; S[14] = b2 + s24; S[15] = b3 + s24;
                        } else {
#pragma unroll
                            for (int i_ = 0; i_ < 16; ++i_) S[i_] = fmaf(-slope2, fabsf((float)(j0 + ((i_ & 3) + 8 * (i_ >> 2)))), -mrun);
                        }
                        { const unsigned kb_ = (unsigned)(uintptr_t)Kb;
                          asm volatile("s_nop 4\n\tv_xor_b32 v220, 0, %[c]\n\tv_add_u32 v220, v220, %[b]\n\tds_read_b128 v[220:223], v220\n\tv_xor_b32 v224, 32, %[c]\n\tv_add_u32 v224, v224, %[b]\n\tds_read_b128 v[224:227], v224\n\tv_xor_b32 v228, 64, %[c]\n\tv_add_u32 v228, v228, %[b]\n\tds_read_b128 v[228:231], v228\n\tv_xor_b32 v232, 96, %[c]\n\tv_add_u32 v232, v232, %[b]\n\tds_read_b128 v[232:235], v232\n\tv_xor_b32 v236, 128, %[c]\n\tv_add_u32 v236, v236, %[b]\n\tds_read_b128 v[236:239], v236\n\tv_xor_b32 v240, 160, %[c]\n\tv_add_u32 v240, v240, %[b]\n\tds_read_b128 v[240:243], v240\n\tv_xor_b32 v244, 192, %[c]\n\tv_add_u32 v244, v244, %[b]\n\tds_read_b128 v[244:247], v244\n\tv_xor_b32 v248, 224, %[c]\n\tv_add_u32 v248, v248, %[b]\n\tds_read_b128 v[248:251], v248\n\ts_waitcnt lgkmcnt(7)\n\tv_mfma_f32_32x32x16_bf16 %[s], v[220:223], %[q0], %[s]\n\ts_waitcnt lgkmcnt(6)\n\tv_mfma_f32_32x32x16_bf16 %[s], v[224:227], %[q1], %[s]\n\ts_waitcnt lgkmcnt(5)\n\tv_mfma_f32_32x32x16_bf16 %[s], v[228:231], %[q2], %[s]\n\ts_waitcnt lgkmcnt(4)\n\tv_mfma_f32_32x32x16_bf16 %[s], v[232:235], %[q3], %[s]\n\ts_waitcnt lgkmcnt(3)\n\tv_mfma_f32_32x32x16_bf16 %[s], v[236:239], %[q4], %[s]\n\ts_waitcnt lgkmcnt(2)\n\tv_mfma_f32_32x32x16_bf16 %[s], v[240:243], %[q5], %[s]\n\ts_waitcnt lgkmcnt(1)\n\tv_mfma_f32_32x32x16_bf16 %[s], v[244:247], %[q6], %[s]\n\ts_waitcnt lgkmcnt(0)\n\tv_mfma_f32_32x32x16_bf16 %[s], v[248:251], %[q7], %[s]\n\ts_nop 15"
                              : [s] "+v"(S) : [b] "v"(kb_), [c] "v"(kc16), [q0] "v"(ATP_QF(0)), [q1] "v"(ATP_QF(1)), [q2] "v"(ATP_QF(2)), [q3] "v"(ATP_QF(3)), [q4] "v"(ATP_QF(4)), [q5] "v"(ATP_QF(5)), [q6] "v"(ATP_QF(6)), [q7] "v"(ATP_QF(7))
                              : "memory", "v220", "v221", "v222", "v223", "v224", "v225", "v226", "v227", "v228", "v229", "v230", "v231", "v232", "v233", "v234", "v235", "v236", "v237", "v238", "v239", "v240", "v241", "v242", "v243", "v244", "v245", "v246", "v247", "v248", "v249", "v250", "v251"); }
                        float mx = fmaxf(S[0], S[1]);
#pragma unroll
                        for (int i_ = 2; i_ < 16; ++i_) mx = fmaxf(mx, S[i_]);
                        const bool live = fresh || !__all(mx < -160.0f);
                        LAS char* pb = L + P_OFF + (i & 1) * (4 * PSTREAM) + pst_l;
                        float alpha = 1.0f;
                        if (live) {
                            mx = hmax(mx);
                            if (fresh || __any(mx > 8.0f)) { const float sh = fresh ? mx : fmaxf(mx, 0.0f);
#pragma unroll
                                for (int i_ = 0; i_ < 16; ++i_) S[i_] -= sh;
                                mrun += sh; if (!fresh) alpha = __builtin_amdgcn_exp2f(-sh); fresh = false; }
                            float ls = 0.f;
#pragma unroll
                            for (int i_ = 0; i_ < 16; ++i_) { S[i_] = __builtin_amdgcn_exp2f(S[i_]); ls += S[i_]; }
                            lsum = lsum * alpha + ls;
                            *(LAS bf16x8*)(pb + lane * 16) = pack8(S, 0); *(LAS bf16x8*)(pb + 1024 + lane * 16) = pack8(S, 1);
                            *(LAS float*)(pb + 2048 + lane * 4) = alpha;
                        }
                        if (lane == 0) *(LAS unsigned*)(pb + 2304) = live ? 1u : 0u;
                        if (i == 1) { float mg = qnk - mrun;
#pragma unroll
                            for (int o_ = 1; o_ < 64; o_ <<= 1) mg = fmaxf(mg, __shfl_xor(mg, o_));
                            if (lane == 0) ((LAS float*)(L + MARG_OFF))[st] = mg; }
                    }
                } else if (i >= 1) {
                    const LAS char* pb = L + P_OFF + ((i - 1) & 1) * (4 * PSTREAM) + pst_l;
                    const unsigned live = __builtin_amdgcn_readfirstlane(*(const LAS unsigned*)(pb + 2304));
                    if (live) {
                        const float alpha = *(const LAS float*)(pb + 2048 + lane * 4);
                        const bf16x8 pf0 = *(const LAS bf16x8*)(pb + lane * 16), pf1 = *(const LAS bf16x8*)(pb + 1024 + lane * 16);
                        if (__any(alpha != 1.0f)) {
#pragma unroll
                            for (int eb = 0; eb < 8; ++eb) o[eb] = o[eb] * alpha; }
                        { const unsigned va_ = (unsigned)(uintptr_t)(L + V_OFF + ((i - 1) & 3) * VTILE + vfrag_l);
                          asm volatile("s_nop 4\n\tds_read_b64_tr_b16 v[228:229], %[a] offset:0\n\tds_read_b64_tr_b16 v[230:231], %[a] offset:8704\n\tds_read_b64_tr_b16 v[232:233], %[a] offset:512\n\tds_read_b64_tr_b16 v[234:235], %[a] offset:9216\n\tds_read_b64_tr_b16 v[236:237], %[a] offset:64\n\tds_read_b64_tr_b16 v[238:239], %[a] offset:8768\n\tds_read_b64_tr_b16 v[240:241], %[a] offset:576\n\tds_read_b64_tr_b16 v[242:243], %[a] offset:9280\n\tds_read_b64_tr_b16 v[244:245], %[a] offset:128\n\tds_read_b64_tr_b16 v[246:247], %[a] offset:8832\n\tds_read_b64_tr_b16 v[248:249], %[a] offset:640\n\tds_read_b64_tr_b16 v[250:251], %[a] offset:9344\n\ts_waitcnt lgkmcnt(10)\n\tv_mfma_f32_32x32x16_bf16 %[o0], v[228:231], %[p0], %[o0]\n\tds_read_b64_tr_b16 v[228:229], %[a] offset:192\n\tds_read_b64_tr_b16 v[230:231], %[a] offset:8896\n\ts_waitcnt lgkmcnt(10)\n\tv_mfma_f32_32x32x16_bf16 %[o0], v[232:235], %[p1], %[o0]\n\tds_read_b64_tr_b16 v[232:233], %[a] offset:704\n\tds_read_b64_tr_b16 v[234:235], %[a] offset:9408\n\ts_waitcnt lgkmcnt(10)\n\tv_mfma_f32_32x32x16_bf16 %[o1], v[236:239], %[p0], %[o1]\n\tds_read_b64_tr_b16 v[236:237], %[a] offset:256\n\tds_read_b64_tr_b16 v[238:239], %[a] offset:8960\n\ts_waitcnt lgkmcnt(10)\n\tv_mfma_f32_32x32x16_bf16 %[o1], v[240:243], %[p1], %[o1]\n\tds_read_b64_tr_b16 v[240:241], %[a] offset:768\n\tds_read_b64_tr_b16 v[242:243], %[a] offset:9472\n\ts_waitcnt lgkmcnt(10)\n\tv_mfma_f32_32x32x16_bf16 %[o2], v[244:247], %[p0], %[o2]\n\tds_read_b64_tr_b16 v[244:245], %[a] offset:320\n\tds_read_b64_tr_b16 v[246:247], %[a] offset:9024\n\ts_waitcnt lgkmcnt(10)\n\tv_mfma_f32_32x32x16_bf16 %[o2], v[248:251], %[p1], %[o2]\n\tds_read_b64_tr_b16 v[248:249], %[a] offset:832\n\tds_read_b64_tr_b16 v[250:251], %[a] offset:9536\n\ts_waitcnt lgkmcnt(10)\n\tv_mfma_f32_32x32x16_bf16 %[o3], v[228:231], %[p0], %[o3]\n\tds_read_b64_tr_b16 v[228:229], %[a] offset:384\n\tds_read_b64_tr_b16 v[230:231], %[a] offset:9088\n\ts_waitcnt lgkmcnt(10)\n\tv_mfma_f32_32x32x16_bf16 %[o3], v[232:235], %[p1], %[o3]\n\tds_read_b64_tr_b16 v[232:233], %[a] offset:896\n\tds_read_b64_tr_b16 v[234:235], %[a] offset:9600\n\ts_waitcnt lgkmcnt(10)\n\tv_mfma_f32_32x32x16_bf16 %[o4], v[236:239], %[p0], %[o4]\n\tds_read_b64_tr_b16 v[236:237], %[a] offset:448\n\tds_read_b64_tr_b16 v[238:239], %[a] offset:9152\n\ts_waitcnt lgkmcnt(10)\n\tv_mfma_f32_32x32x16_bf16 %[o4], v[240:243], %[p1], %[o4]\n\tds_read_b64_tr_b16 v[240:241], %[a] offset:960\n\tds_read_b64_tr_b16 v[242:243], %[a] offset:9664\n\ts_waitcnt lgkmcnt(10)\n\tv_mfma_f32_32x32x16_bf16 %[o5], v[244:247], %[p0], %[o5]\n\ts_waitcnt lgkmcnt(8)\n\tv_mfma_f32_32x32x16_bf16 %[o5], v[248:251], %[p1], %[o5]\n\ts_waitcnt lgkmcnt(6)\n\tv_mfma_f32_32x32x16_bf16 %[o6], v[228:231], %[p0], %[o6]\n\ts_waitcnt lgkmcnt(4)\n\tv_mfma_f32_32x32x16_bf16 %[o6], v[232:235], %[p1], %[o6]\n\ts_waitcnt lgkmcnt(2)\n\tv_mfma_f32_32x32x16_bf16 %[o7], v[236:239], %[p0], %[o7]\n\ts_waitcnt lgkmcnt(0)\n\tv_mfma_f32_32x32x16_bf16 %[o7], v[240:243], %[p1], %[o7]\n\ts_nop 15"
                              : [o0] "+v"(o[0]), [o1] "+v"(o[1]), [o2] "+v"(o[2]), [o3] "+v"(o[3]), [o4] "+v"(o[4]), [o5] "+v"(o[5]), [o6] "+v"(o[6]), [o7] "+v"(o[7])
                              : [a] "v"(va_), [p0] "v"(pf0), [p1] "v"(pf1)
                              : "memory", "v228", "v229", "v230", "v231", "v232", "v233", "v234", "v235", "v236", "v237", "v238", "v239", "v240", "v241", "v242", "v243", "v244", "v245", "v246", "v247", "v248", "v249", "v250", "v251"); }
                    }
                }
            }
#undef ATP_ISSUE
#undef ATP_QF
            int lane2 = F.lane; asm volatile("" : "+v"(lane2));
            const int hh2 = lane2 >> 5;
            LAS float* LQ = (LAS float*)(L + LQ_OFF) + st * 32 + (lane2 & 31);
            if (producer) { const float lt = hsum(lsum); if (hh2 == 0) *LQ = lt; }
            VM_WAIT();
            __syncthreads();
            LAS float* X = (LAS float*)L + (rg * 128) * 64 + lane2;
            float inv = 0.f;
            if (!producer) { inv = 1.0f / *LQ;
                if (map == 1) { const float f = inv * lamv;
#pragma unroll
                    for (int eb = 0; eb < 8; ++eb)
#pragma unroll
                        for (int i = 0; i < 16; ++i) X[(eb * 16 + i) * 64] = o[eb][i] * f; } }
            __syncthreads();
            if (!producer && map == 0) {
                float ssq = 0.f;
#pragma unroll
                for (int eb = 0; eb < 8; ++eb)
#pragma unroll
                    for (int i = 0; i < 16; ++i) { const float d = o[eb][i] * inv - X[(eb * 16 + i) * 64]; o[eb][i] = d; ssq += d * d; }
                ssq = hsum(ssq);
                const float rs = 1.0f / sqrtf(ssq * (1.0f / 256.0f) + EPS);
                const unsigned ovoff = (unsigned)((32 * rg + (lane2 & 31)) * LDH + 4 * hh2) * 2u; const int osoff = ((rowbase + c * 64) * LDH + h * 256) * 2;
                const LAS float* sg = (const LAS float*)(L + SUBG_OFF) + 4 * hh2;
#pragma unroll
                for (int eb = 0; eb < 8; ++eb)
#pragma unroll
                    for (int g = 0; g < 4; ++g) { const f32x4 gg = *(const LAS f32x4*)(sg + 32 * eb + 8 * g);
                        v2u wv; wv.x = pk2(o[eb][4 * g + 0] * rs * gg.x, o[eb][4 * g + 1] * rs * gg.y); wv.y = pk2(o[eb][4 * g + 2] * rs * gg.z, o[eb][4 * g + 3] * rs * gg.w);
                        __builtin_amdgcn_raw_buffer_store_b64(wv, rs_ao, ovoff, osoff + (32 * eb + 8 * g) * 2, 0); }
            }
            __syncthreads();
        }
    }
}

namespace ret {
typedef short bf16x8 __attribute__((ext_vector_type(8)));
typedef short s16x4 __attribute__((ext_vector_type(4)));
typedef float f32x16 __attribute__((ext_vector_type(16)));
constexpr int TS = 1040, TILE = 32 * TS, VS = 1088, VTILE = 8 * VS, PS = 272, PTILE = 32 * PS, SG = 264, SPLANE = 64 * SG, STILE = 2 * SPLANE;
constexpr int QB_OFF = 0, KB_OFF = TILE, VB_OFF = 3 * TILE, ST_OFF = VB_OFF + 2 * VTILE, P_OFF = ST_OFF + STILE, END_OFF = P_OFF + PTILE;
static_assert(END_OFF <= MISC_OFF && ST_OFF % 16 == 0 && P_OFF % 16 == 0, "retention LDS map");
__device__ __forceinline__ s16x4 vtr(const LAS char* p) { return __builtin_bit_cast(s16x4, __builtin_amdgcn_ds_read_tr16_b64_v4i16((LAS s16x4*)p)); }
}
#define RET_BAR0() asm volatile("s_waitcnt vmcnt(0) lgkmcnt(0)\n\ts_barrier" ::: "memory")
#define RET_BAR1() asm volatile("s_waitcnt lgkmcnt(0)\n\ts_barrier" ::: "memory")
__device__ __forceinline__ void ret_phase(Frame& F, const bf16* proj, bf16* ro) {
    using namespace ret;
    __builtin_amdgcn_s_waitcnt(0x0F70);
    LAS char* L = (LAS char*)F.lds;
    const int lane = F.lane, r = lane & 31, hh = lane >> 5, w = F.wave;
    const int q4 = (lane & 15) >> 2, p4 = lane & 3, blk = (lane >> 4) & 1;
    const v4u sd_proj = make_srd(proj, (unsigned)(48 * PJT * 2));
    const v4u sd_ro = make_srd(ro, (unsigned)(M * LDR * 2));
    const unsigned lo_qk = (unsigned)((lane >> 5) * 32 * 512 + (lane & 31) * 16);
    const unsigned lo_v = (unsigned)((lane >> 3) * 8 * 512 + (lane & 7) * 16);
    const int jb = w & 1, ib = (w >> 1) & 1, eb = w & 1;
    const int rb = r * TS + hh * 16;
    const int ktr_l = (8 * hh + q4) * TS + 32 * blk + 8 * p4 + 64 * w;
    const int vtr_l = q4 * VS + hh * 128 + 32 * blk + 8 * p4;
    const int str_l = ST_OFF + 2 * hh * SG + q4 * 64 + 32 * blk + 8 * p4;
    const int stw_l = ST_OFF + (8 * w + (r >> 2)) * SG + (r & 3) * 64 + 8 * hh;
    const int pw_l = P_OFF + r * PS + 8 * hh, pr_l = P_OFF + r * PS + 16 * hh;
    const int vsc_l = w * VS + lane * 16;
    for (int it = blockIdx.x; it < NB * 8 * 8; it += F.G) {
        const int sl = (it >> 3) & 7, bh_ = ((it & 7) << 2) | (it >> 6), h = bh_ & 7, b = bh_ >> 3;
        const int rowbase = b * SEQ;
        const float lg2 = log2f(1.0f - exp2f(-5.0f - (float)h));
        const float g64 = exp2f(lg2 * 64.0f);
        float Dk[16];
#pragma unroll
        for (int i = 0; i < 16; ++i) { const int jj = 32 * jb + (i & 3) + 8 * (i >> 2) + 4 * hh, dj = (32 * ib + r) - jj; Dk[i] = exp2f(lg2 * (float)((dj < 0 ? -dj : dj) + jj - 64)); }
        const float qdec = exp2f(lg2 * (float)(32 * ib + r));
        const float vdec = exp2f(lg2 * (float)(64 - (w + 8 * (lane >> 3))));
        f32x16 acc[2];
#pragma unroll
        for (int e2 = 0; e2 < 2; ++e2)
#pragma unroll
            for (int i = 0; i < 16; ++i) acc[e2][i] = 0.f;
        const int qtile_b = (int)(((size_t)h * PJT + (size_t)rowbase * 256) * 2), ktile_b = (int)(((size_t)(8 + h) * PJT + (size_t)rowbase * 256) * 2),
                  vtile_b = (int)(((size_t)(16 + 2 * h + (sl >> 2)) * PJT + (size_t)rowbase * 256 + (sl & 3) * 64) * 2);
        const unsigned ovoff = (unsigned)((32 * ib + r) * LDR + 4 * hh) * 2u;
#define RET_ISSUE_QK(tile_b, n, bufoff) do { _Pragma("unroll") for (int i_ = 0; i_ < 4; ++i_) { const int pc_ = 4 * w + i_; \
        dma16(sd_proj, lo_qk, (tile_b) + ((n) * 64 + pc_) * 512, (LAS void*)(L + (bufoff) + pc_ * TS)); } } while (0)
#define RET_ISSUE_V(n, bufoff) dma16(sd_proj, lo_v, vtile_b + ((n) * 64 + w) * 512, (LAS void*)(L + (bufoff) + w * VS))
#define RET_ST_WRITE() do { _Pragma("unroll") for (int e2_ = 0; e2_ < 2; ++e2_) _Pragma("unroll") for (int g_ = 0; g_ < 4; ++g_) { v2u sv_; \
            sv_.x = pk2(acc[e2_][4 * g_ + 0], acc[e2_][4 * g_ + 1]); sv_.y = pk2(acc[e2_][4 * g_ + 2], acc[e2_][4 * g_ + 3]); *(LAS v2u*)(L + stw_l + e2_ * SPLANE + 16 * g_) = sv_; } } while (0)
        RET_BAR0();
        RET_ISSUE_QK(qtile_b, 0, QB_OFF); RET_ISSUE_QK(ktile_b, 0, KB_OFF); RET_ISSUE_V(0, VB_OFF);
        v4u qr[4];
#define RET_QLOAD(n) do { const int n_ = (n) < 64 ? (n) : 63; _Pragma("unroll") for (int i_ = 0; i_ < 4; ++i_) qr[i_] = bload16(sd_proj, lo_qk, qtile_b + (n_ * 64 + 4 * w + i_) * 512); } while (0)
        RET_QLOAD(1);
        RET_ST_WRITE();
        for (int n = 0; n < 64; ++n) {
            if (w >= 4 && n > 0) asm volatile("s_waitcnt vmcnt(8) lgkmcnt(0)\n\ts_barrier" ::: "memory"); else asm volatile("s_waitcnt vmcnt(4) lgkmcnt(0)\n\ts_barrier" ::: "memory");
            const int kb_off = KB_OFF + (n & 1) * TILE, vb_off = VB_OFF + (n & 1) * VTILE;
            const int n1 = n + 1 < 64 ? n + 1 : 63;
#define RET_ISSUE_PIECE(j) do { if ((j) < 4) dma16(sd_proj, lo_qk, ktile_b + (n1 * 64 + 4 * w + (j)) * 512, (LAS void*)(L + KB_OFF + ((n + 1) & 1) * TILE + (4 * w + (j)) * TS)); \
                                else RET_ISSUE_V(n1, VB_OFF + ((n + 1) & 1) * VTILE); } while (0)
            {
                LAS v4u* vp = (LAS v4u*)(L + vb_off + vsc_l);
                const v4u vv = *vp;
                acc[0] = acc[0] * g64; acc[1] = acc[1] * g64;
                v4u vo; vo.x = pk2(bflo(vv.x) * vdec, bfhi(vv.x) * vdec); vo.y = pk2(bflo(vv.y) * vdec, bfhi(vv.y) * vdec); vo.z = pk2(bflo(vv.z) * vdec, bfhi(vv.z) * vdec); vo.w = pk2(bflo(vv.w) * vdec, bfhi(vv.w) * vdec);
                *vp = vo;
            }
            f32x16 t;
#pragma unroll
            for (int j = 0; j < 5; ++j) RET_ISSUE_PIECE(j);
            if (w < 4) {
                const unsigned ap_ = (unsigned)(uintptr_t)(L + kb_off + rb + jb * 512), bp_ = (unsigned)(uintptr_t)(L + QB_OFF + rb + ib * 512);
                asm volatile("s_nop 4\n\tds_read_b128 v[200:203], %[a] offset:0\n\tds_read_b128 v[204:207], %[b] offset:0\n\tds_read_b128 v[208:211], %[a] offset:32\n\tds_read_b128 v[212:215], %[b] offset:32\n\tds_read_b128 v[216:219], %[a] offset:64\n\tds_read_b128 v[220:223], %[b] offset:64\n\tds_read_b128 v[224:227], %[a] offset:96\n\tds_read_b128 v[228:231], %[b] offset:96\n\tds_read_b128 v[232:235], %[a] offset:128\n\tds_read_b128 v[236:239], %[b] offset:128\n\ts_waitcnt lgkmcnt(8)\n\tv_mfma_f32_32x32x16_bf16 %[t], v[200:203], v[204:207], 0\n\tds_read_b128 v[200:203], %[a] offset:160\n\tds_read_b128 v[204:207], %[b] offset:160\n\ts_waitcnt lgkmcnt(8)\n\tv_mfma_f32_32x32x16_bf16 %[t], v[208:211], v[212:215], %[t]\n\tds_read_b128 v[208:211], %[a] offset:192\n\tds_read_b128 v[212:215], %[b] offset:192\n\ts_waitcnt lgkmcnt(8)\n\tv_mfma_f32_32x32x16_bf16 %[t], v[216:219], v[220:223], %[t]\n\tds_read_b128 v[216:219], %[a] offset:224\n\tds_read_b128 v[220:223], %[b] offset:224\n\ts_waitcnt lgkmcnt(8)\n\tv_mfma_f32_32x32x16_bf16 %[t], v[224:227], v[228:231], %[t]\n\tds_read_b128 v[224:227], %[a] offset:256\n\tds_read_b128 v[228:231], %[b] offset:256\n\ts_waitcnt lgkmcnt(8)\n\tv_mfma_f32_32x32x16_bf16 %[t], v[232:235], v[236:239], %[t]\n\tds_read_b128 v[232:235], %[a] offset:288\n\tds_read_b128 v[236:239], %[b] offset:288\n\ts_waitcnt lgkmcnt(8)\n\tv_mfma_f32_32x32x16_bf16 %[t], v[200:203], v[204:207], %[t]\n\tds_read_b128 v[200:203], %[a] offset:320\n\tds_read_b128 v[204:207], %[b] offset:320\n\ts_waitcnt lgkmcnt(8)\n\tv_mfma_f32_32x32x16_bf16 %[t], v[208:211], v[212:215], %[t]\n\tds_read_b128 v[208:211], %[a] offset:352\n\tds_read_b128 v[212:215], %[b] offset:352\n\ts_waitcnt lgkmcnt(8)\n\tv_mfma_f32_32x32x16_bf16 %[t], v[216:219], v[220:223], %[t]\n\tds_read_b128 v[216:219], %[a] offset:384\n\tds_read_b128 v[220:223], %[b] offset:384\n\ts_waitcnt lgkmcnt(8)\n\tv_mfma_f32_32x32x16_bf16 %[t], v[224:227], v[228:231], %[t]\n\tds_read_b128 v[224:227], %[a] offset:416\n\tds_read_b128 v[228:231], %[b] offset:416\n\ts_waitcnt lgkmcnt(8)\n\tv_mfma_f32_32x32x16_bf16 %[t], v[232:235], v[236:239], %[t]\n\tds_read_b128 v[232:235], %[a] offset:448\n\tds_read_b128 v[236:239], %[b] offset:448\n\ts_waitcnt lgkmcnt(8)\n\tv_mfma_f32_32x32x16_bf16 %[t], v[200:203], v[204:207], %[t]\n\tds_read_b128 v[200:203], %[a] offset:480\n\tds_read_b128 v[204:207], %[b] offset:480\n\ts_waitcnt lgkmcnt(8)\n\tv_mfma_f32_32x32x16_bf16 %[t], v[208:211], v[212:215], %[t]\n\ts_waitcnt lgkmcnt(6)\n\tv_mfma_f32_32x32x16_bf16 %[t], v[216:219], v[220:223], %[t]\n\ts_waitcnt lgkmcnt(4)\n\tv_mfma_f32_32x32x16_bf16 %[t], v[224:227], v[228:231], %[t]\n\ts_waitcnt lgkmcnt(2)\n\tv_mfma_f32_32x32x16_bf16 %[t], v[232:235], v[236:239], %[t]\n\ts_waitcnt lgkmcnt(0)\n\tv_mfma_f32_32x32x16_bf16 %[t], v[200:203], v[204:207], %[t]\n\ts_nop 15" : [t] "=&v"(t) : [a] "v"(ap_), [b] "v"(bp_) : "memory", "v200", "v201", "v202", "v203", "v204", "v205", "v206", "v207", "v208", "v209", "v210", "v211", "v212", "v213", "v214", "v215", "v216", "v217", "v218", "v219", "v220", "v221", "v222", "v223", "v224", "v225", "v226", "v227", "v228", "v229", "v230", "v231", "v232", "v233", "v234", "v235", "v236", "v237", "v238", "v239");
#pragma unroll
                for (int g = 0; g < 4; ++g) { v2u wv; wv.x = pk2(t[4 * g + 0] * Dk[4 * g + 0], t[4 * g + 1] * Dk[4 * g + 1]); wv.y = pk2(t[4 * g + 2] * Dk[4 * g + 2], t[4 * g + 3] * Dk[4 * g + 3]);
                    *(LAS v2u*)(L + pw_l + ib * 128 + jb * 64 + 16 * g) = wv; }
            } else {
                const unsigned ap_ = (unsigned)(uintptr_t)(L + str_l + eb * SPLANE), bp_ = (unsigned)(uintptr_t)(L + QB_OFF + rb + ib * 512);
                asm volatile("s_nop 4\n\tds_read_b64_tr_b16 v[200:201], %[a] offset:0\n\tds_read_b64_tr_b16 v[202:203], %[a] offset:264\n\tds_read_b128 v[204:207], %[b] offset:0\n\tds_read_b64_tr_b16 v[208:209], %[a] offset:1056\n\tds_read_b64_tr_b16 v[210:211], %[a] offset:1320\n\tds_read_b128 v[212:215], %[b] offset:32\n\tds_read_b64_tr_b16 v[216:217], %[a] offset:2112\n\tds_read_b64_tr_b16 v[218:219], %[a] offset:2376\n\tds_read_b128 v[220:223], %[b] offset:64\n\tds_read_b64_tr_b16 v[224:225], %[a] offset:3168\n\tds_read_b64_tr_b16 v[226:227], %[a] offset:3432\n\tds_read_b128 v[228:231], %[b] offset:96\n\tds_read_b64_tr_b16 v[232:233], %[a] offset:4224\n\tds_read_b64_tr_b16 v[234:235], %[a] offset:4488\n\tds_read_b128 v[236:239], %[b] offset:128\n\ts_waitcnt lgkmcnt(12)\n\tv_mfma_f32_32x32x16_bf16 %[t], v[200:203], v[204:207], 0\n\tds_read_b64_tr_b16 v[200:201], %[a] offset:5280\n\tds_read_b64_tr_b16 v[202:203], %[a] offset:5544\n\tds_read_b128 v[204:207], %[b] offset:160\n\ts_waitcnt lgkmcnt(12)\n\tv_mfma_f32_32x32x16_bf16 %[t], v[208:211], v[212:215], %[t]\n\tds_read_b64_tr_b16 v[208:209], %[a] offset:6336\n\tds_read_b64_tr_b16 v[210:211], %[a] offset:6600\n\tds_read_b128 v[212:215], %[b] offset:192\n\ts_waitcnt lgkmcnt(12)\n\tv_mfma_f32_32x32x16_bf16 %[t], v[216:219], v[220:223], %[t]\n\tds_read_b64_tr_b16 v[216:217], %[a] offset:7392\n\tds_read_b64_tr_b16 v[218:219], %[a] offset:7656\n\tds_read_b128 v[220:223], %[b] offset:224\n\ts_waitcnt lgkmcnt(12)\n\tv_mfma_f32_32x32x16_bf16 %[t], v[224:227], v[228:231], %[t]\n\tds_read_b64_tr_b16 v[224:225], %[a] offset:8448\n\tds_read_b64_tr_b16 v[226:227], %[a] offset:8712\n\tds_read_b128 v[228:231], %[b] offset:256\n\ts_waitcnt lgkmcnt(12)\n\tv_mfma_f32_32x32x16_bf16 %[t], v[232:235], v[236:239], %[t]\n\tds_read_b64_tr_b16 v[232:233], %[a] offset:9504\n\tds_read_b64_tr_b16 v[234:235], %[a] offset:9768\n\tds_read_b128 v[236:239], %[b] offset:288\n\ts_waitcnt lgkmcnt(12)\n\tv_mfma_f32_32x32x16_bf16 %[t], v[200:203], v[204:207], %[t]\n\tds_read_b64_tr_b16 v[200:201], %[a] offset:10560\n\tds_read_b64_tr_b16 v[202:203], %[a] offset:10824\n\tds_read_b128 v[204:207], %[b] offset:320\n\ts_waitcnt lgkmcnt(12)\n\tv_mfma_f32_32x32x16_bf16 %[t], v[208:211], v[212:215], %[t]\n\tds_read_b64_tr_b16 v[208:209], %[a] offset:11616\n\tds_read_b64_tr_b16 v[210:211], %[a] offset:11880\n\tds_read_b128 v[212:215], %[b] offset:352\n\ts_waitcnt lgkmcnt(12)\n\tv_mfma_f32_32x32x16_bf16 %[t], v[216:219], v[220:223], %[t]\n\tds_read_b64_tr_b16 v[216:217], %[a] offset:12672\n\tds_read_b64_tr_b16 v[218:219], %[a] offset:12936\n\tds_read_b128 v[220:223], %[b] offset:384\n\ts_waitcnt lgkmcnt(12)\n\tv_mfma_f32_32x32x16_bf16 %[t], v[224:227], v[228:231], %[t]\n\tds_read_b64_tr_b16 v[224:225], %[a] offset:13728\n\tds_read_b64_tr_b16 v[226:227], %[a] offset:13992\n\tds_read_b128 v[228:231], %[b] offset:416\n\ts_waitcnt lgkmcnt(12)\n\tv_mfma_f32_32x32x16_bf16 %[t], v[232:235], v[236:239], %[t]\n\tds_read_b64_tr_b16 v[232:233], %[a] offset:14784\n\tds_read_b64_tr_b16 v[234:235], %[a] offset:15048\n\tds_read_b128 v[236:239], %[b] offset:448\n\ts_waitcnt lgkmcnt(12)\n\tv_mfma_f32_32x32x16_bf16 %[t], v[200:203], v[204:207], %[t]\n\tds_read_b64_tr_b16 v[200:201], %[a] offset:15840\n\tds_read_b64_tr_b16 v[202:203], %[a] offset:16104\n\tds_read_b128 v[204:207], %[b] offset:480\n\ts_waitcnt lgkmcnt(12)\n\tv_mfma_f32_32x32x16_bf16 %[t], v[208:211], v[212:215], %[t]\n\ts_waitcnt lgkmcnt(9)\n\tv_mfma_f32_32x32x16_bf16 %[t], v[216:219], v[220:223], %[t]\n\ts_waitcnt lgkmcnt(6)\n\tv_mfma_f32_32x32x16_bf16 %[t], v[224:227], v[228:231], %[t]\n\ts_waitcnt lgkmcnt(3)\n\tv_mfma_f32_32x32x16_bf16 %[t], v[232:235], v[236:239], %[t]\n\ts_waitcnt lgkmcnt(0)\n\tv_mfma_f32_32x32x16_bf16 %[t], v[200:203], v[204:207], %[t]\n\ts_nop 15" : [t] "=&v"(t) : [a] "v"(ap_), [b] "v"(bp_) : "memory", "v200", "v201", "v202", "v203", "v204", "v205", "v206", "v207", "v208", "v209", "v210", "v211", "v212", "v213", "v214", "v215", "v216", "v217", "v218", "v219", "v220", "v221", "v222", "v223", "v224", "v225", "v226", "v227", "v228", "v229", "v230", "v231", "v232", "v233", "v234", "v235", "v236", "v237", "v238", "v239");
                t = t * qdec;
            }
            RET_BAR1();
            asm volatile("s_waitcnt vmcnt(5)" : "+v"(qr[0]), "+v"(qr[1]), "+v"(qr[2]), "+v"(qr[3]) :: "memory");
#pragma unroll
            for (int i = 0; i < 4; ++i) *(LAS v4u*)(L + QB_OFF + (4 * w + i) * TS + lane * 16) = qr[i];
            const int n2 = n + 2 < 64 ? n + 2 : 63;
            if (w >= 4) {
                { const unsigned va_ = (unsigned)(uintptr_t)(L + vb_off + vtr_l + eb * 64), pa_ = (unsigned)(uintptr_t)(L + pr_l + ib * 128);
                  asm volatile("s_nop 4\n\tds_read_b64_tr_b16 v[200:201], %[v] offset:0\n\tds_read_b64_tr_b16 v[202:203], %[v] offset:4352\n\tds_read_b128 v[204:207], %[p] offset:0\n\tds_read_b64_tr_b16 v[208:209], %[v] offset:256\n\tds_read_b64_tr_b16 v[210:211], %[v] offset:4608\n\tds_read_b128 v[212:215], %[p] offset:32\n\tds_read_b64_tr_b16 v[216:217], %[v] offset:512\n\tds_read_b64_tr_b16 v[218:219], %[v] offset:4864\n\tds_read_b128 v[220:223], %[p] offset:64\n\tds_read_b64_tr_b16 v[224:225], %[v] offset:768\n\tds_read_b64_tr_b16 v[226:227], %[v] offset:5120\n\tds_read_b128 v[228:231], %[p] offset:96\n\ts_waitcnt lgkmcnt(9)\n\tv_mfma_f32_32x32x16_bf16 %[t], v[200:203], v[204:207], %[t]\n\ts_waitcnt lgkmcnt(6)\n\tv_mfma_f32_32x32x16_bf16 %[t], v[208:211], v[212:215], %[t]\n\ts_waitcnt lgkmcnt(3)\n\tv_mfma_f32_32x32x16_bf16 %[t], v[216:219], v[220:223], %[t]\n\ts_waitcnt lgkmcnt(0)\n\tv_mfma_f32_32x32x16_bf16 %[t], v[224:227], v[228:231], %[t]\n\ts_nop 15" : [t] "+v"(t) : [v] "v"(va_), [p] "v"(pa_) : "memory", "v200", "v201", "v202", "v203", "v204", "v205", "v206", "v207", "v208", "v209", "v210", "v211", "v212", "v213", "v214", "v215", "v216", "v217", "v218", "v219", "v220", "v221", "v222", "v223", "v224", "v225", "v226", "v227", "v228", "v229", "v230", "v231"); }
                const int osoff = ((rowbase + 64 * n) * LDR + h * 512 + sl * 64 + 32 * eb) * 2;
#pragma unroll
                for (int g = 0; g < 4; ++g) { v2u wv; wv.x = pk2(t[4 * g + 0], t[4 * g + 1]); wv.y = pk2(t[4 * g + 2], t[4 * g + 3]);
                    bstore8(sd_ro, wv, ovoff, osoff + 16 * g); }
            }
#pragma unroll
            for (int ks = 0; ks < 4; ++ks) qr[ks] = bload16(sd_proj, lo_qk, qtile_b + (n2 * 64 + 4 * w + ks) * 512);
            { const unsigned ka_ = (unsigned)(uintptr_t)(L + kb_off + ktr_l), va_ = (unsigned)(uintptr_t)(L + vb_off + vtr_l);
              asm volatile("s_nop 4\n\tds_read_b64_tr_b16 v[200:201], %[k] offset:0\n\tds_read_b64_tr_b16 v[202:203], %[k] offset:4160\n\tds_read_b64_tr_b16 v[204:205], %[v] offset:0\n\tds_read_b64_tr_b16 v[206:207], %[v] offset:4352\n\tds_read_b64_tr_b16 v[208:209], %[v] offset:64\n\tds_read_b64_tr_b16 v[210:211], %[v] offset:4416\n\tds_read_b64_tr_b16 v[212:213], %[k] offset:16640\n\tds_read_b64_tr_b16 v[214:215], %[k] offset:20800\n\tds_read_b64_tr_b16 v[216:217], %[v] offset:256\n\tds_read_b64_tr_b16 v[218:219], %[v] offset:4608\n\tds_read_b64_tr_b16 v[220:221], %[v] offset:320\n\tds_read_b64_tr_b16 v[222:223], %[v] offset:4672\n\ts_waitcnt lgkmcnt(6)\n\tv_mfma_f32_32x32x16_bf16 %[c0], v[204:207], v[200:203], %[c0]\n\tv_mfma_f32_32x32x16_bf16 %[c1], v[208:211], v[200:203], %[c1]\n\tds_read_b64_tr_b16 v[224:225], %[k] offset:512\n\tds_read_b64_tr_b16 v[226:227], %[k] offset:4672\n\tds_read_b64_tr_b16 v[228:229], %[v] offset:512\n\tds_read_b64_tr_b16 v[230:231], %[v] offset:4864\n\tds_read_b64_tr_b16 v[232:233], %[v] offset:576\n\tds_read_b64_tr_b16 v[234:235], %[v] offset:4928\n\ts_waitcnt lgkmcnt(6)\n\tv_mfma_f32_32x32x16_bf16 %[c0], v[216:219], v[212:215], %[c0]\n\tv_mfma_f32_32x32x16_bf16 %[c1], v[220:223], v[212:215], %[c1]\n\tds_read_b64_tr_b16 v[200:201], %[k] offset:17152\n\tds_read_b64_tr_b16 v[202:203], %[k] offset:21312\n\tds_read_b64_tr_b16 v[204:205], %[v] offset:768\n\tds_read_b64_tr_b16 v[206:207], %[v] offset:5120\n\tds_read_b64_tr_b16 v[208:209], %[v] offset:832\n\tds_read_b64_tr_b16 v[210:211], %[v] offset:5184\n\ts_waitcnt lgkmcnt(6)\n\tv_mfma_f32_32x32x16_bf16 %[c0], v[228:231], v[224:227], %[c0]\n\tv_mfma_f32_32x32x16_bf16 %[c1], v[232:235], v[224:227], %[c1]\n\ts_waitcnt lgkmcnt(0)\n\tv_mfma_f32_32x32x16_bf16 %[c0], v[204:207], v[200:203], %[c0]\n\tv_mfma_f32_32x32x16_bf16 %[c1], v[208:211], v[200:203], %[c1]\n\ts_nop 15" : [c0] "+v"(acc[0]), [c1] "+v"(acc[1]) : [k] "v"(ka_), [v] "v"(va_) : "memory", "v200", "v201", "v202", "v203", "v204", "v205", "v206", "v207", "v208", "v209", "v210", "v211", "v212", "v213", "v214", "v215", "v216", "v217", "v218", "v219", "v220", "v221", "v222", "v223", "v224", "v225", "v226", "v227", "v228", "v229", "v230", "v231", "v232", "v233", "v234", "v235"); }
            RET_ST_WRITE();
        }
#undef RET_ST_WRITE
#undef RET_ISSUE_V
#undef RET_ISSUE_QK
#undef RET_QLOAD
#undef RET_ISSUE_PIECE
    }
    RET_BAR0();
}

__device__ __forceinline__ void retfin_phase(Frame& F, const bf16* ro, const bf16* proj, const float* gn, bf16* rg) {
    const int gw = blockIdx.x * NWAVES + F.wave, NGW = F.G * NWAVES;
    const f32x4 g0 = *(const f32x4*)(gn + F.lane * 8), g1 = *(const f32x4*)(gn + F.lane * 8 + 4);
    for (int m = gw; m < M; m += NGW) {
        v4u ov[8], gv[8];
#pragma unroll
        for (int h = 0; h < 8; ++h) { ov[h] = *(const v4u*)(ro + (size_t)m * LDR + h * 512 + F.lane * 8); gv[h] = *(const v4u*)(proj + (size_t)(32 + 2 * h + (F.lane >> 5)) * PJT + (size_t)m * 256 + (F.lane & 31) * 8); }
#pragma unroll
        for (int h = 0; h < 8; ++h) {
            float x[8] = {bflo(ov[h].x), bfhi(ov[h].x), bflo(ov[h].y), bfhi(ov[h].y), bflo(ov[h].z), bfhi(ov[h].z), bflo(ov[h].w), bfhi(ov[h].w)};
            const float gt[8] = {bflo(gv[h].x), bfhi(gv[h].x), bflo(gv[h].y), bfhi(gv[h].y), bflo(gv[h].z), bfhi(gv[h].z), bflo(gv[h].w), bfhi(gv[h].w)};
            float s = 0.f;
#pragma unroll
            for (int k = 0; k < 8; ++k) s += x[k];
            const float mu = wave_sum(s) * (1.0f / 512.0f); float q = 0.f;
#pragma unroll
            for (int k = 0; k < 8; ++k) { x[k] -= mu; q += x[k] * x[k]; }
            const float rstd = 1.0f / sqrtf(wave_sum(q) * (1.0f / 512.0f) + EPS);
            v4u w; w.x = pk2(x[0] * rstd * g0.x * gt[0], x[1] * rstd * g0.y * gt[1]); w.y = pk2(x[2] * rstd * g0.z * gt[2], x[3] * rstd * g0.w * gt[3]);
            w.z = pk2(x[4] * rstd * g1.x * gt[4], x[5] * rstd * g1.y * gt[5]); w.w = pk2(x[6] * rstd * g1.z * gt[6], x[7] * rstd * g1.w * gt[7]);
            *(v4u*)(rg + (size_t)m * LDR + h * 512 + F.lane * 8) = w;
        }
    }
}

constexpr int NPH = 18;
struct Args { const float* in[15]; float* out; unsigned char* ws; int ph_lo, ph_hi; };
static_assert(sizeof(Args) == 17 * 8 + 8, "Args has no padding");
__global__ void __launch_bounds__(NWAVES * 64, 2) mk_fwd(Args args) {
    extern __shared__ __attribute__((aligned(16))) unsigned char lds[];
    Frame F;
    F.lds = (LAS unsigned char*)lds;
    F.MISC = (volatile LAS unsigned*)(F.lds + MISC_OFF);
    F.tid = threadIdx.x; F.lane = F.tid & 63; F.wave = __builtin_amdgcn_readfirstlane(F.tid >> 6);
    F.G = gridDim.x;
    unsigned char* ws = args.ws;
    F.ctl = (gu32*)(ws + WS_CTL);
    if (F.tid < 64) F.MISC[F.tid] = 0u;
    __syncthreads();
    XcdBarrier bar; bar.bar = (unsigned*)(F.ctl + CW_BAR); bar.x = 0; bar.st = nullptr;
    if (MK_ONE_LAUNCH) bar = xcd_barrier_post((unsigned*)(F.ctl + CW_BAR), F.MISC + 8);
    const int lo = args.ph_lo, hi = args.ph_hi;
#define IN(k) (lo <= (k) && (k) < hi)
#define SEAM(k) do { if (IN(k) && IN((k) + 1)) xcd_barrier(bar); } while (0)
    const float* x_in = args.in[0]; const float* c_in = args.in[1]; const float* ada_w = args.in[2]; const float* ada_b = args.in[3]; const float* norm_g = args.in[4];
    const float* da_lambda = args.in[8]; const float* da_subln = args.in[9]; const float* ret_gn = args.in[12]; const float* final_g = args.in[14];
    float* xres = args.out;
    unsigned short* XH = (unsigned short*)(ws + WS_XH);
    float* mod = (float*)(ws + WS_MOD);
    bf16* Hb = (bf16*)(ws + WS_H); bf16* BIG = (bf16*)(ws + WS_BIG); bf16* AO = (bf16*)(ws + WS_AO); bf16* RO = (bf16*)(ws + WS_RO);
    LAS unsigned char* glds = F.lds + RING_OFF;

    if (IN(0)) {
        mod_phase(F, c_in, ada_w, ada_b, mod);
        WPtrs P{args.in[5], args.in[6], args.in[7], args.in[10], args.in[11], args.in[13], ws};
        convert_phase(F, P);
    }
    SEAM(0);
    if (IN(1)) pre_phase(F, x_in, norm_g, mod, ws);
    SEAM(1);
    float* gsm = (float*)(ws + WS_GSM); float* biasv = (float*)(ws + WS_BIAS); float* ssq = (float*)(ws + WS_SSQ);
    float* PART = (float*)(ws + WS_AO - 2 * MiB);
#define GATE_OF(s) (mod + (size_t)((s) / 3) * NB * NMOD + (3 * ((s) % 3) + 2) * DM)
#define FFN_BLOCK(PH, f, s, XIN, NEXT, SN, FIRST) \
    if (IN(PH)) { pg8::Gemm g{Hb, (const bf16*)(ws + WS_WIN + (f) * WIN_BYTES), M, FF2, DM, LDH, LDH, 1}; pg8::StaticOrder S; S.init(M, FF2, F.G, (int)blockIdx.x); if ((s) != 0) ssq_local(F, S, PART, ssq + (size_t)(s) * M); \
        pg8::EpiSwiglu E{BIG, LDF, ssq + (size_t)(s) * M, biasv + (size_t)(s) * NB * BIASP, BIASP}; pg8::gemm_phase<pg8::EpiSwiglu, pg8::StaticOrder, PG8_ALIGN, PG8_SP2>(glds, g, S, E); } \
    SEAM(PH); \
    if (IN((PH) + 1)) { pg8::Gemm g{BIG, (const bf16*)(ws + WS_WOUT + (f) * WOUT_BYTES), M, DM, FF, LDF, LDF, 1}; pg8::StaticOrder S; S.init(M, DM, F.G, (int)blockIdx.x); \
        pg8::EpiResid<NEXT, FIRST> E{(XIN), XH, GATE_OF(s), Hb, gsm + (size_t)(SN) * NB * DM, PART, NMOD, LDH, 0.5f, 0}; \
        pg8::gemm_phase<pg8::EpiResid<NEXT, FIRST>, pg8::StaticOrder, PG8_ALIGN, PG8_SP2>(glds, g, S, E); } \
    SEAM((PH) + 1);

    FFN_BLOCK(2, 0, 0, x_in, true, 1, true)
    if (IN(4)) { pg8::Gemm g{Hb, (const bf16*)(ws + WS_WQKV), M, NQKV, DM, LDH, LDH, 1}; pg8::StaticOrder S; S.init(M, NQKV, F.G, (int)blockIdx.x); ssq_local(F, S, PART, ssq + (size_t)1 * M);
        pg8::EpiProj<0> E{BIG, LDQ, QSCALE, ssq + (size_t)1 * M, biasv + (size_t)1 * NB * BIASP, BIASP}; pg8::gemm_phase<pg8::EpiProj<0>, pg8::StaticOrder, PG8_ALIGN, PG8_SP2>(glds, g, S, E); }
    SEAM(4);
    if (IN(5)) { att_kmax_phase(F, BIG, (unsigned*)(ws + WS_KMAX)); xcd_barrier(bar); att_pc_phase(F, BIG, AO, da_lambda, da_subln, (const float*)(ws + WS_KMAX)); }
    SEAM(5);
    if (IN(6)) { pg8::Gemm g{AO, (const bf16*)(ws + WS_WODA), M, DM, DM, LDH, LDH, 0}; pg8::StaticOrder S; S.init(M, DM, F.G, (int)blockIdx.x);
        pg8::EpiResid<true, false> E{XH, XH, GATE_OF(1), Hb, gsm + (size_t)2 * NB * DM, PART, NMOD, LDH, 1.0f, 0};
        pg8::gemm_phase<pg8::EpiResid<true, false>, pg8::StaticOrder, PG8_ALIGN, PG8_SP2>(glds, g, S, E); }
    SEAM(6);
    FFN_BLOCK(7, 1, 2, XH, true, 3, false)
    FFN_BLOCK(9, 2, 3, XH, true, 4, false)
    if (IN(11)) { pg8::Gemm g{Hb, (const bf16*)(ws + WS_WQKVG), M, NPROJ, DM, LDH, LDH, 1}; pg8::StaticOrder S; S.init(M, NPROJ, F.G, (int)blockIdx.x); ssq_local(F, S, PART, ssq + (size_t)4 * M);
        pg8::EpiProj<1> E{BIG, LDP, 1.0f, ssq + (size_t)4 * M, biasv + (size_t)4 * NB * BIASP, BIASP}; pg8::gemm_phase<pg8::EpiProj<1>, pg8::StaticOrder, PG8_ALIGN, PG8_SP2>(glds, g, S, E); }
    SEAM(11);
    if (IN(12)) ret_phase(F, BIG, RO);
    SEAM(12);
    if (IN(13)) retfin_phase(F, RO, BIG, ret_gn, AO);
    SEAM(13);
    if (IN(14)) { pg8::Gemm g{AO, (const bf16*)(ws + WS_WORET), M, DM, RVW, LDR, LDR, 0}; pg8::StaticOrder S; S.init(M, DM, F.G, (int)blockIdx.x);
        pg8::EpiResid<true, false> E{XH, XH, GATE_OF(4), Hb, gsm + (size_t)5 * NB * DM, PART, NMOD, LDH, 1.0f, 0};
        pg8::gemm_phase<pg8::EpiResid<true, false>, pg8::StaticOrder, PG8_ALIGN, PG8_SP2>(glds, g, S, E); }
    SEAM(14);
    FFN_BLOCK(15, 3, 5, XH, false, 0, false)
    if (IN(17)) final_phase(F, XH, xres, final_g);
#undef IN
#undef SEAM
#undef GATE_OF
#undef FFN_BLOCK
}

extern "C" void kernel_launch(void* const* d_in, const int* in_sizes, int n_in, void* d_out, int out_size, void* d_ws, size_t ws_size, hipStream_t stream) {
    static int grid = 0;
    if (grid == 0) {
        if (n_in != 15 || in_sizes[0] != M * DM || out_size != M * DM || ws_size < WS_END) { fprintf(stderr, "kernel_launch: unexpected shapes: n_in %d in0 %d out %d ws %zu (need %zu)\n", n_in, n_in > 0 ? in_sizes[0] : -1, out_size, ws_size, (size_t)WS_END); grid = -1; return; }
        int dev = 0, cus = 0, per_cu = 0;
        if (hipGetDevice(&dev) != hipSuccess || hipDeviceGetAttribute(&cus, hipDeviceAttributeMultiprocessorCount, dev) != hipSuccess) { fprintf(stderr, "kernel_launch: device query failed\n"); grid = -1; return; }
        if (hipFuncSetAttribute((const void*)mk_fwd, hipFuncAttributeMaxDynamicSharedMemorySize, LDS_BYTES) != hipSuccess) { fprintf(stderr, "kernel_launch: hipFuncSetAttribute failed\n"); grid = -1; return; }
        if (hipOccupancyMaxActiveBlocksPerMultiprocessor(&per_cu, (const void*)mk_fwd, NWAVES * 64, LDS_BYTES) != hipSuccess || per_cu < 1) fprintf(stderr, "kernel_launch: note: occupancy query reports %d workgroups per CU\n", per_cu);
        (void)hipGetLastError();
        grid = cus;
    }
    if (grid < 0) return;
    if (hipMemsetAsync((char*)d_ws + WS_CTL, 0, CTL_ZERO_BYTES, stream) != hipSuccess) { fprintf(stderr, "kernel_launch: memset failed\n"); return; }
    Args a{};
    for (int i = 0; i < 15; ++i) a.in[i] = (const float*)d_in[i];
    a.out = (float*)d_out; a.ws = (unsigned char*)d_ws;
#if MK_ONE_LAUNCH
    a.ph_lo = 0; a.ph_hi = NPH;
    hipLaunchKernelGGL(mk_fwd, dim3(grid), dim3(NWAVES * 64), LDS_BYTES, stream, a);
#else
    for (int p = 0; p < NPH; ++p) { a.ph_lo = p; a.ph_hi = p + 1; hipLaunchKernelGGL(mk_fwd, dim3(grid), dim3(NWAVES * 64), LDS_BYTES, stream, a); }
#endif
    const hipError_t le = hipPeekAtLastError();
    if (le != hipSuccess) fprintf(stderr, "kernel_launch: launch failed: %s\n", hipGetErrorName(le));
}
```

```cpp
#include <hip/hip_runtime.h>
#include <cstdio>
#include <cstdint>
#include <cmath>
namespace pg8 {
#define PG8_LAS __attribute__((address_space(3)))
typedef unsigned short bf16_t;
typedef short bf16x8 __attribute__((ext_vector_type(8)));
typedef float f32x4 __attribute__((ext_vector_type(4)));
typedef unsigned u32x4 __attribute__((ext_vector_type(4)));
constexpr int XS_PANEL = 32 * 16384 + 2048;
constexpr int BM = 256, BK = 64, HALF = 128, HTB = HALF * BK * 2  , STAGE_BYTES = 8 * HTB, NXCD = 8, WGM = 4;

__host__ __device__ __forceinline__ int lds_byte(int r, int c) { const int st = (r >> 4) * 2 + (c >> 5), rr = r & 15, cc = c & 31, ob = rr * 64 + cc * 2; return st * 1024 + (ob ^ (((ob >> 9) & 1) << 5)); }
__host__ __device__ __forceinline__ void stage_rc(int b, int& R, int& C) { const int st = b / 1024, sb = b % 1024, swz = sb ^ (((sb >> 9) & 1) << 5); R = (st >> 1) * 16 + swz / 64; C = (st & 1) * 32 + (swz % 64) / 2; }
__host__ __device__ __forceinline__ int perm32(int rho) { const int n = rho >> 4, i = rho & 15; return 8 * (i >> 2) + 4 * n + (i & 3); }

struct Unit { int pm, pn; };
struct Gemm { const bf16_t* A; const bf16_t* Bt; int M, N, K, lda, ldb, atiled; };

struct StaticOrder {
    int nM, nN, nwg, G, c;
    __host__ __device__ void init(int M, int N, int G_, int c_) { nM = M / BM; nN = N / BM; nwg = nM * nN; G = G_; c = c_; }
    __host__ __device__ bool next(int i, Unit& u) const {
        const long L = (long)i * G + c; if (L >= nwg) return false;
        int wgid = (int)L; { const int q = nwg / NXCD, r = nwg % NXCD, xcd = wgid % NXCD, off = wgid / NXCD; wgid = (xcd < r ? xcd * (q + 1) : r * (q + 1) + (xcd - r) * q) + off; }
        const int nig = WGM * nN, gid = wgid / nig, fm = gid * WGM, gsz = (nM - fm) < WGM ? (nM - fm) : WGM;
        u.pm = fm + ((wgid % nig) % gsz); u.pn = (wgid % nig) / gsz; return true;
    }
    __device__ __forceinline__ void a_ready(const Unit&) const {}
    __device__ __forceinline__ void done(const Unit&) const {}
};


typedef float f32x2 __attribute__((ext_vector_type(2)));
typedef __bf16 bf16x2_t __attribute__((ext_vector_type(2)));
__device__ __forceinline__ unsigned cvt_pk_bf16(float lo, float hi) { f32x2 v = {lo, hi}; bf16x2_t b = __builtin_convertvector(v, bf16x2_t); return __builtin_bit_cast(unsigned, b); }
__device__ __forceinline__ float silu_f(float a) { return a * __builtin_amdgcn_rcpf(1.0f + __builtin_amdgcn_exp2f(a * -1.4426950408889634f)); }

__device__ __forceinline__ float rstd_of(const float* ssq, int row) { return 1.0f / sqrtf(ssq[row] * (1.0f / 2048.0f) + 1e-5f); }
constexpr int FFH = 5632;
struct EpiSwiglu {
    static constexpr bool PERM = true, AFTER_DRAIN = false;
    bf16_t* O; int ldc; const float* ssq; const float* bias; int bpitch;
    __device__ __forceinline__ void operator()(const f32x4 (&acc)[2][2][4][2], const Unit& u, int wr, int wc, int fr, int fq) const {
        const int row0 = u.pm * BM + wr * 64 + fr, col0 = u.pn * HALF + wc * 32 + 8 * fq;
        const float* bb = bias + (size_t)(u.pm >> 4) * bpitch + u.pn * BM + wc * 32 + 8 * fq;
        const f32x4 bg0 = *(const f32x4*)bb, bg1 = *(const f32x4*)(bb + 4), bu0 = *(const f32x4*)(bb + HALF), bu1 = *(const f32x4*)(bb + HALF + 4);
        float rsv[8];
#pragma unroll
        for (int i = 0; i < 8; ++i) rsv[i] = ssq[row0 + (i >> 2) * HALF + (i & 3) * 16];
#pragma unroll
        for (int i = 0; i < 8; ++i) rsv[i] = 1.0f / sqrtf(rsv[i] * (1.0f / 2048.0f) + 1e-5f);
#pragma unroll
        for (int ai = 0; ai < 2; ++ai)
#pragma unroll
            for (int m = 0; m < 4; ++m) { const int row = row0 + ai * HALF + m * 16; const float rs = rsv[ai * 4 + m];
                bf16_t* rowp = O + (size_t)u.pm * ((size_t)(FFH / 64) * 16384 + 2048) + (size_t)(col0 >> 6) * 16384 + (size_t)(row & 255) * 64 + (col0 & 63);
                const f32x4 g0 = acc[ai][0][m][0] * rs + bg0, g1 = acc[ai][0][m][1] * rs + bg1, u0 = acc[ai][1][m][0] * rs + bu0, u1 = acc[ai][1][m][1] * rs + bu1;
                u32x4 w;
                w.x = cvt_pk_bf16(silu_f(g0[0]) * u0[0], silu_f(g0[1]) * u0[1]); w.y = cvt_pk_bf16(silu_f(g0[2]) * u0[2], silu_f(g0[3]) * u0[3]);
                w.z = cvt_pk_bf16(silu_f(g1[0]) * u1[0], silu_f(g1[1]) * u1[1]); w.w = cvt_pk_bf16(silu_f(g1[2]) * u1[2], silu_f(g1[3]) * u1[3]);
                *(u32x4*)rowp = w; }
    }
};
typedef _Float16 h16x2 __attribute__((ext_vector_type(2)));
__device__ __forceinline__ unsigned cvt_pk_f16(float lo, float hi) { f32x2 v = {lo, hi}; h16x2 h = __builtin_convertvector(v, h16x2); return __builtin_bit_cast(unsigned, h); }
__device__ __forceinline__ f32x2 unpk_f16(unsigned u) { return __builtin_convertvector(__builtin_bit_cast(h16x2, u), f32x2); }
template <bool NEXT, bool FIRST> struct EpiResid {
    static constexpr bool PERM = true, AFTER_DRAIN = false;
    const void* xin; unsigned short* xout; const float* gate; bf16_t* xs; const float* gsm; float* ssq; int gpitch, ldxs; float gs; int pad_;
    __device__ __forceinline__ void operator()(const f32x4 (&acc)[2][2][4][2], const Unit& u, int wr, int wc, int fr, int fq) const {
        const int row0 = u.pm * BM + wr * 64 + fr, col0 = u.pn * BM + wc * 32 + 8 * fq, b = u.pm >> 4;
        const float* gb = gate + (size_t)b * gpitch + col0;
        f32x4 gv[2][2], sm[2][2];
#pragma unroll
        for (int bj = 0; bj < 2; ++bj)
#pragma unroll
            for (int n = 0; n < 2; ++n) { gv[bj][n] = *(const f32x4*)(gb + bj * HALF + 4 * n) * gs; if (NEXT) sm[bj][n] = *(const f32x4*)(gsm + (size_t)b * 2048 + col0 + bj * HALF + 4 * n); }
        const size_t tile = ((size_t)u.pm * 8 + u.pn) * 65536 + (size_t)(wr * 64 + fr) * 256 + wc * 32 + 8 * fq;
        const unsigned short* hin = (const unsigned short*)xin + tile; unsigned short* hout = xout + tile;
        const float* fin = (const float*)xin + (size_t)row0 * 2048 + col0;
        bf16_t* xst = xs + (size_t)u.pm * XS_PANEL + (size_t)(4 * u.pn + (wc >> 1)) * 16384 + (size_t)(wr * 64 + fr) * 64 + (wc & 1) * 32 + 8 * fq;
        float sq[8];
        if (!FIRST) {
#pragma unroll
            for (int hb = 0; hb < 2; ++hb) {
                u32x4 hx[4][2];
#pragma unroll
                for (int k = 0; k < 4; ++k) { const int rg_ = hb * HALF + k * 16; hx[k][0] = *(const u32x4*)(hin + rg_ * 256); hx[k][1] = *(const u32x4*)(hin + rg_ * 256 + HALF); }
#pragma unroll
                for (int k = 0; k < 4; ++k) { const int it = hb * 4 + k, ai = hb, m = k, rg = ai * HALF + m * 16, row = row0 + rg; float s2 = 0.f;
#pragma unroll
                    for (int bj = 0; bj < 2; ++bj) { const u32x4 h_ = hx[k][bj]; const f32x2 a_ = unpk_f16(h_.x), b_ = unpk_f16(h_.y), c_ = unpk_f16(h_.z), d_ = unpk_f16(h_.w);
                        const f32x4 x0 = (f32x4){a_.x, a_.y, b_.x, b_.y} + gv[bj][0] * acc[ai][bj][m][0], x1 = (f32x4){c_.x, c_.y, d_.x, d_.y} + gv[bj][1] * acc[ai][bj][m][1];
                        u32x4 hw; hw.x = cvt_pk_f16(x0[0], x0[1]); hw.y = cvt_pk_f16(x0[2], x0[3]); hw.z = cvt_pk_f16(x1[0], x1[1]); hw.w = cvt_pk_f16(x1[2], x1[3]);
                        *(u32x4*)(hout + rg * 256 + bj * HALF) = hw;
                        if (NEXT) { s2 += (x0[0] * x0[0] + x0[1] * x0[1]) + (x0[2] * x0[2] + x0[3] * x0[3]) + (x1[0] * x1[0] + x1[1] * x1[1]) + (x1[2] * x1[2] + x1[3] * x1[3]);
                            const f32x4 y0 = x0 * sm[bj][0], y1 = x1 * sm[bj][1]; u32x4 w; w.x = cvt_pk_bf16(y0[0], y0[1]); w.y = cvt_pk_bf16(y0[2], y0[3]); w.z = cvt_pk_bf16(y1[0], y1[1]); w.w = cvt_pk_bf16(y1[2], y1[3]);
                            *(u32x4*)(xst + (size_t)(bj * 2) * 16384 + rg * 64) = w; } }
                    sq[it] = s2; }
            }
        } else {
            f32x4 xv[2][2][2];
#define ER_LOAD(it, buf) do { const int rg_ = ((it) >> 2) * HALF + ((it) & 3) * 16; const float* p_ = fin + (size_t)rg_ * 2048; \
                xv[buf][0][0] = *(const f32x4*)p_; xv[buf][0][1] = *(const f32x4*)(p_ + 4); xv[buf][1][0] = *(const f32x4*)(p_ + HALF); xv[buf][1][1] = *(const f32x4*)(p_ + HALF + 4); } while (0)
            ER_LOAD(0, 0);
#pragma unroll
            for (int it = 0; it < 8; ++it) { const int ai = it >> 2, m = it & 3, rg = ai * HALF + m * 16, row = row0 + rg; float s2 = 0.f;
                if (it + 1 < 8) ER_LOAD(it + 1, (it + 1) & 1);
#pragma unroll
                for (int bj = 0; bj < 2; ++bj) { const f32x4 x0 = xv[it & 1][bj][0] + gv[bj][0] * acc[ai][bj][m][0], x1 = xv[it & 1][bj][1] + gv[bj][1] * acc[ai][bj][m][1];
                    u32x4 hw; hw.x = cvt_pk_f16(x0[0], x0[1]); hw.y = cvt_pk_f16(x0[2], x0[3]); hw.z = cvt_pk_f16(x1[0], x1[1]); hw.w = cvt_pk_f16(x1[2], x1[3]);
                    *(u32x4*)(hout + rg * 256 + bj * HALF) = hw;
                    if (NEXT) { s2 += (x0[0] * x0[0] + x0[1] * x0[1]) + (x0[2] * x0[2] + x0[3] * x0[3]) + (x1[0] * x1[0] + x1[1] * x1[1]) + (x1[2] * x1[2] + x1[3] * x1[3]);
                        const f32x4 y0 = x0 * sm[bj][0], y1 = x1 * sm[bj][1]; u32x4 w; w.x = cvt_pk_bf16(y0[0], y0[1]); w.y = cvt_pk_bf16(y0[2], y0[3]); w.z = cvt_pk_bf16(y1[0], y1[1]); w.w = cvt_pk_bf16(y1[2], y1[3]);
                        *(u32x4*)(xst + (size_t)(bj * 2) * 16384 + rg * 64) = w; } }
                sq[it] = s2; }
#undef ER_LOAD
        }
        if (NEXT) {
#pragma unroll
            for (int it = 0; it < 8; ++it) { float s2 = sq[it]; s2 += __shfl_xor(s2, 16); s2 += __shfl_xor(s2, 32); if (fq == 0) ssq[(size_t)(u.pn * 4 + wc) * 16384 + row0 + (it >> 2) * HALF + (it & 3) * 16] = s2; }
        }
    }
};
template <int MODE> struct EpiProj {
    static constexpr bool PERM = true, AFTER_DRAIN = false;
    bf16_t* O; int ldc; float qscale; const float* ssq; const float* bias; int bpitch;
    __device__ __forceinline__ void operator()(const f32x4 (&acc)[2][2][4][2], const Unit& u, int wr, int wc, int fr, int fq) const {
        const int row0 = u.pm * BM + wr * 64 + fr, colt = u.pn * BM, col0 = colt + wc * 32 + 8 * fq;
        float sc = 1.f; bool act = false;
        if (MODE == 0) { if (colt < 2048) sc = qscale; }
        else { if (colt >= 2048 && colt < 4096) sc = 0.0625f; act = colt >= 8192; }
        const float* bb = bias + (size_t)(u.pm >> 4) * bpitch + col0;
        f32x4 bv[2][2];
#pragma unroll
        for (int bj = 0; bj < 2; ++bj)
#pragma unroll
            for (int n = 0; n < 2; ++n) bv[bj][n] = *(const f32x4*)(bb + bj * HALF + 4 * n);
        float rsv[8];
#pragma unroll
        for (int i = 0; i < 8; ++i) rsv[i] = ssq[row0 + (i >> 2) * HALF + (i & 3) * 16];
#pragma unroll
        for (int i = 0; i < 8; ++i) rsv[i] = 1.0f / sqrtf(rsv[i] * (1.0f / 2048.0f) + 1e-5f);
#pragma unroll
        for (int ai = 0; ai < 2; ++ai)
#pragma unroll
            for (int m = 0; m < 4; ++m) { const int row = row0 + ai * HALF + m * 16; bf16_t* rowp = O + (size_t)u.pn * ((size_t)16384 * 256) + (size_t)row * 256 + (col0 - colt); const float rs = rsv[ai * 4 + m];
#pragma unroll
                for (int bj = 0; bj < 2; ++bj) { f32x4 v0 = (acc[ai][bj][m][0] * rs + bv[bj][0]) * sc, v1 = (acc[ai][bj][m][1] * rs + bv[bj][1]) * sc;
                    if (MODE == 1 && act) {
#pragma unroll
                        for (int j = 0; j < 4; ++j) { v0[j] = silu_f(v0[j]); v1[j] = silu_f(v1[j]); } }
                    u32x4 w; w.x = cvt_pk_bf16(v0[0], v0[1]); w.y = cvt_pk_bf16(v0[2], v0[3]); w.z = cvt_pk_bf16(v1[0], v1[1]); w.w = cvt_pk_bf16(v1[2], v1[3]);
                    *(u32x4*)(rowp + bj * HALF) = w; } }
    }
};

template <class Epi, class Sched, bool ALIGN_EPI = false, bool SP2 = false>
__device__ __forceinline__ void gemm_phase(PG8_LAS unsigned char* lds, const Gemm g, const Sched& S, const Epi& E) {
    const int tid = threadIdx.x, wid = __builtin_amdgcn_readfirstlane(tid >> 6), lane = tid & 63, wr = wid >> 2, wc = wid & 3, fr = lane & 15, fq = lane >> 4;
    const int K = g.K, nt = K / BK;
    unsigned voffA[2], voffB[2];
#pragma unroll
    for (int i = 0; i < 2; ++i) { int R, C; stage_rc(tid * 16 + i * 8192, R, C); const int Rb = Epi::PERM ? ((R & ~31) + perm32(R & 31)) : R;
        voffA[i] = (unsigned)(R * (g.atiled ? 64 : g.lda) + C) * 2u; voffB[i] = (unsigned)(Rb * 64 + C) * 2u; }
    const size_t kstepB = (size_t)(BM * BK * 2), kstepA = g.atiled ? (size_t)(BM * BK * 2) : (size_t)(BK * 2);
    const size_t hstepA = g.atiled ? (size_t)(HALF * BK * 2) : (size_t)HALF * g.lda * 2, hstepB = (size_t)(HALF * BK * 2);
    const size_t tstepA = g.atiled ? ((size_t)(K / BK) * (BM * BK) + 2048) * 2 : 2 * hstepA, tstepB = ((size_t)(K / BK) * (BM * BK) + 2048) * 2;
    const unsigned ldsw = (unsigned)wid * 1024u;
    const int aoff = lds_byte(wr * 64 + fr, fq * 8), boff = lds_byte(wc * 32 + fr, fq * 8);
#define PG8_SA(b, h) (((b) * 2 + (h)) * HTB)
#define PG8_SB(b, h) ((4 + (b) * 2 + (h)) * HTB)
#define PG8_STAGE(bufoff, gbase, voff) do { _Pragma("unroll") for (int _i = 0; _i < 2; ++_i) \
        __builtin_amdgcn_global_load_lds((const unsigned*)((const char*)(gbase) + (voff)[_i]), (PG8_LAS unsigned*)(lds + (bufoff) + ldsw + _i * 8192), 16, 0, 0); } while (0)
#define PG8_LDA(dst, b, h) do { _Pragma("unroll") for (int m = 0; m < 4; ++m) _Pragma("unroll") for (int k = 0; k < 2; ++k) dst[m][k] = *(const PG8_LAS bf16x8*)(lds + PG8_SA(b, h) + aoff + m * 2048 + k * 1024); } while (0)
#define PG8_LDB(dst, b, h) do { _Pragma("unroll") for (int n = 0; n < 2; ++n) _Pragma("unroll") for (int k = 0; k < 2; ++k) dst[n][k] = *(const PG8_LAS bf16x8*)(lds + PG8_SB(b, h) + boff + n * 2048 + k * 1024); } while (0)
#define PG8_MMA(ai, bj, At, Bt) do { __builtin_amdgcn_s_setprio(1); _Pragma("unroll") for (int m = 0; m < 4; ++m) _Pragma("unroll") for (int n = 0; n < 2; ++n) _Pragma("unroll") for (int k = 0; k < 2; ++k) \
        acc[ai][bj][m][n] = __builtin_amdgcn_mfma_f32_16x16x32_bf16(Bt[n][k], At[m][k], acc[ai][bj][m][n], 0, 0, 0); __builtin_amdgcn_s_setprio(0); } while (0)
#define PG8_WAIT_V(n) asm volatile("s_waitcnt vmcnt(" #n ")" ::: "memory")
#define PG8_WAIT_L(n) asm volatile("s_waitcnt lgkmcnt(" #n ")" ::: "memory")
#define PG8_BAR __builtin_amdgcn_s_barrier()
#define PG8_SCHED __builtin_amdgcn_sched_barrier(0)
    Unit cur, nxt; int ui = 0;
    if (!S.next(0, cur)) return;
    f32x4 acc[2][2][4][2];
#pragma unroll
    for (int a = 0; a < 2; ++a)
#pragma unroll
        for (int b = 0; b < 2; ++b)
#pragma unroll
            for (int m = 0; m < 4; ++m)
#pragma unroll
                for (int n = 0; n < 2; ++n) acc[a][b][m][n] = (f32x4){0.f, 0.f, 0.f, 0.f};
    bf16x8 At[4][2], B0[2][2], B1[2][2];
    const char* cA = (const char*)g.A + (size_t)cur.pm * tstepA; const char* cB = (const char*)g.Bt + (size_t)cur.pn * tstepB;
    S.a_ready(cur);
    if constexpr (SP2) {
        PG8_STAGE(PG8_SB(0, 0), cB, voffB); PG8_STAGE(PG8_SB(0, 1), cB + hstepB, voffB); PG8_STAGE(PG8_SA(0, 0), cA, voffA); PG8_STAGE(PG8_SA(0, 1), cA + hstepA, voffA);
        if (wr == 1) PG8_BAR;
        PG8_WAIT_V(2); PG8_BAR;
        PG8_STAGE(PG8_SB(1, 0), cB + kstepB, voffB); PG8_STAGE(PG8_SA(1, 0), cA + kstepA, voffA); PG8_STAGE(PG8_SB(1, 1), cB + hstepB + kstepB, voffB);
        PG8_WAIT_V(6); PG8_BAR;
    } else {
        PG8_STAGE(PG8_SB(0, 0), cB, voffB); PG8_STAGE(PG8_SA(0, 0), cA, voffA); PG8_STAGE(PG8_SB(0, 1), cB + hstepB, voffB); PG8_STAGE(PG8_SA(0, 1), cA + hstepA, voffA);
        if (wr == 1) PG8_BAR;
        PG8_WAIT_V(4); PG8_BAR;
        PG8_STAGE(PG8_SB(1, 0), cB + kstepB, voffB); PG8_STAGE(PG8_SA(1, 0), cA + kstepA, voffA); PG8_STAGE(PG8_SB(1, 1), cB + hstepB + kstepB, voffB);
        PG8_WAIT_V(6); PG8_BAR;
    }
    for (;;) {
        const bool has_next = S.next(ui + 1, nxt);
        const char* nA = has_next ? (const char*)g.A + (size_t)nxt.pm * tstepA : cA; const char* nB = has_next ? (const char*)g.Bt + (size_t)nxt.pn * tstepB : cB;
        for (int t = 0; t < nt; t += 2) {
            const bool last = (t == nt - 2);
            const char* a1 = cA + (size_t)(t + 1) * kstepA;
            const char* a2 = last ? nA : cA + (size_t)(t + 2) * kstepA; const char* b2 = last ? nB : cB + (size_t)(t + 2) * kstepB;
            const char* a3 = a2 + kstepA; const char* b3 = b2 + kstepB;
            if (last && has_next) S.a_ready(nxt);
            if constexpr (SP2) {
            PG8_LDB(B0, 0, 0); PG8_LDB(B1, 0, 1); PG8_SCHED; PG8_LDA(At, 0, 0); PG8_STAGE(PG8_SA(1, 1), a1 + hstepA, voffA);
            PG8_WAIT_V(8); PG8_WAIT_L(0); PG8_BAR; PG8_MMA(0, 0, At, B0); PG8_MMA(0, 1, At, B1); PG8_BAR; PG8_SCHED;
            PG8_LDA(At, 0, 1); PG8_STAGE(PG8_SB(0, 0), b2, voffB); PG8_STAGE(PG8_SB(0, 1), b2 + hstepB, voffB); PG8_STAGE(PG8_SA(0, 0), a2, voffA);
            PG8_WAIT_V(8); PG8_WAIT_L(0); PG8_BAR; PG8_MMA(1, 0, At, B0); PG8_MMA(1, 1, At, B1); PG8_BAR; PG8_SCHED;
            PG8_LDB(B0, 1, 0); PG8_LDB(B1, 1, 1); PG8_SCHED; PG8_LDA(At, 1, 0); PG8_STAGE(PG8_SA(0, 1), a2 + hstepA, voffA);
            PG8_WAIT_V(8); PG8_WAIT_L(0); PG8_BAR; PG8_MMA(0, 0, At, B0); PG8_MMA(0, 1, At, B1); PG8_BAR; PG8_SCHED;
            PG8_LDA(At, 1, 1); PG8_STAGE(PG8_SB(1, 0), b3, voffB); PG8_STAGE(PG8_SB(1, 1), b3 + hstepB, voffB); PG8_STAGE(PG8_SA(1, 0), a3, voffA);
            PG8_WAIT_V(8); PG8_WAIT_L(0); PG8_BAR; PG8_MMA(1, 0, At, B0); PG8_MMA(1, 1, At, B1); PG8_BAR; PG8_SCHED;
            } else {
            PG8_LDB(B0, 0, 0); PG8_SCHED; PG8_LDA(At, 0, 0); PG8_STAGE(PG8_SA(1, 1), a1 + hstepA, voffA);
            PG8_WAIT_L(8); PG8_BAR; PG8_WAIT_L(0); PG8_MMA(0, 0, At, B0); PG8_BAR; PG8_SCHED;
            PG8_LDB(B1, 0, 1); PG8_STAGE(PG8_SB(0, 0), b2, voffB);
            PG8_BAR; PG8_WAIT_L(0); PG8_MMA(0, 1, At, B1); PG8_BAR;
            PG8_LDA(At, 0, 1); PG8_STAGE(PG8_SA(0, 0), a2, voffA);
            PG8_BAR; PG8_WAIT_L(0); PG8_MMA(1, 0, At, B0); PG8_BAR; PG8_SCHED;
            PG8_STAGE(PG8_SB(0, 1), b2 + hstepB, voffB);
            PG8_WAIT_V(6); PG8_BAR; PG8_MMA(1, 1, At, B1); PG8_BAR;
            PG8_LDB(B0, 1, 0); PG8_SCHED; PG8_LDA(At, 1, 0); PG8_STAGE(PG8_SA(0, 1), a2 + hstepA, voffA);
            PG8_WAIT_L(8); PG8_BAR; PG8_WAIT_L(0); PG8_MMA(0, 0, At, B0); PG8_BAR; PG8_SCHED;
            PG8_LDB(B1, 1, 1); PG8_STAGE(PG8_SB(1, 0), b3, voffB);
            PG8_BAR; PG8_WAIT_L(0); PG8_MMA(0, 1, At, B1); PG8_BAR;
            PG8_LDA(At, 1, 1); PG8_STAGE(PG8_SA(1, 0), a3, voffA);
            PG8_BAR; PG8_WAIT_L(0); PG8_MMA(1, 0, At, B0); PG8_BAR; PG8_SCHED;
            PG8_STAGE(PG8_SB(1, 1), b3 + hstepB, voffB);
            PG8_WAIT_V(6); PG8_BAR; PG8_MMA(1, 1, At, B1); PG8_BAR;
            }
        }
        if constexpr (ALIGN_EPI) { if (wr == 0) PG8_BAR; }
        if constexpr (!Epi::AFTER_DRAIN) { E(acc, cur, wr, wc, fr, fq); S.done(cur); }
        if (!has_next) break;
#pragma unroll
        for (int a = 0; a < 2; ++a)
#pragma unroll
            for (int b = 0; b < 2; ++b)
#pragma unroll
                for (int m = 0; m < 4; ++m)
#pragma unroll
                    for (int n = 0; n < 2; ++n) acc[a][b][m][n] = (f32x4){0.f, 0.f, 0.f, 0.f};
        cur = nxt; cA = nA; cB = nB; ++ui;
        if constexpr (ALIGN_EPI) { if (wr == 1) PG8_BAR; }
    }
    PG8_WAIT_V(0);
    if constexpr (!ALIGN_EPI) { if (wr == 0) PG8_BAR; }
    PG8_BAR;
    if constexpr (Epi::AFTER_DRAIN) { E.fused(acc, cur, wr, wc, fr, fq, lds, wid, lane); S.done(cur); }
#undef PG8_SA
#undef PG8_SB
#undef PG8_STAGE
#undef PG8_LDA
#undef PG8_LDB
#undef PG8_MMA
#undef PG8_WAIT_V
#undef PG8_WAIT_L
#undef PG8_BAR
#undef PG8_SCHED
}
}

#ifndef PG8_SP2
#define PG8_SP2 true
#endif
#ifndef PG8_ALIGN
#define PG8_ALIGN true
#endif
#ifndef MK_ONE_LAUNCH
#define MK_ONE_LAUNCH 1
#endif

constexpr int NWAVES = 8;
constexpr int DM = 2048, NB = 4, SEQ = 4096, M = NB * SEQ, FF = 5632, FF2 = 2 * FF;
constexpr int NMOD = 9 * DM;
constexpr int NQKV = 6144, NPROJ = 12288, RVW = 4096;
constexpr int PADE = 64;
constexpr int LDH = DM + PADE, LDF = FF + PADE, LDR = RVW + PADE, LDQ = NQKV + PADE, LDP = NPROJ + PADE;
constexpr size_t PJT = (size_t)M * 256;
constexpr float EPS = 1e-5f;
constexpr float LOG2E = 1.4426950408889634f;
constexpr float QSCALE = 0.08838834764831845f * LOG2E;
constexpr float LAMBDA_INIT0 = 0.2f;

constexpr size_t MiB = 1u << 20;
constexpr size_t WS_CTL = 0, CTL_ZERO_BYTES = 128 * 1024;
constexpr size_t WS_SSQ = 1 * MiB;
constexpr size_t WS_MOD = 2 * MiB;
constexpr size_t WS_GSM = 3 * MiB;
constexpr size_t WS_BIAS = 3 * MiB + 256 * 1024;
constexpr size_t WS_WIN = 6 * MiB, WIN_BYTES = (size_t)FF2 * LDH * 2;
constexpr size_t WS_WOUT = WS_WIN + 4 * WIN_BYTES, WOUT_BYTES = (size_t)DM * LDF * 2;
constexpr size_t WS_WQKV = WS_WOUT + 4 * WOUT_BYTES;
constexpr size_t WS_WODA = WS_WQKV + (size_t)NQKV * LDH * 2;
constexpr size_t WS_WQKVG = WS_WODA + (size_t)DM * LDH * 2;
constexpr size_t WS_WORET = WS_WQKVG + (size_t)NPROJ * LDH * 2;
constexpr size_t WS_H = WS_WORET + (size_t)DM * LDR * 2;
constexpr size_t WS_BIG = WS_H + (size_t)M * LDH * 2;
constexpr size_t WS_AO = WS_BIG + (size_t)M * LDP * 2;
constexpr size_t WS_RO = WS_AO + (size_t)M * LDR * 2;
constexpr size_t WS_XH = WS_RO + (size_t)M * LDR * 2;
constexpr size_t WS_END = WS_XH + (size_t)M * DM * 2;
static_assert(WS_END <= (size_t)1152 * MiB && WS_WIN % 256 == 0 && WIN_BYTES % 256 == 0 && WOUT_BYTES % 256 == 0 && WS_H % 256 == 0 && WS_BIG % 256 == 0 && WS_AO % 256 == 0 && WS_RO % 256 == 0, "ws map");
constexpr int CW_TMO = 0, CW_CODE = 1, CW_BAR = 4096;

constexpr int LDS_BYTES = 163840;
constexpr int MISC_OFF = LDS_BYTES - 256;
constexpr int RING_OFF = 0;

#define GAS __attribute__((address_space(1)))
#define LAS __attribute__((address_space(3)))
typedef unsigned short bf16;
typedef unsigned v4u __attribute__((ext_vector_type(4)));
typedef unsigned v2u __attribute__((ext_vector_type(2)));
typedef float f32x4 __attribute__((ext_vector_type(4)));
typedef GAS unsigned gu32;
#define RLX_AGENT __ATOMIC_RELAXED, __HIP_MEMORY_SCOPE_AGENT
#define LDS_WAIT() asm volatile("s_waitcnt lgkmcnt(0)" ::: "memory")
#define VM_WAIT() asm volatile("s_waitcnt vmcnt(0)" ::: "memory")
__device__ __forceinline__ unsigned pk2(float lo, float hi) { return pg8::cvt_pk_bf16(lo, hi); }
__device__ __forceinline__ float bflo(unsigned u) { return __uint_as_float(u << 16); }
__device__ __forceinline__ float bfhi(unsigned u) { return __uint_as_float(u & 0xffff0000u); }
__device__ __forceinline__ float bf2f(unsigned short b) { return __uint_as_float(((unsigned)b) << 16); }
__device__ __forceinline__ v4u make_srd(const void* base, unsigned nbytes) {
    const unsigned long long a = (unsigned long long)(uintptr_t)base;
    v4u d; d.x = __builtin_amdgcn_readfirstlane((unsigned)a); d.y = __builtin_amdgcn_readfirstlane((unsigned)(a >> 32) & 0xffffu); d.z = nbytes; d.w = 0x00020000u; return d;
}
__device__ __forceinline__ void bstore8(const v4u& srd, v2u data, unsigned voff, int soff) {
    asm volatile("buffer_store_dwordx2 %0, %1, %2, %3 offen" :: "v"(data), "v"(voff), "s"(srd), "s"(soff) : "memory");
}
__device__ __forceinline__ v4u bload16(const v4u& srd, unsigned voff, int soff) {
    v4u r; asm volatile("buffer_load_dwordx4 %0, %1, %2, %3 offen" : "=&v"(r) : "v"(voff), "s"(srd), "s"(soff) : "memory"); return r;
}
__device__ __forceinline__ void dma16(const v4u& srd, unsigned voff, int soff, LAS void* ldsp) {
    unsigned keep; const unsigned la = (unsigned)(uintptr_t)ldsp;
    asm volatile("s_mov_b32 %0, m0\n\ts_mov_b32 m0, %4\n\ts_nop 0\n\tbuffer_load_dwordx4 %1, %2, %3 offen lds\n\ts_mov_b32 m0, %0"
                 : "=&s"(keep) : "v"(voff), "s"(srd), "s"(soff), "s"(la) : "memory");
}

#define XB_TMO      128
#define XB_XCNT(j)  (256  + 64 * (j))
#define XB_XSUB(j)  (1280 + 64 * (j))
#define XB_XGEN(j)  (2304 + 64 * (j))
#define XB_TOP      3328
#define XB_TOPGEN   3392
#define XCD_BAR_WORDS 3456
#define XB_SPIN_CAP (1u << 18)

__device__ __forceinline__ unsigned xb_ld(unsigned* p)              { return __hip_atomic_load(p, __ATOMIC_RELAXED, __HIP_MEMORY_SCOPE_AGENT); }
__device__ __forceinline__ unsigned xb_add(unsigned* p, unsigned v) { return __hip_atomic_fetch_add(p, v, __ATOMIC_RELAXED, __HIP_MEMORY_SCOPE_AGENT); }
__device__ __forceinline__ unsigned xb_xcc_id() { return (unsigned)__builtin_amdgcn_s_getreg((3 << 11) | 20) & 0xFu; }
#define XB_SPIN(cond, bar) do { unsigned _sp = 0; while (cond) { __builtin_amdgcn_s_sleep(1); \
    if ((++_sp & 255u) == 0u) { if (xb_ld(&(bar)[XB_TMO])) break; if (_sp > XB_SPIN_CAP) { atomicAdd(&(bar)[XB_TMO], 1u); break; } } } } while (0)

struct XcdBarrier {
    unsigned* bar; unsigned x;
    volatile LAS unsigned* st;
};

__device__ __forceinline__ XcdBarrier xcd_barrier_post(unsigned* bar, volatile LAS unsigned* st) {
    XcdBarrier b; b.bar = bar; b.x = xb_xcc_id(); b.st = st;
    if (threadIdx.x == 0) (void)xb_add(&bar[XB_XCNT(b.x)], 1u);
    return b;
}
__device__ __forceinline__ void xcd_barrier_complete(unsigned* bar, unsigned x, unsigned& nloc, unsigned& nx) {
    const unsigned G = gridDim.x * gridDim.y * gridDim.z;
    unsigned sum, cnt, mine, sp = 0u;
    for (;;) {
        sum = 0u; cnt = 0u; mine = 0u;
#pragma unroll
        for (unsigned j = 0; j < 16; ++j) { const unsigned c = xb_ld(&bar[XB_XCNT(j)]); sum += c; cnt += (c > 0u) ? 1u : 0u; mine = (j == x) ? c : mine; }
        if (sum == G) break;
        __builtin_amdgcn_s_sleep(1);
        if ((++sp & 255u) == 0u) { if (xb_ld(&bar[XB_TMO])) break; if (sp > XB_SPIN_CAP) { atomicAdd(&bar[XB_TMO], 1u); break; } }
    }
    nloc = mine > 0u ? mine : 1u; nx = cnt > 0u ? cnt : 1u;
}

__device__ __forceinline__ void xcd_barrier(const XcdBarrier& b) {
    asm volatile("s_waitcnt vmcnt(0)" ::: "memory");
    __syncthreads();
    if (threadIdx.x == 0) {
        unsigned* bar = b.bar;
        __builtin_amdgcn_s_waitcnt(0);
        unsigned nloc = b.st[0], nx = b.st[1];
        if (nloc == 0u) { xcd_barrier_complete(bar, b.x, nloc, nx); b.st[0] = nloc; b.st[1] = nx; }
        const unsigned old = xb_add(&bar[XB_XSUB(b.x)], 1u);
        const unsigned gen = old / nloc;
        if (old + 1u == (gen + 1u) * nloc) {
            __builtin_amdgcn_fence(__ATOMIC_RELEASE, "agent");
            asm volatile("s_waitcnt vmcnt(0)" ::: "memory");
            const unsigned og = xb_add(&bar[XB_TOP], 1u);
            const unsigned tg = og / nx;
            if (og + 1u == (tg + 1u) * nx) xb_add(&bar[XB_TOPGEN], 1u);
            else XB_SPIN(xb_ld(&bar[XB_TOPGEN]) == tg, bar);
            __builtin_amdgcn_fence(__ATOMIC_ACQUIRE, "agent");
            xb_add(&bar[XB_XGEN(b.x)], 1u);
            asm volatile("s_waitcnt vmcnt(0)" ::: "memory");
        } else {
            XB_SPIN(xb_ld(&bar[XB_XGEN(b.x)]) == gen, bar);
            __builtin_amdgcn_fence(__ATOMIC_ACQUIRE, "agent");
            asm volatile("s_waitcnt vmcnt(0)" ::: "memory");
        }
    }
    __syncthreads();
}


struct Frame {
    LAS unsigned char* lds;
    volatile LAS unsigned* MISC;
    gu32* ctl;
    int tid, lane, wave, G;
};
__device__ __forceinline__ float wave_sum(float v) {
#pragma unroll
    for (int o = 1; o < 64; o <<= 1) v += __shfl_xor(v, o);
    return v;
}

__device__ __forceinline__ void mod_phase(Frame& F, const float* c, const float* ada_w, const float* ada_b, float* mod) {
    LAS float* cs = (LAS float*)F.lds;
    LAS float* red = (LAS float*)(F.lds + 32768);
    for (int i = F.tid; i < NB * DM; i += NWAVES * 64) { const float v = c[i]; cs[i] = v / (1.0f + __expf(-v)); }
    __syncthreads();
    const int cg = F.tid % 36, ks = F.tid / 36;
    for (int cb = blockIdx.x; cb < 256; cb += F.G) {
        const int layer = cb >> 7, col0 = (cb & 127) * 144;
        if (ks < 14) {
            const float* W = ada_w + (size_t)layer * DM * NMOD + col0 + cg * 4;
            f32x4 a0 = {0.f, 0.f, 0.f, 0.f}, a1 = a0, a2 = a0, a3 = a0;
#pragma unroll 4
            for (int k = ks; k < DM; k += 14) {
                const f32x4 w = *(const f32x4*)(W + (size_t)k * NMOD);
                a0 += w * cs[k]; a1 += w * cs[DM + k]; a2 += w * cs[2 * DM + k]; a3 += w * cs[3 * DM + k];
            }
            LAS f32x4* r = (LAS f32x4*)(red + (ks * 4) * 144 + cg * 4);
            r[0] = a0; r[36] = a1; r[72] = a2; r[108] = a3;
        }
        __syncthreads();
        for (int o = F.tid; o < 4 * 144; o += NWAVES * 64) {
            const int b = o / 144, cc = o % 144; float s = 0.f;
#pragma unroll
            for (int k2 = 0; k2 < 14; ++k2) s += red[(k2 * 4 + b) * 144 + cc];
            mod[(size_t)(layer * NB + b) * NMOD + col0 + cc] = s + ada_b[(size_t)layer * NMOD + col0 + cc];
        }
        __syncthreads();
    }
}
__device__ __forceinline__ size_t wt_off(int n, int k, int K) { return (size_t)(n >> 8) * ((size_t)(K >> 6) * 16384 + 2048) + (size_t)(k >> 6) * 16384 + (size_t)(n & 255) * 64 + (k & 63); }
constexpr int BIASP = 12288;
__device__ __forceinline__ void transpose_item(const float* W, int K, int N, bf16* WT, int ldk, int mode, LAS float* scr, int item, int lane, const float* shp, float* part) {
    const int nblk = N / 32, kb = item / nblk, nb = item % nblk, k0 = 64 * kb, n0 = 32 * nb;
#pragma unroll 8
    for (int i = 0; i < 32; ++i) { const int kk = 2 * i + (lane >> 5); scr[kk * 33 + (lane & 31)] = W[(size_t)(k0 + kk) * N + n0 + (lane & 31)]; }
    LDS_WAIT(); asm volatile("" ::: "memory");
    int r0 = n0;
    if (mode == 1) { const int up = n0 >= FF ? 1 : 0, j = n0 - up * FF; r0 = (j >> 7) * 256 + up * 128 + (j & 127); }
    const int c = lane & 7;
    f32x4 sa[4], sb[4];
    if (shp) {
#pragma unroll
        for (int b = 0; b < 4; ++b) { const float* q = shp + (size_t)b * NMOD + k0 + 8 * c; sa[b] = *(const f32x4*)q; sb[b] = *(const f32x4*)(q + 4); } }
#pragma unroll
    for (int j = 0; j < 4; ++j) { const int n = (lane >> 3) + 8 * j; const LAS float* s = scr + (8 * c) * 33 + n;
        v4u o; o.x = pk2(s[0 * 33], s[1 * 33]); o.y = pk2(s[2 * 33], s[3 * 33]); o.z = pk2(s[4 * 33], s[5 * 33]); o.w = pk2(s[6 * 33], s[7 * 33]);
        *(GAS v4u*)(WT + wt_off(r0 + n, k0 + 8 * c, K)) = o;
        if (shp) {
            const float w0 = bflo(o.x), w1 = bfhi(o.x), w2 = bflo(o.y), w3 = bfhi(o.y), w4 = bflo(o.z), w5 = bfhi(o.z), w6 = bflo(o.w), w7 = bfhi(o.w);
#pragma unroll
            for (int b = 0; b < 4; ++b) {
                float d = ((w0 * sa[b].x + w1 * sa[b].y) + (w2 * sa[b].z + w3 * sa[b].w)) + ((w4 * sb[b].x + w5 * sb[b].y) + (w6 * sb[b].z + w7 * sb[b].w));
                d += __shfl_xor(d, 1); d += __shfl_xor(d, 2); d += __shfl_xor(d, 4);
                if (c == 0) part[(size_t)(kb * 4 + b) * BIASP + r0 + n] = d; }
        } }
    LDS_WAIT(); asm volatile("" ::: "memory");
}
struct WPtrs { const float *w_in, *w_out, *w_qkv, *w_oda, *w_qkvg, *w_oret; unsigned char* ws; const float* mod; float* part; };
constexpr size_t PARTS = (size_t)32 * 4 * BIASP;
__device__ __forceinline__ void convert_phase(Frame& F, const WPtrs& P) {
    LAS float* scr = (LAS float*)(F.lds + F.wave * 16384);
    const int gw = blockIdx.x * NWAVES + F.wave, NGW = F.G * NWAVES;
    constexpr int I_IN = (DM / 64) * (FF2 / 32), I_OUT = (FF / 64) * (DM / 32), I_QKV = (DM / 64) * (NQKV / 32), I_ODA = (DM / 64) * (DM / 32), I_QKVG = (DM / 64) * (NPROJ / 32), I_ORET = (RVW / 64) * (DM / 32);
    constexpr int NITEMS = 4 * I_IN + 4 * I_OUT + I_QKV + I_ODA + I_QKVG + I_ORET;
    for (int it = gw; it < NITEMS; it += NGW) {
        int r = it;
        if (r < 4 * I_IN) { const int f = r / I_IN, sl_ = (f == 0) ? 0 : (f == 1) ? 2 : (f == 2) ? 3 : 5;
            transpose_item(P.w_in + (size_t)f * DM * FF2, DM, FF2, (bf16*)(P.ws + WS_WIN + f * WIN_BYTES), LDH, 1, scr, r % I_IN, F.lane, P.mod + (size_t)((sl_ / 3) * NB) * NMOD + (3 * (sl_ % 3)) * DM, P.part + sl_ * PARTS); continue; } r -= 4 * I_IN;
        if (r < 4 * I_OUT) { const int f = r / I_OUT; transpose_item(P.w_out + (size_t)f * FF * DM, FF, DM, (bf16*)(P.ws + WS_WOUT + f * WOUT_BYTES), LDF, 0, scr, r % I_OUT, F.lane, nullptr, nullptr); continue; } r -= 4 * I_OUT;
        if (r < I_QKV) { transpose_item(P.w_qkv, DM, NQKV, (bf16*)(P.ws + WS_WQKV), LDH, 0, scr, r, F.lane, P.mod + (size_t)(0 * NB) * NMOD + 3 * DM, P.part + 1 * PARTS); continue; } r -= I_QKV;
        if (r < I_ODA) { transpose_item(P.w_oda, DM, DM, (bf16*)(P.ws + WS_WODA), LDH, 0, scr, r, F.lane, nullptr, nullptr); continue; } r -= I_ODA;
        if (r < I_QKVG) { transpose_item(P.w_qkvg, DM, NPROJ, (bf16*)(P.ws + WS_WQKVG), LDH, 0, scr, r, F.lane, P.mod + (size_t)(1 * NB) * NMOD + 3 * DM, P.part + 4 * PARTS); continue; } r -= I_QKVG;
        transpose_item(P.w_oret, RVW, DM, (bf16*)(P.ws + WS_WORET), LDR, 0, scr, r, F.lane, nullptr, nullptr);
    }
}
__device__ __forceinline__ void pre_phase(Frame& F, const float* A_x_in, const float* A_norm_g, const float* A_mod, unsigned char* A_ws) {
    float* gsm = (float*)(A_ws + WS_GSM); float* bias = (float*)(A_ws + WS_BIAS); float* ssq = (float*)(A_ws + WS_SSQ); bf16* Hb = (bf16*)(A_ws + WS_H);
    const int gw = blockIdx.x * NWAVES + F.wave, NGW = F.G * NWAVES;
    for (int i = blockIdx.x * (NWAVES * 64) + F.tid; i < 6 * NB * DM; i += F.G * NWAVES * 64) {
        const int s = i / (NB * DM), b = (i / DM) % NB, col = i % DM, layer = s / 3, j = s % 3;
        gsm[i] = A_norm_g[(size_t)s * DM + col] * (1.0f + A_mod[(size_t)(layer * NB + b) * NMOD + (3 * j + 1) * DM + col]);
    }
    for (int m = gw; m < M; m += NGW) {
        const int b = m >> 12;
        const f32x4* sc4 = (const f32x4*)(A_mod + (size_t)b * NMOD + DM); const f32x4* g4 = (const f32x4*)A_norm_g;
        const f32x4* xr = (const f32x4*)(A_x_in + (size_t)m * DM);
        f32x4 v[8]; float ss = 0.f;
#pragma unroll
        for (int j = 0; j < 8; ++j) { v[j] = xr[F.lane + 64 * j]; ss += (v[j].x * v[j].x + v[j].y * v[j].y) + (v[j].z * v[j].z + v[j].w * v[j].w); }
        ss = wave_sum(ss);
        if (F.lane == 0) ssq[m] = ss;
        bf16* o = Hb + (size_t)(m >> 8) * pg8::XS_PANEL + (size_t)(m & 255) * 64;
#pragma unroll
        for (int j = 0; j < 8; ++j) { const int c4 = F.lane + 64 * j, col = 4 * c4; const f32x4 y = v[j] * (g4[c4] * (sc4[c4] + 1.0f));
            v2u w; w.x = pk2(y.x, y.y); w.y = pk2(y.z, y.w); *(v2u*)(o + (size_t)(col >> 6) * 16384 + (col & 63)) = w; }
    }
    const float* part = (const float*)(A_ws + WS_BIG);
    for (int i = blockIdx.x * (NWAVES * 64) + F.tid; i < 6 * NB * BIASP; i += F.G * NWAVES * 64) {
        const int n = i % BIASP, sb_ = i / BIASP, s = sb_ >> 2, b = sb_ & 3, N = (s == 1) ? NQKV : (s == 4) ? NPROJ : FF2;
        if (n < N) { const float* pp = part + (size_t)s * PARTS + (size_t)b * BIASP + n; float a = 0.f;
#pragma unroll 8
            for (int kb = 0; kb < 32; ++kb) a += pp[(size_t)kb * 4 * BIASP];
            bias[i] = a; }
    }
}
__device__ __forceinline__ void ssq_reduce(Frame& F, const float* part, float* ssq) {
    for (int row = blockIdx.x * (NWAVES * 64) + F.tid; row < M; row += F.G * NWAVES * 64) { float s = 0.f;
#pragma unroll
        for (int k = 0; k < 32; ++k) s += part[(size_t)k * M + row];
        ssq[row] = s; }
}
__device__ __forceinline__ void ssq_pair(Frame& F, const float* part, float* ssq, int pa, int pb) {
    const int pm = (F.tid < 256) ? pa : pb;
    if (pm >= 0) { const int row = pm * 256 + (F.tid & 255); float s = 0.f;
#pragma unroll
        for (int k = 0; k < 32; ++k) s += part[(size_t)k * M + row];
        ssq[row] = s; }
}
template <class Sched> __device__ __forceinline__ void ssq_local(Frame& F, const Sched& S, const float* part, float* ssq) {
    int p0 = -1, p1 = -1; pg8::Unit u;
    for (int i = 0; S.next(i, u); ++i) {
        if (u.pm == p0 || u.pm == p1) continue;
        if (p0 < 0) p0 = u.pm; else if (p1 < 0) p1 = u.pm; else { ssq_pair(F, part, ssq, p0, p1); p0 = u.pm; p1 = -1; }
    }
    ssq_pair(F, part, ssq, p0, p1);
    asm volatile("s_waitcnt vmcnt(0)" ::: "memory");
    __syncthreads();
}
__device__ __forceinline__ void final_phase(Frame& F, const unsigned short* xh, float* out, const float* g) {
    const int gw = blockIdx.x * NWAVES + F.wave, NGW = F.G * NWAVES;
    for (int m = gw; m < M; m += NGW) {
        const unsigned short* xr = xh + (size_t)(m >> 8) * 8 * 65536 + (size_t)(m & 255) * 256 + 4 * F.lane;
        f32x4 v[8]; float ss = 0.f;
#pragma unroll
        for (int j = 0; j < 8; ++j) { const v2u h = *(const v2u*)(xr + (size_t)j * 65536); const pg8::f32x2 a = pg8::unpk_f16(h.x), c = pg8::unpk_f16(h.y);
            v[j] = (f32x4){a.x, a.y, c.x, c.y}; ss += (v[j].x * v[j].x + v[j].y * v[j].y) + (v[j].z * v[j].z + v[j].w * v[j].w); }
        const float rstd = 1.0f / sqrtf(wave_sum(ss) * (1.0f / DM) + EPS);
        f32x4* orow = (f32x4*)(out + (size_t)m * DM); const f32x4* g4 = (const f32x4*)g;
#pragma unroll
        for (int j = 0; j < 8; ++j) orow[F.lane + 64 * j] = (v[j] * rstd) * g4[F.lane + 64 * j];
    }
}

constexpr size_t WS_KMAX = 65536;
__device__ __forceinline__ void att_kmax_phase(Frame& F, const bf16* qkv, unsigned* kmax) {
    const int gw = blockIdx.x * NWAVES + F.wave, NGW = F.G * NWAVES;
    for (int r8 = gw; r8 < M / 8; r8 += NGW) {
        float mx = 0.f;
        for (int j = 0; j < 8; ++j) { const v4u* kp = (const v4u*)(qkv + (size_t)(8 + (F.lane >> 3)) * PJT + (size_t)(r8 * 8 + j) * 256 + 32 * (F.lane & 7)); float ss = 0.f;
#pragma unroll
            for (int u = 0; u < 4; ++u) { const v4u kk = kp[u];
                ss += bflo(kk.x) * bflo(kk.x) + bfhi(kk.x) * bfhi(kk.x) + bflo(kk.y) * bflo(kk.y) + bfhi(kk.y) * bfhi(kk.y) + bflo(kk.z) * bflo(kk.z) + bfhi(kk.z) * bfhi(kk.z) + bflo(kk.w) * bflo(kk.w) + bfhi(kk.w) * bfhi(kk.w); }
            ss += __shfl_xor(ss, 1); ss += __shfl_xor(ss, 2); mx = fmaxf(mx, ss); }
        if ((F.lane & 3) == 0) atomicMax(kmax + ((r8 * 8) >> 12) * 16 + (F.lane >> 2), __float_as_uint(mx));
    }
}
namespace attp {
typedef short bf16x8 __attribute__((ext_vector_type(8)));
typedef short s16x4 __attribute__((ext_vector_type(4)));
typedef float f32x16 __attribute__((ext_vector_type(16)));
constexpr int KTILE = 2 * 32 * 256;
constexpr int VSTR = 1088, VTILE = 16 * VSTR;
constexpr int PSTREAM = 2 * 1024 + 256 + 16;
constexpr int K_OFF = 0, V_OFF = 3 * KTILE, P_OFF = V_OFF + 4 * VTILE, LQ_OFF = P_OFF + 2 * 4 * PSTREAM, SUBG_OFF = LQ_OFF + 4 * 32 * 4, MARG_OFF = SUBG_OFF + 1024, END_OFF = MARG_OFF + 16;
static_assert(END_OFF <= MISC_OFF && 2 * 128 * 64 * 4 <= P_OFF, "attention LDS map");
__device__ __forceinline__ s16x4 vtr(const LAS char* p) { return __builtin_bit_cast(s16x4, __builtin_amdgcn_ds_read_tr16_b64_v4i16((LAS s16x4*)p)); }
__device__ __forceinline__ float hmax(float v) { auto rr = __builtin_amdgcn_permlane32_swap(__float_as_uint(v), __float_as_uint(v), false, false); return fmaxf(__uint_as_float(rr[0]), __uint_as_float(rr[1])); }
__device__ __forceinline__ float hsum(float v) { auto rr = __builtin_amdgcn_permlane32_swap(__float_as_uint(v), __float_as_uint(v), false, false); return __uint_as_float(rr[0]) + __uint_as_float(rr[1]); }
__device__ __forceinline__ bf16x8 pack8(const f32x16& p, int s) {
    v4u w; w.x = pg8::cvt_pk_bf16(p[8 * s + 0], p[8 * s + 1]); w.y = pg8::cvt_pk_bf16(p[8 * s + 2], p[8 * s + 3]); w.z = pg8::cvt_pk_bf16(p[8 * s + 4], p[8 * s + 5]); w.w = pg8::cvt_pk_bf16(p[8 * s + 6], p[8 * s + 7]);
    return __builtin_bit_cast(bf16x8, w);
}
}
__device__ __forceinline__ void att_pc_phase(Frame& F, const bf16* qkv, bf16* ao, const float* lam, const float* subg, const float* kmax) {
    using namespace attp;
    __builtin_amdgcn_s_waitcnt(0x0F70);
    LAS char* L = (LAS char*)F.lds;
    const int lane = F.lane, r = lane & 31, hh = lane >> 5, w = F.wave;
    const bool producer = w < 4; const int st = w & 3, map = st >> 1, rg = st & 1;
    if (w == 0) {
        const float s1 = wave_sum(lam[lane] * lam[128 + lane] + lam[64 + lane] * lam[192 + lane]);
        const float s2 = wave_sum(lam[256 + lane] * lam[384 + lane] + lam[320 + lane] * lam[448 + lane]);
        if (lane == 0) F.MISC[16] = __float_as_uint(expf(s1) - expf(s2) + LAMBDA_INIT0);
    }
    if (F.tid < 256) ((LAS float*)(L + SUBG_OFF))[F.tid] = subg[F.tid] * (1.0f - LAMBDA_INIT0);
    __syncthreads();
    const float lamv = __uint_as_float(F.MISC[16]);
    const int vcu = (F.G % 8 == 0) ? (int)(blockIdx.x & 7) * (F.G >> 3) + (int)(blockIdx.x >> 3) : (int)blockIdx.x;
    const unsigned ksrc_b = (unsigned)((lane >> 4) * 512 + (((lane & 15) ^ ((4 * (w & 3) + (lane >> 4)) & 15)) * 16));
    const unsigned vsrc_b = (unsigned)((lane >> 5) * 16 * 512 + (lane & 31) * 16);
    const unsigned qsrc_b = (unsigned)((32 * rg + r) * 256 + 8 * hh) * 2u;
    const __amdgpu_buffer_rsrc_t rs_qkv = __builtin_amdgcn_make_buffer_rsrc((void*)qkv, 0, (int)(24 * PJT * 2), 0x00020000);
    const __amdgpu_buffer_rsrc_t rs_ao = __builtin_amdgcn_make_buffer_rsrc((void*)ao, 0, M * LDH * 2, 0x00020000);
    const v4u sd_qkv = make_srd(qkv, (unsigned)(24 * PJT * 2));
    const unsigned kc16 = (unsigned)(16 * (hh ^ (r & 15)));
    const int kfrag_l = map * 8192 + r * 256;
    const int vfrag_l = (4 * hh + ((lane & 15) >> 2)) * VSTR + ((lane >> 4) & 1) * 32 + (lane & 3) * 8;
    const int pst_l = st * PSTREAM;
    for (int p = vcu; p < 1024; p += F.G) {
        const int pr = p & 31, b = (p >> 8) & 3, xs_ = (p >> 5) & 7, kr = (p >> 8) & 3, h = (kr == 0) ? xs_ : (kr == 1) ? 7 - xs_ : (kr == 2) ? (xs_ ^ 4) : 7 - (xs_ ^ 4);
        const int rowbase = b * SEQ;
        const float slope2 = exp2f(-(float)(h + 1)) * LOG2E;
        const int kbase_b = (int)(((size_t)(8 + h) * PJT + (size_t)rowbase * 256) * 2), vbase_b = (int)(((size_t)(16 + h) * PJT + (size_t)rowbase * 256) * 2);
        for (int half2 = 0; half2 < 2; ++half2) {
            const int c = half2 ? 63 - pr : pr;
            const int tq = c * 64 + 32 * rg + r;
            const int n32 = 2 * (c + 1);
            f32x16 o[8];
#define ATP_QF(ks) __builtin_bit_cast(bf16x8, (f32x4){o[(ks) >> 2][4 * ((ks) & 3)], o[(ks) >> 2][4 * ((ks) & 3) + 1], o[(ks) >> 2][4 * ((ks) & 3) + 2], o[(ks) >> 2][4 * ((ks) & 3) + 3]})
            float mrun = 0.f, lsum = 0.f; bool fresh = true;
            if (producer) { const int qoff = (int)(((size_t)h * PJT + (size_t)(rowbase + c * 64) * 256 + map * 128) * 2);
#pragma unroll
                for (int ks = 0; ks < 8; ++ks) { const f32x4 q4 = __builtin_bit_cast(f32x4, __builtin_amdgcn_raw_buffer_load_b128(rs_qkv, qsrc_b, qoff + 32 * ks, 0));
                    o[ks >> 2][4 * (ks & 3)] = q4[0]; o[ks >> 2][4 * (ks & 3) + 1] = q4[1]; o[ks >> 2][4 * (ks & 3) + 2] = q4[2]; o[ks >> 2][4 * (ks & 3) + 3] = q4[3]; } }
            else {
#pragma unroll
                for (int eb = 0; eb < 8; ++eb)
#pragma unroll
                    for (int i = 0; i < 16; ++i) o[eb][i] = 0.f; }
            float qnk = 0.f;
            if (producer) { float qq = 0.f;
#pragma unroll
                for (int e = 0; e < 32; ++e) { const unsigned u_ = __float_as_uint(o[e >> 4][e & 15]); qq += bflo(u_) * bflo(u_) + bfhi(u_) * bfhi(u_); }
                qnk = sqrtf(hsum(qq)) * sqrtf(kmax[b * 16 + h * 2 + map]) * 1.004f; }
            int nend = n32;
            __builtin_amdgcn_s_waitcnt(0x0F70);
#define ATP_ISSUE(kt32, ti) do { const int k0_ = (kt32) * 32; \
        _Pragma("unroll") for (int i_ = 0; i_ < 2; ++i_) { const int pc_ = (w & 3) + 4 * i_; \
            dma16(sd_qkv, ksrc_b, kbase_b + (k0_ + 4 * pc_) * 512 + (w >> 2) * 256, (LAS void*)(L + K_OFF + ((ti) % 3) * KTILE + (w >> 2) * 8192 + pc_ * 1024)); } \
        _Pragma("unroll") for (int i_ = 0; i_ < 2; ++i_) { const int pc_ = 2 * w + i_; \
            dma16(sd_qkv, vsrc_b, vbase_b + (k0_ + pc_) * 512, (LAS void*)(L + V_OFF + ((ti) & 3) * VTILE + pc_ * VSTR)); } } while (0)
            ATP_ISSUE(n32 - 1, 0); ATP_ISSUE(n32 - 2, 1);
            int issued = 2;
            for (int i = 0; i <= nend; ++i) {
                if (issued > i + 1) asm volatile("s_waitcnt vmcnt(4)" ::: "memory"); else VM_WAIT();
                __syncthreads();
                if (i == 2) { const LAS float* mg = (const LAS float*)(L + MARG_OFF); const float need = fmaxf(fmaxf(mg[0], mg[1]), fmaxf(mg[2], mg[3]));
                    const float xcut = (need + 161.0f) / (32.0f * slope2) + 1.97f; const int idead = (xcut < 4096.0f ? (int)xcut : 4096) + 2; nend = idead < n32 ? idead : n32; if (nend < 2) nend = 2; }
                if (i + 2 < nend) { ATP_ISSUE(n32 - 3 - i, i + 2); issued = i + 3; }
                if (producer) {
                    if (i < nend) {
                        const int kt32 = n32 - 1 - i;
                        const LAS char* Kb = L + K_OFF + (i % 3) * KTILE + kfrag_l;
                        f32x16 S;
                        const int j0 = kt32 * 32 + 4 * hh - tq;
                        if (kt32 < 2 * c) {
                            const float b0 = slope2 * (float)j0 - mrun, b1 = b0 + slope2, b2 = b1 + slope2, b3 = b2 + slope2, s8 = 8.0f * slope2, s16 = 16.0f * slope2, s24 = 24.0f * slope2;
                            S[0] = b0; S[1] = b1; S[2] = b2; S[3] = b3; S[4] = b0 + s8; S[5] = b1 + s8; S[6] = b2 + s8; S[7] = b3 + s8;
                            S[8] = b0 + s16; S[9] = b1 + s16; S[10] = b2 + s16; S[11] = b3 + s16; S[12] = b0 + s24; S[13] = b1 + s24; S[14] = b2 + s24; S[15] = b3 + s24;
                        } else {
#pragma unroll
                            for (int i_ = 0; i_ < 16; ++i_) S[i_] = fmaf(-slope2, fabsf((float)(j0 + ((i_ & 3) + 8 * (i_ >> 2)))), -mrun);
                        }
                        { const unsigned kb_ = (unsigned)(uintptr_t)Kb;
                          asm volatile("s_nop 4\n\tv_xor_b32 v220, 0, %[c]\n\tv_add_u32 v220, v220, %[b]\n\tds_read_b128 v[220:223], v220\n\tv_xor_b32 v224, 32, %[c]\n\tv_add_u32 v224, v224, %[b]\n\tds_read_b128 v[224:227], v224\n\tv_xor_b32 v228, 64, %[c]\n\tv_add_u32 v228, v228, %[b]\n\tds_read_b128 v[228:231], v228\n\tv_xor_b32 v232, 96, %[c]\n\tv_add_u32 v232, v232, %[b]\n\tds_read_b128 v[232:235], v232\n\tv_xor_b32 v236, 128, %[c]\n\tv_add_u32 v236, v236, %[b]\n\tds_read_b128 v[236:239], v236\n\tv_xor_b32 v240, 160, %[c]\n\tv_add_u32 v240, v240, %[b]\n\tds_read_b128 v[240:243], v240\n\tv_xor_b32 v244, 192, %[c]\n\tv_add_u32 v244, v244, %[b]\n\tds_read_b128 v[244:247], v244\n\tv_xor_b32 v248, 224, %[c]\n\tv_add_u32 v248, v248, %[b]\n\tds_read_b128 v[248:251], v248\n\ts_waitcnt lgkmcnt(7)\n\tv_mfma_f32_32x32x16_bf16 %[s], v[220:223], %[q0], %[s]\n\ts_waitcnt lgkmcnt(6)\n\tv_mfma_f32_32x32x16_bf16 %[s], v[224:227], %[q1], %[s]\n\ts_waitcnt lgkmcnt(5)\n\tv_mfma_f32_32x32x16_bf16 %[s], v[228:231], %[q2], %[s]\n\ts_waitcnt lgkmcnt(4)\n\tv_mfma_f32_32x32x16_bf16 %[s], v[232:235], %[q3], %[s]\n\ts_waitcnt lgkmcnt(3)\n\tv_mfma_f32_32x32x16_bf16 %[s], v[236:239], %[q4], %[s]\n\ts_waitcnt lgkmcnt(2)\n\tv_mfma_f32_32x32x16_bf16 %[s], v[240:243], %[q5], %[s]\n\ts_waitcnt lgkmcnt(1)\n\tv_mfma_f32_32x32x16_bf16 %[s], v[244:247], %[q6], %[s]\n\ts_waitcnt lgkmcnt(0)\n\tv_mfma_f32_32x32x16_bf16 %[s], v[248:251], %[q7], %[s]\n\ts_nop 15"
                              : [s] "+v"(S) : [b] "v"(kb_), [c] "v"(kc16), [q0] "v"(ATP_QF(0)), [q1] "v"(ATP_QF(1)), [q2] "v"(ATP_QF(2)), [q3] "v"(ATP_QF(3)), [q4] "v"(ATP_QF(4)), [q5] "v"(ATP_QF(5)), [q6] "v"(ATP_QF(6)), [q7] "v"(ATP_QF(7))
                              : "memory", "v220", "v221", "v222", "v223", "v224", "v225", "v226", "v227", "v228", "v229", "v230", "v231", "v232", "v233", "v234", "v235", "v236", "v237", "v238", "v239", "v240", "v241", "v242", "v243", "v244", "v245", "v246", "v247", "v248", "v249", "v250", "v251"); }
                        float mx = fmaxf(S[0], S[1]);
#pragma unroll
                        for (int i_ = 2; i_ < 16; ++i_) mx = fmaxf(mx, S[i_]);
                        const bool live = fresh || !__all(mx < -160.0f);
                        LAS char* pb = L + P_OFF + (i & 1) * (4 * PSTREAM) + pst_l;
                        float alpha = 1.0f;
                        if (live) {
                            mx = hmax(mx);
                            if (fresh || __any(mx > 8.0f)) { const float sh = fresh ? mx : fmaxf(mx, 0.0f);
#pragma unroll
                                for (int i_ = 0; i_ < 16; ++i_) S[i_] -= sh;
                                mrun += sh; if (!fresh) alpha = __builtin_amdgcn_exp2f(-sh); fresh = false; }
                            float ls = 0.f;
#pragma unroll
                            for (int i_ = 0; i_ < 16; ++i_) { S[i_] = __builtin_amdgcn_exp2f(S[i_]); ls += S[i_]; }
                            lsum = lsum * alpha + ls;
                            *(LAS bf16x8*)(pb + lane * 16) = pack8(S, 0); *(LAS bf16x8*)(pb + 1024 + lane * 16) = pack8(S, 1);
                            *(LAS float*)(pb + 2048 + lane * 4) = alpha;
                        }
                        if (lane == 0) *(LAS unsigned*)(pb + 2304) = live ? 1u : 0u;
                        if (i == 1) { float mg = qnk - mrun;
#pragma unroll
                            for (int o_ = 1; o_ < 64; o_ <<= 1) mg = fmaxf(mg, __shfl_xor(mg, o_));
                            if (lane == 0) ((LAS float*)(L + MARG_OFF))[st] = mg; }
                    }
                } else if (i >= 1) {
                    const LAS char* pb = L + P_OFF + ((i - 1) & 1) * (4 * PSTREAM) + pst_l;
                    const unsigned live = __builtin_amdgcn_readfirstlane(*(const LAS unsigned*)(pb + 2304));
                    if (live) {
                        const float alpha = *(const LAS float*)(pb + 2048 + lane * 4);
                        const bf16x8 pf0 = *(const LAS bf16x8*)(pb + lane * 16), pf1 = *(const LAS bf16x8*)(pb + 1024 + lane * 16);
                        if (__any(alpha != 1.0f)) {
#pragma unroll
                            for (int eb = 0; eb < 8; ++eb) o[eb] = o[eb] * alpha; }
                        { const unsigned va_ = (unsigned)(uintptr_t)(L + V_OFF + ((i - 1) & 3) * VTILE + vfrag_l);
                          asm volatile("s_nop 4\n\tds_read_b64_tr_b16 v[228:229], %[a] offset:0\n\tds_read_b64_tr_b16 v[230:231], %[a] offset:8704\n\tds_read_b64_tr_b16 v[232:233], %[a] offset:512\n\tds_read_b64_tr_b16 v[234:235], %[a] offset:9216\n\tds_read_b64_tr_b16 v[236:237], %[a] offset:64\n\tds_read_b64_tr_b16 v[238:239], %[a] offset:8768\n\tds_read_b64_tr_b16 v[240:241], %[a] offset:576\n\tds_read_b64_tr_b16 v[242:243], %[a] offset:9280\n\tds_read_b64_tr_b16 v[244:245], %[a] offset:128\n\tds_read_b64_tr_b16 v[246:247], %[a] offset:8832\n\tds_read_b64_tr_b16 v[248:249], %[a] offset:640\n\tds_read_b64_tr_b16 v[250:251], %[a] offset:9344\n\ts_waitcnt lgkmcnt(10)\n\tv_mfma_f32_32x32x16_bf16 %[o0], v[228:231], %[p0], %[o0]\n\tds_read_b64_tr_b16 v[228:229], %[a] offset:192\n\tds_read_b64_tr_b16 v[230:231], %[a] offset:8896\n\ts_waitcnt lgkmcnt(10)\n\tv_mfma_f32_32x32x16_bf16 %[o0], v[232:235], %[p1], %[o0]\n\tds_read_b64_tr_b16 v[232:233], %[a] offset:704\n\tds_read_b64_tr_b16 v[234:235], %[a] offset:9408\n\ts_waitcnt lgkmcnt(10)\n\tv_mfma_f32_32x32x16_bf16 %[o1], v[236:239], %[p0], %[o1]\n\tds_read_b64_tr_b16 v[236:237], %[a] offset:256\n\tds_read_b64_tr_b16 v[238:239], %[a] offset:8960\n\ts_waitcnt lgkmcnt(10)\n\tv_mfma_f32_32x32x16_bf16 %[o1], v[240:243], %[p1], %[o1]\n\tds_read_b64_tr_b16 v[240:241], %[a] offset:768\n\tds_read_b64_tr_b16 v[242:243], %[a] offset:9472\n\ts_waitcnt lgkmcnt(10)\n\tv_mfma_f32_32x32x16_bf16 %[o2], v[244:247], %[p0], %[o2]\n\tds_read_b64_tr_b16 v[244:245], %[a] offset:320\n\tds_read_b64_tr_b16 v[246:247], %[a] offset:9024\n\ts_waitcnt lgkmcnt(10)\n\tv_mfma_f32_32x32x16_bf16 %[o2], v[248:251], %[p1], %[o2]\n\tds_read_b64_tr_b16 v[248:249], %[a] offset:832\n\tds_read_b64_tr_b16 v[250:251], %[a] offset:9536\n\ts_waitcnt lgkmcnt(10)\n\tv_mfma_f32_32x32x16_bf16 %[o3], v[228:231], %[p0], %[o3]\n\tds_read_b64_tr_b16 v[228:229], %[a] offset:384\n\tds_read_b64_tr_b16 v[230:231], %[a] offset:9088\n\ts_waitcnt lgkmcnt(10)\n\tv_mfma_f32_32x32x16_bf16 %[o3], v[232:235], %[p1], %[o3]\n\tds_read_b64_tr_b16 v[232:233], %[a] offset:896\n\tds_read_b64_tr_b16 v[234:235], %[a] offset:9600\n\ts_waitcnt lgkmcnt(10)\n\tv_mfma_f32_32x32x16_bf16 %[o4], v[236:239], %[p0], %[o4]\n\tds_read_b64_tr_b16 v[236:237], %[a] offset:448\n\tds_read_b64_tr_b16 v[238:239], %[a] offset:9152\n\ts_waitcnt lgkmcnt(10)\n\tv_mfma_f32_32x32x16_bf16 %[o4], v[240:243], %[p1], %[o4]\n\tds_read_b64_tr_b16 v[240:241], %[a] offset:960\n\tds_read_b64_tr_b16 v[242:243], %[a] offset:9664\n\ts_waitcnt lgkmcnt(10)\n\tv_mfma_f32_32x32x16_bf16 %[o5], v[244:247], %[p0], %[o5]\n\ts_waitcnt lgkmcnt(8)\n\tv_mfma_f32_32x32x16_bf16 %[o5], v[248:251], %[p1], %[o5]\n\ts_waitcnt lgkmcnt(6)\n\tv_mfma_f32_32x32x16_bf16 %[o6], v[228:231], %[p0], %[o6]\n\ts_waitcnt lgkmcnt(4)\n\tv_mfma_f32_32x32x16_bf16 %[o6], v[232:235], %[p1], %[o6]\n\ts_waitcnt lgkmcnt(2)\n\tv_mfma_f32_32x32x16_bf16 %[o7], v[236:239], %[p0], %[o7]\n\ts_waitcnt lgkmcnt(0)\n\tv_mfma_f32_32x32x16_bf16 %[o7], v[240:243], %[p1], %[o7]\n\ts_nop 15"
                              : [o0] "+v"(o[0]), [o1] "+v"(o[1]), [o2] "+v"(o[2]), [o3] "+v"(o[3]), [o4] "+v"(o[4]), [o5] "+v"(o[5]), [o6] "+v"(o[6]), [o7] "+v"(o[7])
                              : [a] "v"(va_), [p0] "v"(pf0), [p1] "v"(pf1)
                              : "memory", "v228", "v229", "v230", "v231", "v232", "v233", "v234", "v235", "v236", "v237", "v238", "v239", "v240", "v241", "v242", "v243", "v244", "v245", "v246", "v247", "v248", "v249", "v250", "v251"); }
                    }
                }
            }
#undef ATP_ISSUE
#undef ATP_QF
            int lane2 = F.lane; asm volatile("" : "+v"(lane2));
            const int hh2 = lane2 >> 5;
            LAS float* LQ = (LAS float*)(L + LQ_OFF) + st * 32 + (lane2 & 31);
            if (producer) { const float lt = hsum(lsum); if (hh2 == 0) *LQ = lt; }
            VM_WAIT();
            __syncthreads();
            LAS float* X = (LAS float*)L + (rg * 128) * 64 + lane2;
            float inv = 0.f;
            if (!producer) { inv = 1.0f / *LQ;
                if (map == 1) { const float f = inv * lamv;
#pragma unroll
                    for (int eb = 0; eb < 8; ++eb)
#pragma unroll
                        for (int i = 0; i < 16; ++i) X[(eb * 16 + i) * 64] = o[eb][i] * f; } }
            __syncthreads();
            if (!producer && map == 0) {
                float ssq = 0.f;
#pragma unroll
                for (int eb = 0; eb < 8; ++eb)
#pragma unroll
                    for (int i = 0; i < 16; ++i) { const float d = o[eb][i] * inv - X[(eb * 16 + i) * 64]; o[eb][i] = d; ssq += d * d; }
                ssq = hsum(ssq);
                const float rs = 1.0f / sqrtf(ssq * (1.0f / 256.0f) + EPS);
                const unsigned ovoff = (unsigned)((32 * rg + (lane2 & 31)) * LDH + 4 * hh2) * 2u; const int osoff = ((rowbase + c * 64) * LDH + h * 256) * 2;
                const LAS float* sg = (const LAS float*)(L + SUBG_OFF) + 4 * hh2;
#pragma unroll
                for (int eb = 0; eb < 8; ++eb)
#pragma unroll
                    for (int g = 0; g < 4; ++g) { const f32x4 gg = *(const LAS f32x4*)(sg + 32 * eb + 8 * g);
                        v2u wv; wv.x = pk2(o[eb][4 * g + 0] * rs * gg.x, o[eb][4 * g + 1] * rs * gg.y); wv.y = pk2(o[eb][4 * g + 2] * rs * gg.z, o[eb][4 * g + 3] * rs * gg.w);
                        __builtin_amdgcn_raw_buffer_store_b64(wv, rs_ao, ovoff, osoff + (32 * eb + 8 * g) * 2, 0); }
            }
            __syncthreads();
        }
    }
}

namespace ret {
typedef short bf16x8 __attribute__((ext_vector_type(8)));
typedef short s16x4 __attribute__((ext_vector_type(4)));
typedef float f32x16 __attribute__((ext_vector_type(16)));
constexpr int TS = 1040, TILE = 32 * TS, VS = 1088, VTILE = 8 * VS, PS = 272, PTILE = 32 * PS, SG = 264, SPLANE = 64 * SG, STILE = 2 * SPLANE;
constexpr int QB_OFF = 0, KB_OFF = TILE, VB_OFF = 3 * TILE, ST_OFF = VB_OFF + 2 * VTILE, P_OFF = ST_OFF + STILE, END_OFF = P_OFF + PTILE;
static_assert(END_OFF <= MISC_OFF && ST_OFF % 16 == 0 && P_OFF % 16 == 0, "retention LDS map");
__device__ __forceinline__ s16x4 vtr(const LAS char* p) { return __builtin_bit_cast(s16x4, __builtin_amdgcn_ds_read_tr16_b64_v4i16((LAS s16x4*)p)); }
}
#define RET_BAR0() asm volatile("s_waitcnt vmcnt(0) lgkmcnt(0)\n\ts_barrier" ::: "memory")
#define RET_BAR1() asm volatile("s_waitcnt lgkmcnt(0)\n\ts_barrier" ::: "memory")
__device__ __forceinline__ void ret_phase(Frame& F, const bf16* proj, bf16* ro) {
    using namespace ret;
    __builtin_amdgcn_s_waitcnt(0x0F70);
    LAS char* L = (LAS char*)F.lds;
    const int lane = F.lane, r = lane & 31, hh = lane >> 5, w = F.wave;
    const int q4 = (lane & 15) >> 2, p4 = lane & 3, blk = (lane >> 4) & 1;
    const v4u sd_proj = make_srd(proj, (unsigned)(48 * PJT * 2));
    const v4u sd_ro = make_srd(ro, (unsigned)(M * LDR * 2));
    const unsigned lo_qk = (unsigned)((lane >> 5) * 32 * 512 + (lane & 31) * 16);
    const unsigned lo_v = (unsigned)((lane >> 3) * 8 * 512 + (lane & 7) * 16);
    const int jb = w & 1, ib = (w >> 1) & 1, eb = w & 1;
    const int rb = r * TS + hh * 16;
    const int ktr_l = (8 * hh + q4) * TS + 32 * blk + 8 * p4 + 64 * w;
    const int vtr_l = q4 * VS + hh * 128 + 32 * blk + 8 * p4;
    const int str_l = ST_OFF + 2 * hh * SG + q4 * 64 + 32 * blk + 8 * p4;
    const int stw_l = ST_OFF + (8 * w + (r >> 2)) * SG + (r & 3) * 64 + 8 * hh;
    const int pw_l = P_OFF + r * PS + 8 * hh, pr_l = P_OFF + r * PS + 16 * hh;
    const int vsc_l = w * VS + lane * 16;
    for (int it = blockIdx.x; it < NB * 8 * 8; it += F.G) {
        const int sl = (it >> 3) & 7, bh_ = ((it & 7) << 2) | (it >> 6), h = bh_ & 7, b = bh_ >> 3;
        const int rowbase = b * SEQ;
        const float lg2 = log2f(1.0f - exp2f(-5.0f - (float)h));
        const float g64 = exp2f(lg2 * 64.0f);
        float Dk[16];
#pragma unroll
        for (int i = 0; i < 16; ++i) { const int jj = 32 * jb + (i & 3) + 8 * (i >> 2) + 4 * hh, dj = (32 * ib + r) - jj; Dk[i] = exp2f(lg2 * (float)((dj < 0 ? -dj : dj) + jj - 64)); }
        const float qdec = exp2f(lg2 * (float)(32 * ib + r));
        const float vdec = exp2f(lg2 * (float)(64 - (w + 8 * (lane >> 3))));
        f32x16 acc[2];
#pragma unroll
        for (int e2 = 0; e2 < 2; ++e2)
#pragma unroll
            for (int i = 0; i < 16; ++i) acc[e2][i] = 0.f;
        const int qtile_b = (int)(((size_t)h * PJT + (size_t)rowbase * 256) * 2), ktile_b = (int)(((size_t)(8 + h) * PJT + (size_t)rowbase * 256) * 2),
                  vtile_b = (int)(((size_t)(16 + 2 * h + (sl >> 2)) * PJT + (size_t)rowbase * 256 + (sl & 3) * 64) * 2);
        const unsigned ovoff = (unsigned)((32 * ib + r) * LDR + 4 * hh) * 2u;
#define RET_ISSUE_QK(tile_b, n, bufoff) do { _Pragma("unroll") for (int i_ = 0; i_ < 4; ++i_) { const int pc_ = 4 * w + i_; \
        dma16(sd_proj, lo_qk, (tile_b) + ((n) * 64 + pc_) * 512, (LAS void*)(L + (bufoff) + pc_ * TS)); } } while (0)
#define RET_ISSUE_V(n, bufoff) dma16(sd_proj, lo_v, vtile_b + ((n) * 64 + w) * 512, (LAS void*)(L + (bufoff) + w * VS))
#define RET_ST_WRITE() do { _Pragma("unroll") for (int e2_ = 0; e2_ < 2; ++e2_) _Pragma("unroll") for (int g_ = 0; g_ < 4; ++g_) { v2u sv_; \
            sv_.x = pk2(acc[e2_][4 * g_ + 0], acc[e2_][4 * g_ + 1]); sv_.y = pk2(acc[e2_][4 * g_ + 2], acc[e2_][4 * g_ + 3]); *(LAS v2u*)(L + stw_l + e2_ * SPLANE + 16 * g_) = sv_; } } while (0)
        RET_BAR0();
        RET_ISSUE_QK(qtile_b, 0, QB_OFF); RET_ISSUE_QK(ktile_b, 0, KB_OFF); RET_ISSUE_V(0, VB_OFF);
        v4u qr[4];
#define RET_QLOAD(n) do { const int n_ = (n) < 64 ? (n) : 63; _Pragma("unroll") for (int i_ = 0; i_ < 4; ++i_) qr[i_] = bload16(sd_proj, lo_qk, qtile_b + (n_ * 64 + 4 * w + i_) * 512); } while (0)
        RET_QLOAD(1);
        RET_ST_WRITE();
        for (int n = 0; n < 64; ++n) {
            if (w >= 4 && n > 0) asm volatile("s_waitcnt vmcnt(8) lgkmcnt(0)\n\ts_barrier" ::: "memory"); else asm volatile("s_waitcnt vmcnt(4) lgkmcnt(0)\n\ts_barrier" ::: "memory");
            const int kb_off = KB_OFF + (n & 1) * TILE, vb_off = VB_OFF + (n & 1) * VTILE;
            const int n1 = n + 1 < 64 ? n + 1 : 63;
#define RET_ISSUE_PIECE(j) do { if ((j) < 4) dma16(sd_proj, lo_qk, ktile_b + (n1 * 64 + 4 * w + (j)) * 512, (LAS void*)(L + KB_OFF + ((n + 1) & 1) * TILE + (4 * w + (j)) * TS)); \
                                else RET_ISSUE_V(n1, VB_OFF + ((n + 1) & 1) * VTILE); } while (0)
            {
                LAS v4u* vp = (LAS v4u*)(L + vb_off + vsc_l);
                const v4u vv = *vp;
                acc[0] = acc[0] * g64; acc[1] = acc[1] * g64;
                v4u vo; vo.x = pk2(bflo(vv.x) * vdec, bfhi(vv.x) * vdec); vo.y = pk2(bflo(vv.y) * vdec, bfhi(vv.y) * vdec); vo.z = pk2(bflo(vv.z) * vdec, bfhi(vv.z) * vdec); vo.w = pk2(bflo(vv.w) * vdec, bfhi(vv.w) * vdec);
                *vp = vo;
            }
            f32x16 t;
#pragma unroll
            for (int j = 0; j < 5; ++j) RET_ISSUE_PIECE(j);
            if (w < 4) {
                const unsigned ap_ = (unsigned)(uintptr_t)(L + kb_off + rb + jb * 512), bp_ = (unsigned)(uintptr_t)(L + QB_OFF + rb + ib * 512);
                asm volatile("s_nop 4\n\tds_read_b128 v[200:203], %[a] offset:0\n\tds_read_b128 v[204:207], %[b] offset:0\n\tds_read_b128 v[208:211], %[a] offset:32\n\tds_read_b128 v[212:215], %[b] offset:32\n\tds_read_b128 v[216:219], %[a] offset:64\n\tds_read_b128 v[220:223], %[b] offset:64\n\tds_read_b128 v[224:227], %[a] offset:96\n\tds_read_b128 v[228:231], %[b] offset:96\n\tds_read_b128 v[232:235], %[a] offset:128\n\tds_read_b128 v[236:239], %[b] offset:128\n\ts_waitcnt lgkmcnt(8)\n\tv_mfma_f32_32x32x16_bf16 %[t], v[200:203], v[204:207], 0\n\tds_read_b128 v[200:203], %[a] offset:160\n\tds_read_b128 v[204:207], %[b] offset:160\n\ts_waitcnt lgkmcnt(8)\n\tv_mfma_f32_32x32x16_bf16 %[t], v[208:211], v[212:215], %[t]\n\tds_read_b128 v[208:211], %[a] offset:192\n\tds_read_b128 v[212:215], %[b] offset:192\n\ts_waitcnt lgkmcnt(8)\n\tv_mfma_f32_32x32x16_bf16 %[t], v[216:219], v[220:223], %[t]\n\tds_read_b128 v[216:219], %[a] offset:224\n\tds_read_b128 v[220:223], %[b] offset:224\n\ts_waitcnt lgkmcnt(8)\n\tv_mfma_f32_32x32x16_bf16 %[t], v[224:227], v[228:231], %[t]\n\tds_read_b128 v[224:227], %[a] offset:256\n\tds_read_b128 v[228:231], %[b] offset:256\n\ts_waitcnt lgkmcnt(8)\n\tv_mfma_f32_32x32x16_bf16 %[t], v[232:235], v[236:239], %[t]\n\tds_read_b128 v[232:235], %[a] offset:288\n\tds_read_b128 v[236:239], %[b] offset:288\n\ts_waitcnt lgkmcnt(8)\n\tv_mfma_f32_32x32x16_bf16 %[t], v[200:203], v[204:207], %[t]\n\tds_read_b128 v[200:203], %[a] offset:320\n\tds_read_b128 v[204:207], %[b] offset:320\n\ts_waitcnt lgkmcnt(8)\n\tv_mfma_f32_32x32x16_bf16 %[t], v[208:211], v[212:215], %[t]\n\tds_read_b128 v[208:211], %[a] offset:352\n\tds_read_b128 v[212:215], %[b] offset:352\n\ts_waitcnt lgkmcnt(8)\n\tv_mfma_f32_32x32x16_bf16 %[t], v[216:219], v[220:223], %[t]\n\tds_read_b128 v[216:219], %[a] offset:384\n\tds_read_b128 v[220:223], %[b] offset:384\n\ts_waitcnt lgkmcnt(8)\n\tv_mfma_f32_32x32x16_bf16 %[t], v[224:227], v[228:231], %[t]\n\tds_read_b128 v[224:227], %[a] offset:416\n\tds_read_b128 v[228:231], %[b] offset:416\n\ts_waitcnt lgkmcnt(8)\n\tv_mfma_f32_32x32x16_bf16 %[t], v[232:235], v[236:239], %[t]\n\tds_read_b128 v[232:235], %[a] offset:448\n\tds_read_b128 v[236:239], %[b] offset:448\n\ts_waitcnt lgkmcnt(8)\n\tv_mfma_f32_32x32x16_bf16 %[t], v[200:203], v[204:207], %[t]\n\tds_read_b128 v[200:203], %[a] offset:480\n\tds_read_b128 v[204:207], %[b] offset:480\n\ts_waitcnt lgkmcnt(8)\n\tv_mfma_f32_32x32x16_bf16 %[t], v[208:211], v[212:215], %[t]\n\ts_waitcnt lgkmcnt(6)\n\tv_mfma_f32_32x32x16_bf16 %[t], v[216:219], v[220:223], %[t]\n\ts_waitcnt lgkmcnt(4)\n\tv_mfma_f32_32x32x16_bf16 %[t], v[224:227], v[228:231], %[t]\n\ts_waitcnt lgkmcnt(2)\n\tv_mfma_f32_32x32x16_bf16 %[t], v[232:235], v[236:239], %[t]\n\ts_waitcnt lgkmcnt(0)\n\tv_mfma_f32_32x32x16_bf16 %[t], v[200:203], v[204:207], %[t]\n\ts_nop 15" : [t] "=&v"(t) : [a] "v"(ap_), [b] "v"(bp_) : "memory", "v200", "v201", "v202", "v203", "v204", "v205", "v206", "v207", "v208", "v209", "v210", "v211", "v212", "v213", "v214", "v215", "v216", "v217", "v218", "v219", "v220", "v221", "v222", "v223", "v224", "v225", "v226", "v227", "v228", "v229", "v230", "v231", "v232", "v233", "v234", "v235", "v236", "v237", "v238", "v239");
#pragma unroll
                for (int g = 0; g < 4; ++g) { v2u wv; wv.x = pk2(t[4 * g + 0] * Dk[4 * g + 0], t[4 * g + 1] * Dk[4 * g + 1]); wv.y = pk2(t[4 * g + 2] * Dk[4 * g + 2], t[4 * g + 3] * Dk[4 * g + 3]);
                    *(LAS v2u*)(L + pw_l + ib * 128 + jb * 64 + 16 * g) = wv; }
            } else {
                const unsigned ap_ = (unsigned)(uintptr_t)(L + str_l + eb * SPLANE), bp_ = (unsigned)(uintptr_t)(L + QB_OFF + rb + ib * 512);
                asm volatile("s_nop 4\n\tds_read_b64_tr_b16 v[200:201], %[a] offset:0\n\tds_read_b64_tr_b16 v[202:203], %[a] offset:264\n\tds_read_b128 v[204:207], %[b] offset:0\n\tds_read_b64_tr_b16 v[208:209], %[a] offset:1056\n\tds_read_b64_tr_b16 v[210:211], %[a] offset:1320\n\tds_read_b128 v[212:215], %[b] offset:32\n\tds_read_b64_tr_b16 v[216:217], %[a] offset:2112\n\tds_read_b64_tr_b16 v[218:219], %[a] offset:2376\n\tds_read_b128 v[220:223], %[b] offset:64\n\tds_read_b64_tr_b16 v[224:225], %[a] offset:3168\n\tds_read_b64_tr_b16 v[226:227], %[a] offset:3432\n\tds_read_b128 v[228:231], %[b] offset:96\n\tds_read_b64_tr_b16 v[232:233], %[a] offset:4224\n\tds_read_b64_tr_b16 v[234:235], %[a] offset:4488\n\tds_read_b128 v[236:239], %[b] offset:128\n\ts_waitcnt lgkmcnt(12)\n\tv_mfma_f32_32x32x16_bf16 %[t], v[200:203], v[204:207], 0\n\tds_read_b64_tr_b16 v[200:201], %[a] offset:5280\n\tds_read_b64_tr_b16 v[202:203], %[a] offset:5544\n\tds_read_b128 v[204:207], %[b] offset:160\n\ts_waitcnt lgkmcnt(12)\n\tv_mfma_f32_32x32x16_bf16 %[t], v[208:211], v[212:215], %[t]\n\tds_read_b64_tr_b16 v[208:209], %[a] offset:6336\n\tds_read_b64_tr_b16 v[210:211], %[a] offset:6600\n\tds_read_b128 v[212:215], %[b] offset:192\n\ts_waitcnt lgkmcnt(12)\n\tv_mfma_f32_32x32x16_bf16 %[t], v[216:219], v[220:223], %[t]\n\tds_read_b64_tr_b16 v[216:217], %[a] offset:7392\n\tds_read_b64_tr_b16 v[218:219], %[a] offset:7656\n\tds_read_b128 v[220:223], %[b] offset:224\n\ts_waitcnt lgkmcnt(12)\n\tv_mfma_f32_32x32x16_bf16 %[t], v[224:227], v[228:231], %[t]\n\tds_read_b64_tr_b16 v[224:225], %[a] offset:8448\n\tds_read_b64_tr_b16 v[226:227], %[a] offset:8712\n\tds_read_b128 v[228:231], %[b] offset:256\n\ts_waitcnt lgkmcnt(12)\n\tv_mfma_f32_32x32x16_bf16 %[t], v[232:235], v[236:239], %[t]\n\tds_read_b64_tr_b16 v[232:233], %[a] offset:9504\n\tds_read_b64_tr_b16 v[234:235], %[a] offset:9768\n\tds_read_b128 v[236:239], %[b] offset:288\n\ts_waitcnt lgkmcnt(12)\n\tv_mfma_f32_32x32x16_bf16 %[t], v[200:203], v[204:207], %[t]\n\tds_read_b64_tr_b16 v[200:201], %[a] offset:10560\n\tds_read_b64_tr_b16 v[202:203], %[a] offset:10824\n\tds_read_b128 v[204:207], %[b] offset:320\n\ts_waitcnt lgkmcnt(12)\n\tv_mfma_f32_32x32x16_bf16 %[t], v[208:211], v[212:215], %[t]\n\tds_read_b64_tr_b16 v[208:209], %[a] offset:11616\n\tds_read_b64_tr_b16 v[210:211], %[a] offset:11880\n\tds_read_b128 v[212:215], %[b] offset:352\n\ts_waitcnt lgkmcnt(12)\n\tv_mfma_f32_32x32x16_bf16 %[t], v[216:219], v[220:223], %[t]\n\tds_read_b64_tr_b16 v[216:217], %[a] offset:12672\n\tds_read_b64_tr_b16 v[218:219], %[a] offset:12936\n\tds_read_b128 v[220:223], %[b] offset:384\n\ts_waitcnt lgkmcnt(12)\n\tv_mfma_f32_32x32x16_bf16 %[t], v[224:227], v[228:231], %[t]\n\tds_read_b64_tr_b16 v[224:225], %[a] offset:13728\n\tds_read_b64_tr_b16 v[226:227], %[a] offset:13992\n\tds_read_b128 v[228:231], %[b] offset:416\n\ts_waitcnt lgkmcnt(12)\n\tv_mfma_f32_32x32x16_bf16 %[t], v[232:235], v[236:239], %[t]\n\tds_read_b64_tr_b16 v[232:233], %[a] offset:14784\n\tds_read_b64_tr_b16 v[234:235], %[a] offset:15048\n\tds_read_b128 v[236:239], %[b] offset:448\n\ts_waitcnt lgkmcnt(12)\n\tv_mfma_f32_32x32x16_bf16 %[t], v[200:203], v[204:207], %[t]\n\tds_read_b64_tr_b16 v[200:201], %[a] offset:15840\n\tds_read_b64_tr_b16 v[202:203], %[a] offset:16104\n\tds_read_b128 v[204:207], %[b] offset:480\n\ts_waitcnt lgkmcnt(12)\n\tv_mfma_f32_32x32x16_bf16 %[t], v[208:211], v[212:215], %[t]\n\ts_waitcnt lgkmcnt(9)\n\tv_mfma_f32_32x32x16_bf16 %[t], v[216:219], v[220:223], %[t]\n\ts_waitcnt lgkmcnt(6)\n\tv_mfma_f32_32x32x16_bf16 %[t], v[224:227], v[228:231], %[t]\n\ts_waitcnt lgkmcnt(3)\n\tv_mfma_f32_32x32x16_bf16 %[t], v[232:235], v[236:239], %[t]\n\ts_waitcnt lgkmcnt(0)\n\tv_mfma_f32_32x32x16_bf16 %[t], v[200:203], v[204:207], %[t]\n\ts_nop 15" : [t] "=&v"(t) : [a] "v"(ap_), [b] "v"(bp_) : "memory", "v200", "v201", "v202", "v203", "v204", "v205", "v206", "v207", "v208", "v209", "v210", "v211", "v212", "v213", "v214", "v215", "v216", "v217", "v218", "v219", "v220", "v221", "v222", "v223", "v224", "v225", "v226", "v227", "v228", "v229", "v230", "v231", "v232", "v233", "v234", "v235", "v236", "v237", "v238", "v239");
                t = t * qdec;
            }
            RET_BAR1();
            asm volatile("s_waitcnt vmcnt(5)" : "+v"(qr[0]), "+v"(qr[1]), "+v"(qr[2]), "+v"(qr[3]) :: "memory");
#pragma unroll
            for (int i = 0; i < 4; ++i) *(LAS v4u*)(L + QB_OFF + (4 * w + i) * TS + lane * 16) = qr[i];
            const int n2 = n + 2 < 64 ? n + 2 : 63;
            if (w >= 4) {
                { const unsigned va_ = (unsigned)(uintptr_t)(L + vb_off + vtr_l + eb * 64), pa_ = (unsigned)(uintptr_t)(L + pr_l + ib * 128);
                  asm volatile("s_nop 4\n\tds_read_b64_tr_b16 v[200:201], %[v] offset:0\n\tds_read_b64_tr_b16 v[202:203], %[v] offset:4352\n\tds_read_b128 v[204:207], %[p] offset:0\n\tds_read_b64_tr_b16 v[208:209], %[v] offset:256\n\tds_read_b64_tr_b16 v[210:211], %[v] offset:4608\n\tds_read_b128 v[212:215], %[p] offset:32\n\tds_read_b64_tr_b16 v[216:217], %[v] offset:512\n\tds_read_b64_tr_b16 v[218:219], %[v] offset:4864\n\tds_read_b128 v[220:223], %[p] offset:64\n\tds_read_b64_tr_b16 v[224:225], %[v] offset:768\n\tds_read_b64_tr_b16 v[226:227], %[v] offset:5120\n\tds_read_b128 v[228:231], %[p] offset:96\n\ts_waitcnt lgkmcnt(9)\n\tv_mfma_f32_32x32x16_bf16 %[t], v[200:203], v[204:207], %[t]\n\ts_waitcnt lgkmcnt(6)\n\tv_mfma_f32_32x32x16_bf16 %[t], v[208:211], v[212:215], %[t]\n\ts_waitcnt lgkmcnt(3)\n\tv_mfma_f32_32x32x16_bf16 %[t], v[216:219], v[220:223], %[t]\n\ts_waitcnt lgkmcnt(0)\n\tv_mfma_f32_32x32x16_bf16 %[t], v[224:227], v[228:231], %[t]\n\ts_nop 15" : [t] "+v"(t) : [v] "v"(va_), [p] "v"(pa_) : "memory", "v200", "v201", "v202", "v203", "v204", "v205", "v206", "v207", "v208", "v209", "v210", "v211", "v212", "v213", "v214", "v215", "v216", "v217", "v218", "v219", "v220", "v221", "v222", "v223", "v224", "v225", "v226", "v227", "v228", "v229", "v230", "v231"); }
                const int osoff = ((rowbase + 64 * n) * LDR + h * 512 + sl * 64 + 32 * eb) * 2;
#pragma unroll
                for (int g = 0; g < 4; ++g) { v2u wv; wv.x = pk2(t[4 * g + 0], t[4 * g + 1]); wv.y = pk2(t[4 * g + 2], t[4 * g + 3]);
                    bstore8(sd_ro, wv, ovoff, osoff + 16 * g); }
            }
#pragma unroll
            for (int ks = 0; ks < 4; ++ks) qr[ks] = bload16(sd_proj, lo_qk, qtile_b + (n2 * 64 + 4 * w + ks) * 512);
            { const unsigned ka_ = (unsigned)(uintptr_t)(L + kb_off + ktr_l), va_ = (unsigned)(uintptr_t)(L + vb_off + vtr_l);
              asm volatile("s_nop 4\n\tds_read_b64_tr_b16 v[200:201], %[k] offset:0\n\tds_read_b64_tr_b16 v[202:203], %[k] offset:4160\n\tds_read_b64_tr_b16 v[204:205], %[v] offset:0\n\tds_read_b64_tr_b16 v[206:207], %[v] offset:4352\n\tds_read_b64_tr_b16 v[208:209], %[v] offset:64\n\tds_read_b64_tr_b16 v[210:211], %[v] offset:4416\n\tds_read_b64_tr_b16 v[212:213], %[k] offset:16640\n\tds_read_b64_tr_b16 v[214:215], %[k] offset:20800\n\tds_read_b64_tr_b16 v[216:217], %[v] offset:256\n\tds_read_b64_tr_b16 v[218:219], %[v] offset:4608\n\tds_read_b64_tr_b16 v[220:221], %[v] offset:320\n\tds_read_b64_tr_b16 v[222:223], %[v] offset:4672\n\ts_waitcnt lgkmcnt(6)\n\tv_mfma_f32_32x32x16_bf16 %[c0], v[204:207], v[200:203], %[c0]\n\tv_mfma_f32_32x32x16_bf16 %[c1], v[208:211], v[200:203], %[c1]\n\tds_read_b64_tr_b16 v[224:225], %[k] offset:512\n\tds_read_b64_tr_b16 v[226:227], %[k] offset:4672\n\tds_read_b64_tr_b16 v[228:229], %[v] offset:512\n\tds_read_b64_tr_b16 v[230:231], %[v] offset:4864\n\tds_read_b64_tr_b16 v[232:233], %[v] offset:576\n\tds_read_b64_tr_b16 v[234:235], %[v] offset:4928\n\ts_waitcnt lgkmcnt(6)\n\tv_mfma_f32_32x32x16_bf16 %[c0], v[216:219], v[212:215], %[c0]\n\tv_mfma_f32_32x32x16_bf16 %[c1], v[220:223], v[212:215], %[c1]\n\tds_read_b64_tr_b16 v[200:201], %[k] offset:17152\n\tds_read_b64_tr_b16 v[202:203], %[k] offset:21312\n\tds_read_b64_tr_b16 v[204:205], %[v] offset:768\n\tds_read_b64_tr_b16 v[206:207], %[v] offset:5120\n\tds_read_b64_tr_b16 v[208:209], %[v] offset:832\n\tds_read_b64_tr_b16 v[210:211], %[v] offset:5184\n\ts_waitcnt lgkmcnt(6)\n\tv_mfma_f32_32x32x16_bf16 %[c0], v[228:231], v[224:227], %[c0]\n\tv_mfma_f32_32x32x16_bf16 %[c1], v[232:235], v[224:227], %[c1]\n\ts_waitcnt lgkmcnt(0)\n\tv_mfma_f32_32x32x16_bf16 %[c0], v[204:207], v[200:203], %[c0]\n\tv_mfma_f32_32x32x16_bf16 %[c1], v[208:211], v[200:203], %[c1]\n\ts_nop 15" : [c0] "+v"(acc[0]), [c1] "+v"(acc[1]) : [k] "v"(ka_), [v] "v"(va_) : "memory", "v200", "v201", "v202", "v203", "v204", "v205", "v206", "v207", "v208", "v209", "v210", "v211", "v212", "v213", "v214", "v215", "v216", "v217", "v218", "v219", "v220", "v221", "v222", "v223", "v224", "v225", "v226", "v227", "v228", "v229", "v230", "v231", "v232", "v233", "v234", "v235"); }
            RET_ST_WRITE();
        }
#undef RET_ST_WRITE
#undef RET_ISSUE_V
#undef RET_ISSUE_QK
#undef RET_QLOAD
#undef RET_ISSUE_PIECE
    }
    RET_BAR0();
}

__device__ __forceinline__ void retfin_phase(Frame& F, const bf16* ro, const bf16* proj, const float* gn, bf16* rg) {
    const int gw = blockIdx.x * NWAVES + F.wave, NGW = F.G * NWAVES;
    const f32x4 g0 = *(const f32x4*)(gn + F.lane * 8), g1 = *(const f32x4*)(gn + F.lane * 8 + 4);
    for (int m = gw; m < M; m += NGW) {
        v4u ov[8], gv[8];
#pragma unroll
        for (int h = 0; h < 8; ++h) { ov[h] = *(const v4u*)(ro + (size_t)m * LDR + h * 512 + F.lane * 8); gv[h] = *(const v4u*)(proj + (size_t)(32 + 2 * h + (F.lane >> 5)) * PJT + (size_t)m * 256 + (F.lane & 31) * 8); }
#pragma unroll
        for (int h = 0; h < 8; ++h) {
            float x[8] = {bflo(ov[h].x), bfhi(ov[h].x), bflo(ov[h].y), bfhi(ov[h].y), bflo(ov[h].z), bfhi(ov[h].z), bflo(ov[h].w), bfhi(ov[h].w)};
            const float gt[8] = {bflo(gv[h].x), bfhi(gv[h].x), bflo(gv[h].y), bfhi(gv[h].y), bflo(gv[h].z), bfhi(gv[h].z), bflo(gv[h].w), bfhi(gv[h].w)};
            float s = 0.f;
#pragma unroll
            for (int k = 0; k < 8; ++k) s += x[k];
            const float mu = wave_sum(s) * (1.0f / 512.0f); float q = 0.f;
#pragma unroll
            for (int k = 0; k < 8; ++k) { x[k] -= mu; q += x[k] * x[k]; }
            const float rstd = 1.0f / sqrtf(wave_sum(q) * (1.0f / 512.0f) + EPS);
            v4u w; w.x = pk2(x[0] * rstd * g0.x * gt[0], x[1] * rstd * g0.y * gt[1]); w.y = pk2(x[2] * rstd * g0.z * gt[2], x[3] * rstd * g0.w * gt[3]);
            w.z = pk2(x[4] * rstd * g1.x * gt[4], x[5] * rstd * g1.y * gt[5]); w.w = pk2(x[6] * rstd * g1.z * gt[6], x[7] * rstd * g1.w * gt[7]);
            *(v4u*)(rg + (size_t)m * LDR + h * 512 + F.lane * 8) = w;
        }
    }
}

constexpr int NPH = 18;
struct Args { const float* in[15]; float* out; unsigned char* ws; int ph_lo, ph_hi; };
static_assert(sizeof(Args) == 17 * 8 + 8, "Args has no padding");
__global__ void __launch_bounds__(NWAVES * 64, 2) mk_fwd(Args args) {
    extern __shared__ __attribute__((aligned(16))) unsigned char lds[];
    Frame F;
    F.lds = (LAS unsigned char*)lds;
    F.MISC = (volatile LAS unsigned*)(F.lds + MISC_OFF);
    F.tid = threadIdx.x; F.lane = F.tid & 63; F.wave = __builtin_amdgcn_readfirstlane(F.tid >> 6);
    F.G = gridDim.x;
    unsigned char* ws = args.ws;
    F.ctl = (gu32*)(ws + WS_CTL);
    if (F.tid < 64) F.MISC[F.tid] = 0u;
    __syncthreads();
    XcdBarrier bar; bar.bar = (unsigned*)(F.ctl + CW_BAR); bar.x = 0; bar.st = nullptr;
    if (MK_ONE_LAUNCH) bar = xcd_barrier_post((unsigned*)(F.ctl + CW_BAR), F.MISC + 8);
    const int lo = args.ph_lo, hi = args.ph_hi;
#define IN(k) (lo <= (k) && (k) < hi)
#define SEAM(k) do { if (IN(k) && IN((k) + 1)) xcd_barrier(bar); } while (0)
    const float* x_in = args.in[0]; const float* c_in = args.in[1]; const float* ada_w = args.in[2]; const float* ada_b = args.in[3]; const float* norm_g = args.in[4];
    const float* da_lambda = args.in[8]; const float* da_subln = args.in[9]; const float* ret_gn = args.in[12]; const float* final_g = args.in[14];
    float* xres = args.out;
    unsigned short* XH = (unsigned short*)(ws + WS_XH);
    float* mod = (float*)(ws + WS_MOD);
    bf16* Hb = (bf16*)(ws + WS_H); bf16* BIG = (bf16*)(ws + WS_BIG); bf16* AO = (bf16*)(ws + WS_AO); bf16* RO = (bf16*)(ws + WS_RO);
    LAS unsigned char* glds = F.lds + RING_OFF;

    if (IN(0)) {
        mod_phase(F, c_in, ada_w, ada_b, mod);
        xcd_barrier(bar);
        WPtrs P{args.in[5], args.in[6], args.in[7], args.in[10], args.in[11], args.in[13], ws, mod, (float*)(ws + WS_BIG)};
        convert_phase(F, P);
    }
    SEAM(0);
    if (IN(1)) pre_phase(F, x_in, norm_g, mod, ws);
    SEAM(1);
    float* gsm = (float*)(ws + WS_GSM); float* biasv = (float*)(ws + WS_BIAS); float* ssq = (float*)(ws + WS_SSQ);
    float* PART = (float*)(ws + WS_AO - 2 * MiB);
#define GATE_OF(s) (mod + (size_t)((s) / 3) * NB * NMOD + (3 * ((s) % 3) + 2) * DM)
#define FFN_BLOCK(PH, f, s, XIN, NEXT, SN, FIRST) \
    if (IN(PH)) { pg8::Gemm g{Hb, (const bf16*)(ws + WS_WIN + (f) * WIN_BYTES), M, FF2, DM, LDH, LDH, 1}; pg8::StaticOrder S; S.init(M, FF2, F.G, (int)blockIdx.x); if ((s) != 0) ssq_local(F, S, PART, ssq + (size_t)(s) * M); \
        pg8::EpiSwiglu E{BIG, LDF, ssq + (size_t)(s) * M, biasv + (size_t)(s) * NB * BIASP, BIASP}; pg8::gemm_phase<pg8::EpiSwiglu, pg8::StaticOrder, PG8_ALIGN, PG8_SP2>(glds, g, S, E); } \
    SEAM(PH); \
    if (IN((PH) + 1)) { pg8::Gemm g{BIG, (const bf16*)(ws + WS_WOUT + (f) * WOUT_BYTES), M, DM, FF, LDF, LDF, 1}; pg8::StaticOrder S; S.init(M, DM, F.G, (int)blockIdx.x); \
        pg8::EpiResid<NEXT, FIRST> E{(XIN), XH, GATE_OF(s), Hb, gsm + (size_t)(SN) * NB * DM, PART, NMOD, LDH, 0.5f, 0}; \
        pg8::gemm_phase<pg8::EpiResid<NEXT, FIRST>, pg8::StaticOrder, PG8_ALIGN, PG8_SP2>(glds, g, S, E); } \
    SEAM((PH) + 1);

    FFN_BLOCK(2, 0, 0, x_in, true, 1, true)
    if (IN(4)) { pg8::Gemm g{Hb, (const bf16*)(ws + WS_WQKV), M, NQKV, DM, LDH, LDH, 1}; pg8::StaticOrder S; S.init(M, NQKV, F.G, (int)blockIdx.x); ssq_local(F, S, PART, ssq + (size_t)1 * M);
        pg8::EpiProj<0> E{BIG, LDQ, QSCALE, ssq + (size_t)1 * M, biasv + (size_t)1 * NB * BIASP, BIASP}; pg8::gemm_phase<pg8::EpiProj<0>, pg8::StaticOrder, PG8_ALIGN, PG8_SP2>(glds, g, S, E); }
    SEAM(4);
    if (IN(5)) { att_kmax_phase(F, BIG, (unsigned*)(ws + WS_KMAX)); xcd_barrier(bar); att_pc_phase(F, BIG, AO, da_lambda, da_subln, (const float*)(ws + WS_KMAX)); }
    SEAM(5);
    if (IN(6)) { pg8::Gemm g{AO, (const bf16*)(ws + WS_WODA), M, DM, DM, LDH, LDH, 0}; pg8::StaticOrder S; S.init(M, DM, F.G, (int)blockIdx.x);
        pg8::EpiResid<true, false> E{XH, XH, GATE_OF(1), Hb, gsm + (size_t)2 * NB * DM, PART, NMOD, LDH, 1.0f, 0};
        pg8::gemm_phase<pg8::EpiResid<true, false>, pg8::StaticOrder, PG8_ALIGN, PG8_SP2>(glds, g, S, E); }
    SEAM(6);
    FFN_BLOCK(7, 1, 2, XH, true, 3, false)
    FFN_BLOCK(9, 2, 3, XH, true, 4, false)
    if (IN(11)) { pg8::Gemm g{Hb, (const bf16*)(ws + WS_WQKVG), M, NPROJ, DM, LDH, LDH, 1}; pg8::StaticOrder S; S.init(M, NPROJ, F.G, (int)blockIdx.x); ssq_local(F, S, PART, ssq + (size_t)4 * M);
        pg8::EpiProj<1> E{BIG, LDP, 1.0f, ssq + (size_t)4 * M, biasv + (size_t)4 * NB * BIASP, BIASP}; pg8::gemm_phase<pg8::EpiProj<1>, pg8::StaticOrder, PG8_ALIGN, PG8_SP2>(glds, g, S, E); }
    SEAM(11);
    if (IN(12)) ret_phase(F, BIG, RO);
    SEAM(12);
    if (IN(13)) retfin_phase(F, RO, BIG, ret_gn, AO);
    SEAM(13);
    if (IN(14)) { pg8::Gemm g{AO, (const bf16*)(ws + WS_WORET), M, DM, RVW, LDR, LDR, 0}; pg8::StaticOrder S; S.init(M, DM, F.G, (int)blockIdx.x);
        pg8::EpiResid<true, false> E{XH, XH, GATE_OF(4), Hb, gsm + (size_t)5 * NB * DM, PART, NMOD, LDH, 1.0f, 0};
        pg8::gemm_phase<pg8::EpiResid<true, false>, pg8::StaticOrder, PG8_ALIGN, PG8_SP2>(glds, g, S, E); }
    SEAM(14);
    FFN_BLOCK(15, 3, 5, XH, false, 0, false)
    if (IN(17)) final_phase(F, XH, xres, final_g);
#undef IN
#undef SEAM
#undef GATE_OF
#undef FFN_BLOCK
}

extern "C" void kernel_launch(void* const* d_in, const int* in_sizes, int n_in, void* d_out, int out_size, void* d_ws, size_t ws_size, hipStream_t stream) {
    static int grid = 0;
    if (grid == 0) {
        if (n_in != 15 || in_sizes[0] != M * DM || out_size != M * DM || ws_size < WS_END) { fprintf(stderr, "kernel_launch: unexpected shapes: n_in %d in0 %d out %d ws %zu (need %zu)\n", n_in, n_in > 0 ? in_sizes[0] : -1, out_size, ws_size, (size_t)WS_END); grid = -1; return; }
        int dev = 0, cus = 0, per_cu = 0;
        if (hipGetDevice(&dev) != hipSuccess || hipDeviceGetAttribute(&cus, hipDeviceAttributeMultiprocessorCount, dev) != hipSuccess) { fprintf(stderr, "kernel_launch: device query failed\n"); grid = -1; return; }
        if (hipFuncSetAttribute((const void*)mk_fwd, hipFuncAttributeMaxDynamicSharedMemorySize, LDS_BYTES) != hipSuccess) { fprintf(stderr, "kernel_launch: hipFuncSetAttribute failed\n"); grid = -1; return; }
        if (hipOccupancyMaxActiveBlocksPerMultiprocessor(&per_cu, (const void*)mk_fwd, NWAVES * 64, LDS_BYTES) != hipSuccess || per_cu < 1) fprintf(stderr, "kernel_launch: note: occupancy query reports %d workgroups per CU\n", per_cu);
        (void)hipGetLastError();
        grid = cus;
    }
    if (grid < 0) return;
    if (hipMemsetAsync((char*)d_ws + WS_CTL, 0, CTL_ZERO_BYTES, stream) != hipSuccess) { fprintf(stderr, "kernel_launch: memset failed\n"); return; }
    Args a{};
    for (int i = 0; i < 15; ++i) a.in[i] = (const float*)d_in[i];
    a.out = (float*)d_out; a.ws = (unsigned char*)d_ws;
#if MK_ONE_LAUNCH
    a.ph_lo = 0; a.ph_hi = NPH;
    hipLaunchKernelGGL(mk_fwd, dim3(grid), dim3(NWAVES * 64), LDS_BYTES, stream, a);
#else
    for (int p = 0; p < NPH; ++p) { a.ph_lo = p; a.ph_hi = p + 1; hipLaunchKernelGGL(mk_fwd, dim3(grid), dim3(NWAVES * 64), LDS_BYTES, stream, a); }
#endif
    const hipError_t le = hipPeekAtLastError();
    if (le != hipSuccess) fprintf(stderr, "kernel_launch: launch failed: %s\n", hipGetErrorName(le));
}
```

```cpp
#include <hip/hip_runtime.h>
#include <cstdio>
#include <cstdint>
#include <cmath>
namespace pg8 {
#define PG8_LAS __attribute__((address_space(3)))
typedef unsigned short bf16_t;
typedef short bf16x8 __attribute__((ext_vector_type(8)));
typedef float f32x4 __attribute__((ext_vector_type(4)));
typedef unsigned u32x4 __attribute__((ext_vector_type(4)));
constexpr int XS_PANEL = 32 * 16384 + 2048;
constexpr int BM = 256, BK = 64, HALF = 128, HTB = HALF * BK * 2  , STAGE_BYTES = 8 * HTB, NXCD = 8, WGM = 4;

__host__ __device__ __forceinline__ int lds_byte(int r, int c) { const int st = (r >> 4) * 2 + (c >> 5), rr = r & 15, cc = c & 31, ob = rr * 64 + cc * 2; return st * 1024 + (ob ^ (((ob >> 9) & 1) << 5)); }
__host__ __device__ __forceinline__ void stage_rc(int b, int& R, int& C) { const int st = b / 1024, sb = b % 1024, swz = sb ^ (((sb >> 9) & 1) << 5); R = (st >> 1) * 16 + swz / 64; C = (st & 1) * 32 + (swz % 64) / 2; }
__host__ __device__ __forceinline__ int perm32(int rho) { const int n = rho >> 4, i = rho & 15; return 8 * (i >> 2) + 4 * n + (i & 3); }

struct Unit { int pm, pn; };
struct Gemm { const bf16_t* A; const bf16_t* Bt; int M, N, K, lda, ldb, atiled; };

struct StaticOrder {
    int nM, nN, nwg, G, c;
    __host__ __device__ void init(int M, int N, int G_, int c_) { nM = M / BM; nN = N / BM; nwg = nM * nN; G = G_; c = c_; }
    __host__ __device__ bool next(int i, Unit& u) const {
        const long L = (long)i * G + c; if (L >= nwg) return false;
        int wgid = (int)L; { const int q = nwg / NXCD, r = nwg % NXCD, xcd = wgid % NXCD, off = wgid / NXCD; wgid = (xcd < r ? xcd * (q + 1) : r * (q + 1) + (xcd - r) * q) + off; }
        const int nig = WGM * nN, gid = wgid / nig, fm = gid * WGM, gsz = (nM - fm) < WGM ? (nM - fm) : WGM;
        u.pm = fm + ((wgid % nig) % gsz); u.pn = (wgid % nig) / gsz; return true;
    }
    __device__ __forceinline__ void a_ready(const Unit&) const {}
    __device__ __forceinline__ void done(const Unit&) const {}
};


typedef float f32x2 __attribute__((ext_vector_type(2)));
typedef __bf16 bf16x2_t __attribute__((ext_vector_type(2)));
__device__ __forceinline__ unsigned cvt_pk_bf16(float lo, float hi) { f32x2 v = {lo, hi}; bf16x2_t b = __builtin_convertvector(v, bf16x2_t); return __builtin_bit_cast(unsigned, b); }
__device__ __forceinline__ float silu_f(float a) { return a * __builtin_amdgcn_rcpf(1.0f + __builtin_amdgcn_exp2f(a * -1.4426950408889634f)); }

__device__ __forceinline__ float rstd_of(const float* ssq, int row) { return 1.0f / sqrtf(ssq[row] * (1.0f / 2048.0f) + 1e-5f); }
constexpr int FFH = 5632;
struct EpiSwiglu {
    static constexpr bool PERM = true, AFTER_DRAIN = false;
    bf16_t* O; int ldc; const float* ssq; const float* bias; int bpitch;
    __device__ __forceinline__ void operator()(const f32x4 (&acc)[2][2][4][2], const Unit& u, int wr, int wc, int fr, int fq) const {
        const int row0 = u.pm * BM + wr * 64 + fr, col0 = u.pn * HALF + wc * 32 + 8 * fq;
        const float* bb = bias + (size_t)(u.pm >> 4) * bpitch + u.pn * BM + wc * 32 + 8 * fq;
        const f32x4 bg0 = *(const f32x4*)bb, bg1 = *(const f32x4*)(bb + 4), bu0 = *(const f32x4*)(bb + HALF), bu1 = *(const f32x4*)(bb + HALF + 4);
        float rsv[8];
#pragma unroll
        for (int i = 0; i < 8; ++i) rsv[i] = ssq[row0 + (i >> 2) * HALF + (i & 3) * 16];
#pragma unroll
        for (int i = 0; i < 8; ++i) rsv[i] = 1.0f / sqrtf(rsv[i] * (1.0f / 2048.0f) + 1e-5f);
#pragma unroll
        for (int ai = 0; ai < 2; ++ai)
#pragma unroll
            for (int m = 0; m < 4; ++m) { const int row = row0 + ai * HALF + m * 16; const float rs = rsv[ai * 4 + m];
                bf16_t* rowp = O + (size_t)u.pm * ((size_t)(FFH / 64) * 16384 + 2048) + (size_t)(col0 >> 6) * 16384 + (size_t)(row & 255) * 64 + (col0 & 63);
                const f32x4 g0 = acc[ai][0][m][0] * rs + bg0, g1 = acc[ai][0][m][1] * rs + bg1, u0 = acc[ai][1][m][0] * rs + bu0, u1 = acc[ai][1][m][1] * rs + bu1;
                u32x4 w;
                w.x = cvt_pk_bf16(silu_f(g0[0]) * u0[0], silu_f(g0[1]) * u0[1]); w.y = cvt_pk_bf16(silu_f(g0[2]) * u0[2], silu_f(g0[3]) * u0[3]);
                w.z = cvt_pk_bf16(silu_f(g1[0]) * u1[0], silu_f(g1[1]) * u1[1]); w.w = cvt_pk_bf16(silu_f(g1[2]) * u1[2], silu_f(g1[3]) * u1[3]);
                *(u32x4*)rowp = w; }
    }
};
typedef _Float16 h16x2 __attribute__((ext_vector_type(2)));
__device__ __forceinline__ unsigned cvt_pk_f16(float lo, float hi) { f32x2 v = {lo, hi}; h16x2 h = __builtin_convertvector(v, h16x2); return __builtin_bit_cast(unsigned, h); }
__device__ __forceinline__ f32x2 unpk_f16(unsigned u) { return __builtin_convertvector(__builtin_bit_cast(h16x2, u), f32x2); }
template <bool NEXT, bool FIRST> struct EpiResid {
    static constexpr bool PERM = true, AFTER_DRAIN = false;
    const void* xin; unsigned short* xout; const float* gate; bf16_t* xs; const float* gsm; float* ssq; int gpitch, ldxs; float gs; int pad_;
    __device__ __forceinline__ void operator()(const f32x4 (&acc)[2][2][4][2], const Unit& u, int wr, int wc, int fr, int fq) const {
        const int row0 = u.pm * BM + wr * 64 + fr, col0 = u.pn * BM + wc * 32 + 8 * fq, b = u.pm >> 4;
        const float* gb = gate + (size_t)b * gpitch + col0;
        f32x4 gv[2][2], sm[2][2];
#pragma unroll
        for (int bj = 0; bj < 2; ++bj)
#pragma unroll
            for (int n = 0; n < 2; ++n) { gv[bj][n] = *(const f32x4*)(gb + bj * HALF + 4 * n) * gs; if (NEXT) sm[bj][n] = *(const f32x4*)(gsm + (size_t)b * 2048 + col0 + bj * HALF + 4 * n); }
        const size_t tile = ((size_t)u.pm * 8 + u.pn) * 65536 + (size_t)(wr * 64 + fr) * 256 + wc * 32 + 8 * fq;
        const unsigned short* hin = (const unsigned short*)xin + tile; unsigned short* hout = xout + tile;
        const float* fin = (const float*)xin + (size_t)row0 * 2048 + col0;
        bf16_t* xst = xs + (size_t)u.pm * XS_PANEL + (size_t)(4 * u.pn + (wc >> 1)) * 16384 + (size_t)(wr * 64 + fr) * 64 + (wc & 1) * 32 + 8 * fq;
        float sq[8];
        if (!FIRST) {
#pragma unroll
            for (int hb = 0; hb < 2; ++hb) {
                u32x4 hx[4][2];
#pragma unroll
                for (int k = 0; k < 4; ++k) { const int rg_ = hb * HALF + k * 16; hx[k][0] = *(const u32x4*)(hin + rg_ * 256); hx[k][1] = *(const u32x4*)(hin + rg_ * 256 + HALF); }
#pragma unroll
                for (int k = 0; k < 4; ++k) { const int it = hb * 4 + k, ai = hb, m = k, rg = ai * HALF + m * 16, row = row0 + rg; float s2 = 0.f;
#pragma unroll
                    for (int bj = 0; bj < 2; ++bj) { const u32x4 h_ = hx[k][bj]; const f32x2 a_ = unpk_f16(h_.x), b_ = unpk_f16(h_.y), c_ = unpk_f16(h_.z), d_ = unpk_f16(h_.w);
                        const f32x4 x0 = (f32x4){a_.x, a_.y, b_.x, b_.y} + gv[bj][0] * acc[ai][bj][m][0], x1 = (f32x4){c_.x, c_.y, d_.x, d_.y} + gv[bj][1] * acc[ai][bj][m][1];
                        u32x4 hw; hw.x = cvt_pk_f16(x0[0], x0[1]); hw.y = cvt_pk_f16(x0[2], x0[3]); hw.z = cvt_pk_f16(x1[0], x1[1]); hw.w = cvt_pk_f16(x1[2], x1[3]);
                        *(u32x4*)(hout + rg * 256 + bj * HALF) = hw;
                        if (NEXT) { s2 += (x0[0] * x0[0] + x0[1] * x0[1]) + (x0[2] * x0[2] + x0[3] * x0[3]) + (x1[0] * x1[0] + x1[1] * x1[1]) + (x1[2] * x1[2] + x1[3] * x1[3]);
                            const f32x4 y0 = x0 * sm[bj][0], y1 = x1 * sm[bj][1]; u32x4 w; w.x = cvt_pk_bf16(y0[0], y0[1]); w.y = cvt_pk_bf16(y0[2], y0[3]); w.z = cvt_pk_bf16(y1[0], y1[1]); w.w = cvt_pk_bf16(y1[2], y1[3]);
                            *(u32x4*)(xst + (size_t)(bj * 2) * 16384 + rg * 64) = w; } }
                    sq[it] = s2; }
            }
        } else {
            f32x4 xv[2][2][2];
#define ER_LOAD(it, buf) do { const int rg_ = ((it) >> 2) * HALF + ((it) & 3) * 16; const float* p_ = fin + (size_t)rg_ * 2048; \
                xv[buf][0][0] = *(const f32x4*)p_; xv[buf][0][1] = *(const f32x4*)(p_ + 4); xv[buf][1][0] = *(const f32x4*)(p_ + HALF); xv[buf][1][1] = *(const f32x4*)(p_ + HALF + 4); } while (0)
            ER_LOAD(0, 0);
#pragma unroll
            for (int it = 0; it < 8; ++it) { const int ai = it >> 2, m = it & 3, rg = ai * HALF + m * 16, row = row0 + rg; float s2 = 0.f;
                if (it + 1 < 8) ER_LOAD(it + 1, (it + 1) & 1);
#pragma unroll
                for (int bj = 0; bj < 2; ++bj) { const f32x4 x0 = xv[it & 1][bj][0] + gv[bj][0] * acc[ai][bj][m][0], x1 = xv[it & 1][bj][1] + gv[bj][1] * acc[ai][bj][m][1];
                    u32x4 hw; hw.x = cvt_pk_f16(x0[0], x0[1]); hw.y = cvt_pk_f16(x0[2], x0[3]); hw.z = cvt_pk_f16(x1[0], x1[1]); hw.w = cvt_pk_f16(x1[2], x1[3]);
                    *(u32x4*)(hout + rg * 256 + bj * HALF) = hw;
                    if (NEXT) { s2 += (x0[0] * x0[0] + x0[1] * x0[1]) + (x0[2] * x0[2] + x0[3] * x0[3]) + (x1[0] * x1[0] + x1[1] * x1[1]) + (x1[2] * x1[2] + x1[3] * x1[3]);
                        const f32x4 y0 = x0 * sm[bj][0], y1 = x1 * sm[bj][1]; u32x4 w; w.x = cvt_pk_bf16(y0[0], y0[1]); w.y = cvt_pk_bf16(y0[2], y0[3]); w.z = cvt_pk_bf16(y1[0], y1[1]); w.w = cvt_pk_bf16(y1[2], y1[3]);
                        *(u32x4*)(xst + (size_t)(bj * 2) * 16384 + rg * 64) = w; } }
                sq[it] = s2; }
#undef ER_LOAD
        }
        if (NEXT) {
#pragma unroll
            for (int it = 0; it < 8; ++it) { float s2 = sq[it]; s2 += __shfl_xor(s2, 16); s2 += __shfl_xor(s2, 32); if (fq == 0) ssq[(size_t)(u.pn * 4 + wc) * 16384 + row0 + (it >> 2) * HALF + (it & 3) * 16] = s2; }
        }
    }
};
template <int MODE> struct EpiProj {
    static constexpr bool PERM = true, AFTER_DRAIN = false;
    bf16_t* O; int ldc; float qscale; const float* ssq; const float* bias; int bpitch;
    __device__ __forceinline__ void operator()(const f32x4 (&acc)[2][2][4][2], const Unit& u, int wr, int wc, int fr, int fq) const {
        const int row0 = u.pm * BM + wr * 64 + fr, colt = u.pn * BM, col0 = colt + wc * 32 + 8 * fq;
        float sc = 1.f; bool act = false;
        if (MODE == 0) { if (colt < 2048) sc = qscale; }
        else { if (colt >= 2048 && colt < 4096) sc = 0.0625f; act = colt >= 8192; }
        const float* bb = bias + (size_t)(u.pm >> 4) * bpitch + col0;
        f32x4 bv[2][2];
#pragma unroll
        for (int bj = 0; bj < 2; ++bj)
#pragma unroll
            for (int n = 0; n < 2; ++n) bv[bj][n] = *(const f32x4*)(bb + bj * HALF + 4 * n);
        float rsv[8];
#pragma unroll
        for (int i = 0; i < 8; ++i) rsv[i] = ssq[row0 + (i >> 2) * HALF + (i & 3) * 16];
#pragma unroll
        for (int i = 0; i < 8; ++i) rsv[i] = 1.0f / sqrtf(rsv[i] * (1.0f / 2048.0f) + 1e-5f);
#pragma unroll
        for (int ai = 0; ai < 2; ++ai)
#pragma unroll
            for (int m = 0; m < 4; ++m) { const int row = row0 + ai * HALF + m * 16; bf16_t* rowp = O + (size_t)u.pn * ((size_t)16384 * 256) + (size_t)row * 256 + (col0 - colt); const float rs = rsv[ai * 4 + m];
#pragma unroll
                for (int bj = 0; bj < 2; ++bj) { f32x4 v0 = (acc[ai][bj][m][0] * rs + bv[bj][0]) * sc, v1 = (acc[ai][bj][m][1] * rs + bv[bj][1]) * sc;
                    if (MODE == 1 && act) {
#pragma unroll
                        for (int j = 0; j < 4; ++j) { v0[j] = silu_f(v0[j]); v1[j] = silu_f(v1[j]); } }
                    u32x4 w; w.x = cvt_pk_bf16(v0[0], v0[1]); w.y = cvt_pk_bf16(v0[2], v0[3]); w.z = cvt_pk_bf16(v1[0], v1[1]); w.w = cvt_pk_bf16(v1[2], v1[3]);
                    *(u32x4*)(rowp + bj * HALF) = w; } }
    }
};

template <class Epi, class Sched, bool ALIGN_EPI = false, bool SP2 = false>
__device__ __forceinline__ void gemm_phase(PG8_LAS unsigned char* lds, const Gemm g, const Sched& S, const Epi& E) {
    const int tid = threadIdx.x, wid = __builtin_amdgcn_readfirstlane(tid >> 6), lane = tid & 63, wr = wid >> 2, wc = wid & 3, fr = lane & 15, fq = lane >> 4;
    const int K = g.K, nt = K / BK;
    unsigned voffA[2], voffB[2];
#pragma unroll
    for (int i = 0; i < 2; ++i) { int R, C; stage_rc(tid * 16 + i * 8192, R, C); const int Rb = Epi::PERM ? ((R & ~31) + perm32(R & 31)) : R;
        voffA[i] = (unsigned)(R * (g.atiled ? 64 : g.lda) + C) * 2u; voffB[i] = (unsigned)(Rb * 64 + C) * 2u; }
    const size_t kstepB = (size_t)(BM * BK * 2), kstepA = g.atiled ? (size_t)(BM * BK * 2) : (size_t)(BK * 2);
    const size_t hstepA = g.atiled ? (size_t)(HALF * BK * 2) : (size_t)HALF * g.lda * 2, hstepB = (size_t)(HALF * BK * 2);
    const size_t tstepA = g.atiled ? ((size_t)(K / BK) * (BM * BK) + 2048) * 2 : 2 * hstepA, tstepB = ((size_t)(K / BK) * (BM * BK) + 2048) * 2;
    const unsigned ldsw = (unsigned)wid * 1024u;
    const int aoff = lds_byte(wr * 64 + fr, fq * 8), boff = lds_byte(wc * 32 + fr, fq * 8);
#define PG8_SA(b, h) (((b) * 2 + (h)) * HTB)
#define PG8_SB(b, h) ((4 + (b) * 2 + (h)) * HTB)
#define PG8_STAGE(bufoff, gbase, voff) do { _Pragma("unroll") for (int _i = 0; _i < 2; ++_i) \
        __builtin_amdgcn_global_load_lds((const unsigned*)((const char*)(gbase) + (voff)[_i]), (PG8_LAS unsigned*)(lds + (bufoff) + ldsw + _i * 8192), 16, 0, 0); } while (0)
#define PG8_LDA(dst, b, h) do { _Pragma("unroll") for (int m = 0; m < 4; ++m) _Pragma("unroll") for (int k = 0; k < 2; ++k) dst[m][k] = *(const PG8_LAS bf16x8*)(lds + PG8_SA(b, h) + aoff + m * 2048 + k * 1024); } while (0)
#define PG8_LDB(dst, b, h) do { _Pragma("unroll") for (int n = 0; n < 2; ++n) _Pragma("unroll") for (int k = 0; k < 2; ++k) dst[n][k] = *(const PG8_LAS bf16x8*)(lds + PG8_SB(b, h) + boff + n * 2048 + k * 1024); } while (0)
#define PG8_MMA(ai, bj, At, Bt) do { __builtin_amdgcn_s_setprio(1); _Pragma("unroll") for (int m = 0; m < 4; ++m) _Pragma("unroll") for (int n = 0; n < 2; ++n) _Pragma("unroll") for (int k = 0; k < 2; ++k) \
        acc[ai][bj][m][n] = __builtin_amdgcn_mfma_f32_16x16x32_bf16(Bt[n][k], At[m][k], acc[ai][bj][m][n], 0, 0, 0); __builtin_amdgcn_s_setprio(0); } while (0)
#define PG8_WAIT_V(n) asm volatile("s_waitcnt vmcnt(" #n ")" ::: "memory")
#define PG8_WAIT_L(n) asm volatile("s_waitcnt lgkmcnt(" #n ")" ::: "memory")
#define PG8_BAR __builtin_amdgcn_s_barrier()
#define PG8_SCHED __builtin_amdgcn_sched_barrier(0)
    Unit cur, nxt; int ui = 0;
    if (!S.next(0, cur)) return;
    f32x4 acc[2][2][4][2];
#pragma unroll
    for (int a = 0; a < 2; ++a)
#pragma unroll
        for (int b = 0; b < 2; ++b)
#pragma unroll
            for (int m = 0; m < 4; ++m)
#pragma unroll
                for (int n = 0; n < 2; ++n) acc[a][b][m][n] = (f32x4){0.f, 0.f, 0.f, 0.f};
    bf16x8 At[4][2], B0[2][2], B1[2][2];
    const char* cA = (const char*)g.A + (size_t)cur.pm * tstepA; const char* cB = (const char*)g.Bt + (size_t)cur.pn * tstepB;
    S.a_ready(cur);
    if constexpr (SP2) {
        PG8_STAGE(PG8_SB(0, 0), cB, voffB); PG8_STAGE(PG8_SB(0, 1), cB + hstepB, voffB); PG8_STAGE(PG8_SA(0, 0), cA, voffA); PG8_STAGE(PG8_SA(0, 1), cA + hstepA, voffA);
        if (wr == 1) PG8_BAR;
        PG8_WAIT_V(2); PG8_BAR;
        PG8_STAGE(PG8_SB(1, 0), cB + kstepB, voffB); PG8_STAGE(PG8_SA(1, 0), cA + kstepA, voffA); PG8_STAGE(PG8_SB(1, 1), cB + hstepB + kstepB, voffB);
        PG8_WAIT_V(6); PG8_BAR;
    } else {
        PG8_STAGE(PG8_SB(0, 0), cB, voffB); PG8_STAGE(PG8_SA(0, 0), cA, voffA); PG8_STAGE(PG8_SB(0, 1), cB + hstepB, voffB); PG8_STAGE(PG8_SA(0, 1), cA + hstepA, voffA);
        if (wr == 1) PG8_BAR;
        PG8_WAIT_V(4); PG8_BAR;
        PG8_STAGE(PG8_SB(1, 0), cB + kstepB, voffB); PG8_STAGE(PG8_SA(1, 0), cA + kstepA, voffA); PG8_STAGE(PG8_SB(1, 1), cB + hstepB + kstepB, voffB);
        PG8_WAIT_V(6); PG8_BAR;
    }
    for (;;) {
        const bool has_next = S.next(ui + 1, nxt);
        const char* nA = has_next ? (const char*)g.A + (size_t)nxt.pm * tstepA : cA; const char* nB = has_next ? (const char*)g.Bt + (size_t)nxt.pn * tstepB : cB;
        for (int t = 0; t < nt; t += 2) {
            const bool last = (t == nt - 2);
            const char* a1 = cA + (size_t)(t + 1) * kstepA;
            const char* a2 = last ? nA : cA + (size_t)(t + 2) * kstepA; const char* b2 = last ? nB : cB + (size_t)(t + 2) * kstepB;
            const char* a3 = a2 + kstepA; const char* b3 = b2 + kstepB;
            if (last && has_next) S.a_ready(nxt);
            if constexpr (SP2) {
            PG8_LDB(B0, 0, 0); PG8_LDB(B1, 0, 1); PG8_SCHED; PG8_LDA(At, 0, 0); PG8_STAGE(PG8_SA(1, 1), a1 + hstepA, voffA);
            PG8_WAIT_V(8); PG8_WAIT_L(0); PG8_BAR; PG8_MMA(0, 0, At, B0); PG8_MMA(0, 1, At, B1); PG8_BAR; PG8_SCHED;
            PG8_LDA(At, 0, 1); PG8_STAGE(PG8_SB(0, 0), b2, voffB); PG8_STAGE(PG8_SB(0, 1), b2 + hstepB, voffB); PG8_STAGE(PG8_SA(0, 0), a2, voffA);
            PG8_WAIT_V(8); PG8_WAIT_L(0); PG8_BAR; PG8_MMA(1, 0, At, B0); PG8_MMA(1, 1, At, B1); PG8_BAR; PG8_SCHED;
            PG8_LDB(B0, 1, 0); PG8_LDB(B1, 1, 1); PG8_SCHED; PG8_LDA(At, 1, 0); PG8_STAGE(PG8_SA(0, 1), a2 + hstepA, voffA);
            PG8_WAIT_V(8); PG8_WAIT_L(0); PG8_BAR; PG8_MMA(0, 0, At, B0); PG8_MMA(0, 1, At, B1); PG8_BAR; PG8_SCHED;
            PG8_LDA(At, 1, 1); PG8_STAGE(PG8_SB(1, 0), b3, voffB); PG8_STAGE(PG8_SB(1, 1), b3 + hstepB, voffB); PG8_STAGE(PG8_SA(1, 0), a3, voffA);
            PG8_WAIT_V(8); PG8_WAIT_L(0); PG8_BAR; PG8_MMA(1, 0, At, B0); PG8_MMA(1, 1, At, B1); PG8_BAR; PG8_SCHED;
            } else {
            PG8_LDB(B0, 0, 0); PG8_SCHED; PG8_LDA(At, 0, 0); PG8_STAGE(PG8_SA(1, 1), a1 + hstepA, voffA);
            PG8_WAIT_L(8); PG8_BAR; PG8_WAIT_L(0); PG8_MMA(0, 0, At, B0); PG8_BAR; PG8_SCHED;
            PG8_LDB(B1, 0, 1); PG8_STAGE(PG8_SB(0, 0), b2, voffB);
            PG8_BAR; PG8_WAIT_L(0); PG8_MMA(0, 1, At, B1); PG8_BAR;
            PG8_LDA(At, 0, 1); PG8_STAGE(PG8_SA(0, 0), a2, voffA);
            PG8_BAR; PG8_WAIT_L(0); PG8_MMA(1, 0, At, B0); PG8_BAR; PG8_SCHED;
            PG8_STAGE(PG8_SB(0, 1), b2 + hstepB, voffB);
            PG8_WAIT_V(6); PG8_BAR; PG8_MMA(1, 1, At, B1); PG8_BAR;
            PG8_LDB(B0, 1, 0); PG8_SCHED; PG8_LDA(At, 1, 0); PG8_STAGE(PG8_SA(0, 1), a2 + hstepA, voffA);
            PG8_WAIT_L(8); PG8_BAR; PG8_WAIT_L(0); PG8_MMA(0, 0, At, B0); PG8_BAR; PG8_SCHED;
            PG8_LDB(B1, 1, 1); PG8_STAGE(PG8_SB(1, 0), b3, voffB);
            PG8_BAR; PG8_WAIT_L(0); PG8_MMA(0, 1, At, B1); PG8_BAR;
            PG8_LDA(At, 1, 1); PG8_STAGE(PG8_SA(1, 0), a3, voffA);
            PG8_BAR; PG8_WAIT_L(0); PG8_MMA(1, 0, At, B0); PG8_BAR; PG8_SCHED;
            PG8_STAGE(PG8_SB(1, 1), b3 + hstepB, voffB);
            PG8_WAIT_V(6); PG8_BAR; PG8_MMA(1, 1, At, B1); PG8_BAR;
            }
        }
        if constexpr (ALIGN_EPI) { if (wr == 0) PG8_BAR; }
        if constexpr (!Epi::AFTER_DRAIN) { E(acc, cur, wr, wc, fr, fq); S.done(cur); }
        if (!has_next) break;
#pragma unroll
        for (int a = 0; a < 2; ++a)
#pragma unroll
            for (int b = 0; b < 2; ++b)
#pragma unroll
                for (int m = 0; m < 4; ++m)
#pragma unroll
                    for (int n = 0; n < 2; ++n) acc[a][b][m][n] = (f32x4){0.f, 0.f, 0.f, 0.f};
        cur = nxt; cA = nA; cB = nB; ++ui;
        if constexpr (ALIGN_EPI) { if (wr == 1) PG8_BAR; }
    }
    PG8_WAIT_V(0);
    if constexpr (!ALIGN_EPI) { if (wr == 0) PG8_BAR; }
    PG8_BAR;
    if constexpr (Epi::AFTER_DRAIN) { E.fused(acc, cur, wr, wc, fr, fq, lds, wid, lane); S.done(cur); }
#undef PG8_SA
#undef PG8_SB
#undef PG8_STAGE
#undef PG8_LDA
#undef PG8_LDB
#undef PG8_MMA
#undef PG8_WAIT_V
#undef PG8_WAIT_L
#undef PG8_BAR
#undef PG8_SCHED
}
}

#ifndef PG8_SP2
#define PG8_SP2 true
#endif
#ifndef PG8_ALIGN
#define PG8_ALIGN true
#endif
#ifndef MK_ONE_LAUNCH
#define MK_ONE_LAUNCH 1
#endif

constexpr int NWAVES = 8;
constexpr int DM = 2048, NB = 4, SEQ = 4096, M = NB * SEQ, FF = 5632, FF2 = 2 * FF;
constexpr int NMOD = 9 * DM;
constexpr int NQKV = 6144, NPROJ = 12288, RVW = 4096;
constexpr int PADE = 64;
constexpr int LDH = DM + PADE, LDF = FF + PADE, LDR = RVW + PADE, LDQ = NQKV + PADE, LDP = NPROJ + PADE;
constexpr size_t PJT = (size_t)M * 256;
constexpr float EPS = 1e-5f;
constexpr float LOG2E = 1.4426950408889634f;
constexpr float QSCALE = 0.08838834764831845f * LOG2E;
constexpr float LAMBDA_INIT0 = 0.2f;

constexpr size_t MiB = 1u << 20;
constexpr size_t WS_CTL = 0, CTL_ZERO_BYTES = 128 * 1024;
constexpr size_t WS_SSQ = 1 * MiB;
constexpr size_t WS_MOD = 2 * MiB;
constexpr size_t WS_GSM = 3 * MiB;
constexpr size_t WS_BIAS = 3 * MiB + 256 * 1024;
constexpr size_t WS_WIN = 6 * MiB, WIN_BYTES = (size_t)FF2 * LDH * 2;
constexpr size_t WS_WOUT = WS_WIN + 4 * WIN_BYTES, WOUT_BYTES = (size_t)DM * LDF * 2;
constexpr size_t WS_WQKV = WS_WOUT + 4 * WOUT_BYTES;
constexpr size_t WS_WODA = WS_WQKV + (size_t)NQKV * LDH * 2;
constexpr size_t WS_WQKVG = WS_WODA + (size_t)DM * LDH * 2;
constexpr size_t WS_WORET = WS_WQKVG + (size_t)NPROJ * LDH * 2;
constexpr size_t WS_H = WS_WORET + (size_t)DM * LDR * 2;
constexpr size_t WS_BIG = WS_H + (size_t)M * LDH * 2;
constexpr size_t WS_AO = WS_BIG + (size_t)M * LDP * 2;
constexpr size_t WS_RO = WS_AO + (size_t)M * LDR * 2;
constexpr size_t WS_XH = WS_RO + (size_t)M * LDR * 2;
constexpr size_t WS_END = WS_XH + (size_t)M * DM * 2;
static_assert(WS_END <= (size_t)1152 * MiB && WS_WIN % 256 == 0 && WIN_BYTES % 256 == 0 && WOUT_BYTES % 256 == 0 && WS_H % 256 == 0 && WS_BIG % 256 == 0 && WS_AO % 256 == 0 && WS_RO % 256 == 0, "ws map");
constexpr int CW_TMO = 0, CW_CODE = 1, CW_BAR = 4096;

constexpr int LDS_BYTES = 163840;
constexpr int MISC_OFF = LDS_BYTES - 256;
constexpr int RING_OFF = 0;

#define GAS __attribute__((address_space(1)))
#define LAS __attribute__((address_space(3)))
typedef unsigned short bf16;
typedef unsigned v4u __attribute__((ext_vector_type(4)));
typedef unsigned v2u __attribute__((ext_vector_type(2)));
typedef float f32x4 __attribute__((ext_vector_type(4)));
typedef GAS unsigned gu32;
#define RLX_AGENT __ATOMIC_RELAXED, __HIP_MEMORY_SCOPE_AGENT
#define LDS_WAIT() asm volatile("s_waitcnt lgkmcnt(0)" ::: "memory")
#define VM_WAIT() asm volatile("s_waitcnt vmcnt(0)" ::: "memory")
__device__ __forceinline__ unsigned pk2(float lo, float hi) { return pg8::cvt_pk_bf16(lo, hi); }
__device__ __forceinline__ float bflo(unsigned u) { return __uint_as_float(u << 16); }
__device__ __forceinline__ float bfhi(unsigned u) { return __uint_as_float(u & 0xffff0000u); }
__device__ __forceinline__ float bf2f(unsigned short b) { return __uint_as_float(((unsigned)b) << 16); }
__device__ __forceinline__ v4u make_srd(const void* base, unsigned nbytes) {
    const unsigned long long a = (unsigned long long)(uintptr_t)base;
    v4u d; d.x = __builtin_amdgcn_readfirstlane((unsigned)a); d.y = __builtin_amdgcn_readfirstlane((unsigned)(a >> 32) & 0xffffu); d.z = nbytes; d.w = 0x00020000u; return d;
}
__device__ __forceinline__ void bstore8(const v4u& srd, v2u data, unsigned voff, int soff) {
    asm volatile("buffer_store_dwordx2 %0, %1, %2, %3 offen" :: "v"(data), "v"(voff), "s"(srd), "s"(soff) : "memory");
}
__device__ __forceinline__ v4u bload16(const v4u& srd, unsigned voff, int soff) {
    v4u r; asm volatile("buffer_load_dwordx4 %0, %1, %2, %3 offen" : "=&v"(r) : "v"(voff), "s"(srd), "s"(soff) : "memory"); return r;
}
__device__ __forceinline__ void dma16(const v4u& srd, unsigned voff, int soff, LAS void* ldsp) {
    unsigned keep; const unsigned la = (unsigned)(uintptr_t)ldsp;
    asm volatile("s_mov_b32 %0, m0\n\ts_mov_b32 m0, %4\n\ts_nop 0\n\tbuffer_load_dwordx4 %1, %2, %3 offen lds\n\ts_mov_b32 m0, %0"
                 : "=&s"(keep) : "v"(voff), "s"(srd), "s"(soff), "s"(la) : "memory");
}

#define XB_TMO      128
#define XB_XCNT(j)  (256  + 64 * (j))
#define XB_XSUB(j)  (1280 + 64 * (j))
#define XB_XGEN(j)  (2304 + 64 * (j))
#define XB_TOP      3328
#define XB_TOPGEN   3392
#define XCD_BAR_WORDS 3456
#define XB_SPIN_CAP (1u << 18)

__device__ __forceinline__ unsigned xb_ld(unsigned* p)              { return __hip_atomic_load(p, __ATOMIC_RELAXED, __HIP_MEMORY_SCOPE_AGENT); }
__device__ __forceinline__ unsigned xb_add(unsigned* p, unsigned v) { return __hip_atomic_fetch_add(p, v, __ATOMIC_RELAXED, __HIP_MEMORY_SCOPE_AGENT); }
__device__ __forceinline__ unsigned xb_xcc_id() { return (unsigned)__builtin_amdgcn_s_getreg((3 << 11) | 20) & 0xFu; }
#define XB_SPIN(cond, bar) do { unsigned _sp = 0; while (cond) { __builtin_amdgcn_s_sleep(1); \
    if ((++_sp & 255u) == 0u) { if (xb_ld(&(bar)[XB_TMO])) break; if (_sp > XB_SPIN_CAP) { atomicAdd(&(bar)[XB_TMO], 1u); break; } } } } while (0)

struct XcdBarrier {
    unsigned* bar; unsigned x;
    volatile LAS unsigned* st;
};

__device__ __forceinline__ XcdBarrier xcd_barrier_post(unsigned* bar, volatile LAS unsigned* st) {
    XcdBarrier b; b.bar = bar; b.x = xb_xcc_id(); b.st = st;
    if (threadIdx.x == 0) (void)xb_add(&bar[XB_XCNT(b.x)], 1u);
    return b;
}
__device__ __forceinline__ void xcd_barrier_complete(unsigned* bar, unsigned x, unsigned& nloc, unsigned& nx) {
    const unsigned G = gridDim.x * gridDim.y * gridDim.z;
    unsigned sum, cnt, mine, sp = 0u;
    for (;;) {
        sum = 0u; cnt = 0u; mine = 0u;
#pragma unroll
        for (unsigned j = 0; j < 16; ++j) { const unsigned c = xb_ld(&bar[XB_XCNT(j)]); sum += c; cnt += (c > 0u) ? 1u : 0u; mine = (j == x) ? c : mine; }
        if (sum == G) break;
        __builtin_amdgcn_s_sleep(1);
        if ((++sp & 255u) == 0u) { if (xb_ld(&bar[XB_TMO])) break; if (sp > XB_SPIN_CAP) { atomicAdd(&bar[XB_TMO], 1u); break; } }
    }
    nloc = mine > 0u ? mine : 1u; nx = cnt > 0u ? cnt : 1u;
}

__device__ __forceinline__ void xcd_barrier(const XcdBarrier& b) {
    asm volatile("s_waitcnt vmcnt(0)" ::: "memory");
    __syncthreads();
    if (threadIdx.x == 0) {
        unsigned* bar = b.bar;
        __builtin_amdgcn_s_waitcnt(0);
        unsigned nloc = b.st[0], nx = b.st[1];
        if (nloc == 0u) { xcd_barrier_complete(bar, b.x, nloc, nx); b.st[0] = nloc; b.st[1] = nx; }
        const unsigned old = xb_add(&bar[XB_XSUB(b.x)], 1u);
        const unsigned gen = old / nloc;
        if (old + 1u == (gen + 1u) * nloc) {
            __builtin_amdgcn_fence(__ATOMIC_RELEASE, "agent");
            asm volatile("s_waitcnt vmcnt(0)" ::: "memory");
            const unsigned og = xb_add(&bar[XB_TOP], 1u);
            const unsigned tg = og / nx;
            if (og + 1u == (tg + 1u) * nx) xb_add(&bar[XB_TOPGEN], 1u);
            else XB_SPIN(xb_ld(&bar[XB_TOPGEN]) == tg, bar);
            __builtin_amdgcn_fence(__ATOMIC_ACQUIRE, "agent");
            xb_add(&bar[XB_XGEN(b.x)], 1u);
            asm volatile("s_waitcnt vmcnt(0)" ::: "memory");
        } else {
            XB_SPIN(xb_ld(&bar[XB_XGEN(b.x)]) == gen, bar);
            __builtin_amdgcn_fence(__ATOMIC_ACQUIRE, "agent");
            asm volatile("s_waitcnt vmcnt(0)" ::: "memory");
        }
    }
    __syncthreads();
}


struct Frame {
    LAS unsigned char* lds;
    volatile LAS unsigned* MISC;
    gu32* ctl;
    int tid, lane, wave, G;
};
__device__ __forceinline__ float wave_sum(float v) {
#pragma unroll
    for (int o = 1; o < 64; o <<= 1) v += __shfl_xor(v, o);
    return v;
}

__device__ __forceinline__ void mod_phase(Frame& F, const float* c, const float* ada_w, const float* ada_b, float* mod) {
    LAS float* cs = (LAS float*)F.lds;
    LAS float* red = (LAS float*)(F.lds + 32768);
    for (int i = F.tid; i < NB * DM; i += NWAVES * 64) { const float v = c[i]; cs[i] = v / (1.0f + __expf(-v)); }
    __syncthreads();
    const int cg = F.tid % 36, ks = F.tid / 36;
    for (int cb = blockIdx.x; cb < 256; cb += F.G) {
        const int layer = cb >> 7, col0 = (cb & 127) * 144;
        if (ks < 14) {
            const float* W = ada_w + (size_t)layer * DM * NMOD + col0 + cg * 4;
            f32x4 a0 = {0.f, 0.f, 0.f, 0.f}, a1 = a0, a2 = a0, a3 = a0;
#pragma unroll 4
            for (int k = ks; k < DM; k += 14) {
                const f32x4 w = *(const f32x4*)(W + (size_t)k * NMOD);
                a0 += w * cs[k]; a1 += w * cs[DM + k]; a2 += w * cs[2 * DM + k]; a3 += w * cs[3 * DM + k];
            }
            LAS f32x4* r = (LAS f32x4*)(red + (ks * 4) * 144 + cg * 4);
            r[0] = a0; r[36] = a1; r[72] = a2; r[108] = a3;
        }
        __syncthreads();
        for (int o = F.tid; o < 4 * 144; o += NWAVES * 64) {
            const int b = o / 144, cc = o % 144; float s = 0.f;
#pragma unroll
            for (int k2 = 0; k2 < 14; ++k2) s += red[(k2 * 4 + b) * 144 + cc];
            mod[(size_t)(layer * NB + b) * NMOD + col0 + cc] = s + ada_b[(size_t)layer * NMOD + col0 + cc];
        }
        __syncthreads();
    }
}
__device__ __forceinline__ size_t wt_off(int n, int k, int K) { return (size_t)(n >> 8) * ((size_t)(K >> 6) * 16384 + 2048) + (size_t)(k >> 6) * 16384 + (size_t)(n & 255) * 64 + (k & 63); }
constexpr int BIASP = 12288;
__device__ __forceinline__ void transpose_item(const float* W, int K, int N, bf16* WT, int ldk, int mode, LAS float* scr, int item, int lane, const float* shp, float* part) {
    const int nblk = N / 32, kb = item / nblk, nb = item % nblk, k0 = 64 * kb, n0 = 32 * nb;
#pragma unroll 8
    for (int i = 0; i < 32; ++i) { const int kk = 2 * i + (lane >> 5); scr[kk * 33 + (lane & 31)] = W[(size_t)(k0 + kk) * N + n0 + (lane & 31)]; }
    LDS_WAIT(); asm volatile("" ::: "memory");
    int r0 = n0;
    if (mode == 1) { const int up = n0 >= FF ? 1 : 0, j = n0 - up * FF; r0 = (j >> 7) * 256 + up * 128 + (j & 127); }
    const int c = lane & 7;
    f32x4 sa[4], sb[4];
    if (shp) {
#pragma unroll
        for (int b = 0; b < 4; ++b) { const float* q = shp + (size_t)b * NMOD + k0 + 8 * c; sa[b] = *(const f32x4*)q; sb[b] = *(const f32x4*)(q + 4); } }
#pragma unroll
    for (int j = 0; j < 4; ++j) { const int n = (lane >> 3) + 8 * j; const LAS float* s = scr + (8 * c) * 33 + n;
        v4u o; o.x = pk2(s[0 * 33], s[1 * 33]); o.y = pk2(s[2 * 33], s[3 * 33]); o.z = pk2(s[4 * 33], s[5 * 33]); o.w = pk2(s[6 * 33], s[7 * 33]);
        *(GAS v4u*)(WT + wt_off(r0 + n, k0 + 8 * c, K)) = o;
        if (shp) {
            const float w0 = bflo(o.x), w1 = bfhi(o.x), w2 = bflo(o.y), w3 = bfhi(o.y), w4 = bflo(o.z), w5 = bfhi(o.z), w6 = bflo(o.w), w7 = bfhi(o.w);
#pragma unroll
            for (int b = 0; b < 4; ++b) {
                float d = ((w0 * sa[b].x + w1 * sa[b].y) + (w2 * sa[b].z + w3 * sa[b].w)) + ((w4 * sb[b].x + w5 * sb[b].y) + (w6 * sb[b].z + w7 * sb[b].w));
                d += __shfl_xor(d, 1); d += __shfl_xor(d, 2); d += __shfl_xor(d, 4);
                if (c == 0) part[(size_t)(kb * 4 + b) * BIASP + r0 + n] = d; }
        } }
    LDS_WAIT(); asm volatile("" ::: "memory");
}
struct WPtrs { const float *w_in, *w_out, *w_qkv, *w_oda, *w_qkvg, *w_oret; unsigned char* ws; const float* mod; float* part; };
constexpr size_t PARTS = (size_t)32 * 4 * BIASP;
__device__ __forceinline__ void convert_phase(Frame& F, const WPtrs& P) {
    LAS float* scr = (LAS float*)(F.lds + F.wave * 16384);
    const int gw = blockIdx.x * NWAVES + F.wave, NGW = F.G * NWAVES;
    constexpr int I_IN = (DM / 64) * (FF2 / 32), I_OUT = (FF / 64) * (DM / 32), I_QKV = (DM / 64) * (NQKV / 32), I_ODA = (DM / 64) * (DM / 32), I_QKVG = (DM / 64) * (NPROJ / 32), I_ORET = (RVW / 64) * (DM / 32);
    constexpr int NITEMS = 4 * I_IN + 4 * I_OUT + I_QKV + I_ODA + I_QKVG + I_ORET;
    for (int it = gw; it < NITEMS; it += NGW) {
        int r = it;
        if (r < 4 * I_IN) { const int f = r / I_IN, sl_ = (f == 0) ? 0 : (f == 1) ? 2 : (f == 2) ? 3 : 5;
            transpose_item(P.w_in + (size_t)f * DM * FF2, DM, FF2, (bf16*)(P.ws + WS_WIN + f * WIN_BYTES), LDH, 1, scr, r % I_IN, F.lane, P.mod + (size_t)((sl_ / 3) * NB) * NMOD + (3 * (sl_ % 3)) * DM, P.part + sl_ * PARTS); continue; } r -= 4 * I_IN;
        if (r < 4 * I_OUT) { const int f = r / I_OUT; transpose_item(P.w_out + (size_t)f * FF * DM, FF, DM, (bf16*)(P.ws + WS_WOUT + f * WOUT_BYTES), LDF, 0, scr, r % I_OUT, F.lane, nullptr, nullptr); continue; } r -= 4 * I_OUT;
        if (r < I_QKV) { transpose_item(P.w_qkv, DM, NQKV, (bf16*)(P.ws + WS_WQKV), LDH, 0, scr, r, F.lane, P.mod + (size_t)(0 * NB) * NMOD + 3 * DM, P.part + 1 * PARTS); continue; } r -= I_QKV;
        if (r < I_ODA) { transpose_item(P.w_oda, DM, DM, (bf16*)(P.ws + WS_WODA), LDH, 0, scr, r, F.lane, nullptr, nullptr); continue; } r -= I_ODA;
        if (r < I_QKVG) { transpose_item(P.w_qkvg, DM, NPROJ, (bf16*)(P.ws + WS_WQKVG), LDH, 0, scr, r, F.lane, P.mod + (size_t)(1 * NB) * NMOD + 3 * DM, P.part + 4 * PARTS); continue; } r -= I_QKVG;
        transpose_item(P.w_oret, RVW, DM, (bf16*)(P.ws + WS_WORET), LDR, 0, scr, r, F.lane, nullptr, nullptr);
    }
}
__device__ __forceinline__ void pre_phase(Frame& F, const float* A_x_in, const float* A_norm_g, const float* A_mod, unsigned char* A_ws) {
    float* gsm = (float*)(A_ws + WS_GSM); float* bias = (float*)(A_ws + WS_BIAS); float* ssq = (float*)(A_ws + WS_SSQ); bf16* Hb = (bf16*)(A_ws + WS_H);
    const int gw = blockIdx.x * NWAVES + F.wave, NGW = F.G * NWAVES;
    for (int i = blockIdx.x * (NWAVES * 64) + F.tid; i < 6 * NB * DM; i += F.G * NWAVES * 64) {
        const int s = i / (NB * DM), b = (i / DM) % NB, col = i % DM, layer = s / 3, j = s % 3;
        gsm[i] = A_norm_g[(size_t)s * DM + col] * (1.0f + A_mod[(size_t)(layer * NB + b) * NMOD + (3 * j + 1) * DM + col]);
    }
    for (int m = gw; m < M; m += NGW) {
        const int b = m >> 12;
        const f32x4* sc4 = (const f32x4*)(A_mod + (size_t)b * NMOD + DM); const f32x4* g4 = (const f32x4*)A_norm_g;
        const f32x4* xr = (const f32x4*)(A_x_in + (size_t)m * DM);
        f32x4 v[8]; float ss = 0.f;
#pragma unroll
        for (int j = 0; j < 8; ++j) { v[j] = xr[F.lane + 64 * j]; ss += (v[j].x * v[j].x + v[j].y * v[j].y) + (v[j].z * v[j].z + v[j].w * v[j].w); }
        ss = wave_sum(ss);
        if (F.lane == 0) ssq[m] = ss;
        bf16* o = Hb + (size_t)(m >> 8) * pg8::XS_PANEL + (size_t)(m & 255) * 64;
#pragma unroll
        for (int j = 0; j < 8; ++j) { const int c4 = F.lane + 64 * j, col = 4 * c4; const f32x4 y = v[j] * (g4[c4] * (sc4[c4] + 1.0f));
            v2u w; w.x = pk2(y.x, y.y); w.y = pk2(y.z, y.w); *(v2u*)(o + (size_t)(col >> 6) * 16384 + (col & 63)) = w; }
    }
    const float* part = (const float*)(A_ws + WS_BIG);
    for (int i = blockIdx.x * (NWAVES * 64) + F.tid; i < 6 * NB * BIASP; i += F.G * NWAVES * 64) {
        const int n = i % BIASP, sb_ = i / BIASP, s = sb_ >> 2, b = sb_ & 3, N = (s == 1) ? NQKV : (s == 4) ? NPROJ : FF2;
        if (n < N) { const float* pp = part + (size_t)s * PARTS + (size_t)b * BIASP + n; float a = 0.f;
#pragma unroll 8
            for (int kb = 0; kb < 32; ++kb) a += pp[(size_t)kb * 4 * BIASP];
            bias[i] = a; }
    }
}
__device__ __forceinline__ void ssq_reduce(Frame& F, const float* part, float* ssq) {
    for (int row = blockIdx.x * (NWAVES * 64) + F.tid; row < M; row += F.G * NWAVES * 64) { float s = 0.f;
#pragma unroll
        for (int k = 0; k < 32; ++k) s += part[(size_t)k * M + row];
        ssq[row] = s; }
}
__device__ __forceinline__ void ssq_pair(Frame& F, const float* part, float* ssq, int pa, int pb) {
    const int pm = (F.tid < 256) ? pa : pb;
    if (pm >= 0) { const int row = pm * 256 + (F.tid & 255); float s = 0.f;
#pragma unroll
        for (int k = 0; k < 32; ++k) s += part[(size_t)k * M + row];
        ssq[row] = s; }
}
template <class Sched> __device__ __forceinline__ void ssq_local(Frame& F, const Sched& S, const float* part, float* ssq) {
    int p0 = -1, p1 = -1; pg8::Unit u;
    for (int i = 0; S.next(i, u); ++i) {
        if (u.pm == p0 || u.pm == p1) continue;
        if (p0 < 0) p0 = u.pm; else if (p1 < 0) p1 = u.pm; else { ssq_pair(F, part, ssq, p0, p1); p0 = u.pm; p1 = -1; }
    }
    ssq_pair(F, part, ssq, p0, p1);
    asm volatile("s_waitcnt vmcnt(0)" ::: "memory");
    __syncthreads();
}
__device__ __forceinline__ void final_phase(Frame& F, const unsigned short* xh, float* out, const float* g) {
    const int gw = blockIdx.x * NWAVES + F.wave, NGW = F.G * NWAVES;
    for (int m = gw; m < M; m += NGW) {
        const unsigned short* xr = xh + (size_t)(m >> 8) * 8 * 65536 + (size_t)(m & 255) * 256 + 4 * F.lane;
        f32x4 v[8]; float ss = 0.f;
#pragma unroll
        for (int j = 0; j < 8; ++j) { const v2u h = *(const v2u*)(xr + (size_t)j * 65536); const pg8::f32x2 a = pg8::unpk_f16(h.x), c = pg8::unpk_f16(h.y);
            v[j] = (f32x4){a.x, a.y, c.x, c.y}; ss += (v[j].x * v[j].x + v[j].y * v[j].y) + (v[j].z * v[j].z + v[j].w * v[j].w); }
        const float rstd = 1.0f / sqrtf(wave_sum(ss) * (1.0f / DM) + EPS);
        f32x4* orow = (f32x4*)(out + (size_t)m * DM); const f32x4* g4 = (const f32x4*)g;
#pragma unroll
        for (int j = 0; j < 8; ++j) orow[F.lane + 64 * j] = (v[j] * rstd) * g4[F.lane + 64 * j];
    }
}

constexpr size_t WS_KMAX = 65536;
__device__ __forceinline__ void att_kmax_phase(Frame& F, const bf16* qkv, unsigned* kmax) {
    const int gw = blockIdx.x * NWAVES + F.wave, NGW = F.G * NWAVES;
    for (int r8 = gw; r8 < M / 8; r8 += NGW) {
        float mx = 0.f;
        for (int j = 0; j < 8; ++j) { const v4u* kp = (const v4u*)(qkv + (size_t)(8 + (F.lane >> 3)) * PJT + (size_t)(r8 * 8 + j) * 256 + 32 * (F.lane & 7)); float ss = 0.f;
#pragma unroll
            for (int u = 0; u < 4; ++u) { const v4u kk = kp[u];
                ss += bflo(kk.x) * bflo(kk.x) + bfhi(kk.x) * bfhi(kk.x) + bflo(kk.y) * bflo(kk.y) + bfhi(kk.y) * bfhi(kk.y) + bflo(kk.z) * bflo(kk.z) + bfhi(kk.z) * bfhi(kk.z) + bflo(kk.w) * bflo(kk.w) + bfhi(kk.w) * bfhi(kk.w); }
            ss += __shfl_xor(ss, 1); ss += __shfl_xor(ss, 2); mx = fmaxf(mx, ss); }
        if ((F.lane & 3) == 0) atomicMax(kmax + ((r8 * 8) >> 12) * 16 + (F.lane >> 2), __float_as_uint(mx));
    }
}
namespace attp {
typedef short bf16x8 __attribute__((ext_vector_type(8)));
typedef short s16x4 __attribute__((ext_vector_type(4)));
typedef float f32x16 __attribute__((ext_vector_type(16)));
constexpr int KTILE = 2 * 32 * 256;
constexpr int VSTR = 1088, VTILE = 16 * VSTR;
constexpr int PSTREAM = 2 * 1024 + 256 + 16;
constexpr int K_OFF = 0, V_OFF = 3 * KTILE, P_OFF = V_OFF + 4 * VTILE, LQ_OFF = P_OFF + 2 * 4 * PSTREAM, SUBG_OFF = LQ_OFF + 4 * 32 * 4, MARG_OFF = SUBG_OFF + 1024, END_OFF = MARG_OFF + 16;
static_assert(END_OFF <= MISC_OFF && 2 * 128 * 64 * 4 <= P_OFF, "attention LDS map");
__device__ __forceinline__ s16x4 vtr(const LAS char* p) { return __builtin_bit_cast(s16x4, __builtin_amdgcn_ds_read_tr16_b64_v4i16((LAS s16x4*)p)); }
__device__ __forceinline__ float hmax(float v) { auto rr = __builtin_amdgcn_permlane32_swap(__float_as_uint(v), __float_as_uint(v), false, false); return fmaxf(__uint_as_float(rr[0]), __uint_as_float(rr[1])); }
__device__ __forceinline__ float hsum(float v) { auto rr = __builtin_amdgcn_permlane32_swap(__float_as_uint(v), __float_as_uint(v), false, false); return __uint_as_float(rr[0]) + __uint_as_float(rr[1]); }
__device__ __forceinline__ bf16x8 pack8(const f32x16& p, int s) {
    v4u w; w.x = pg8::cvt_pk_bf16(p[8 * s + 0], p[8 * s + 1]); w.y = pg8::cvt_pk_bf16(p[8 * s + 2], p[8 * s + 3]); w.z = pg8::cvt_pk_bf16(p[8 * s + 4], p[8 * s + 5]); w.w = pg8::cvt_pk_bf16(p[8 * s + 6], p[8 * s + 7]);
    return __builtin_bit_cast(bf16x8, w);
}
}
__device__ __forceinline__ void att_pc_phase(Frame& F, const bf16* qkv, bf16* ao, const float* lam, const float* subg, const float* kmax) {
    using namespace attp;
    __builtin_amdgcn_s_waitcnt(0x0F70);
    LAS char* L = (LAS char*)F.lds;
    const int lane = F.lane, r = lane & 31, hh = lane >> 5, w = F.wave;
    const bool producer = w < 4; const int st = w & 3, map = st >> 1, rg = st & 1;
    if (w == 0) {
        const float s1 = wave_sum(lam[lane] * lam[128 + lane] + lam[64 + lane] * lam[192 + lane]);
        const float s2 = wave_sum(lam[256 + lane] * lam[384 + lane] + lam[320 + lane] * lam[448 + lane]);
        if (lane == 0) F.MISC[16] = __float_as_uint(expf(s1) - expf(s2) + LAMBDA_INIT0);
    }
    if (F.tid < 256) ((LAS float*)(L + SUBG_OFF))[F.tid] = subg[F.tid] * (1.0f - LAMBDA_INIT0);
    __syncthreads();
    const float lamv = __uint_as_float(F.MISC[16]);
    const int vcu = (F.G % 8 == 0) ? (int)(blockIdx.x & 7) * (F.G >> 3) + (int)(blockIdx.x >> 3) : (int)blockIdx.x;
    const unsigned ksrc_b = (unsigned)((lane >> 4) * 512 + (((lane & 15) ^ ((4 * (w & 3) + (lane >> 4)) & 15)) * 16));
    const unsigned vsrc_b = (unsigned)((lane >> 5) * 16 * 512 + (lane & 31) * 16);
    const unsigned qsrc_b = (unsigned)((32 * rg + r) * 256 + 8 * hh) * 2u;
    const __amdgpu_buffer_rsrc_t rs_qkv = __builtin_amdgcn_make_buffer_rsrc((void*)qkv, 0, (int)(24 * PJT * 2), 0x00020000);
    const __amdgpu_buffer_rsrc_t rs_ao = __builtin_amdgcn_make_buffer_rsrc((void*)ao, 0, M * LDH * 2, 0x00020000);
    const v4u sd_qkv = make_srd(qkv, (unsigned)(24 * PJT * 2));
    const unsigned kc16 = (unsigned)(16 * (hh ^ (r & 15)));
    const int kfrag_l = map * 8192 + r * 256;
    const int vfrag_l = (4 * hh + ((lane & 15) >> 2)) * VSTR + ((lane >> 4) & 1) * 32 + (lane & 3) * 8;
    const int pst_l = st * PSTREAM;
    for (int p = vcu; p < 1024; p += F.G) {
        const int pr = p & 31, b = (p >> 8) & 3, xs_ = (p >> 5) & 7, kr = (p >> 8) & 3, h = (kr == 0) ? xs_ : (kr == 1) ? 7 - xs_ : (kr == 2) ? (xs_ ^ 4) : 7 - (xs_ ^ 4);
        const int rowbase = b * SEQ;
        const float slope2 = exp2f(-(float)(h + 1)) * LOG2E;
        const int kbase_b = (int)(((size_t)(8 + h) * PJT + (size_t)rowbase * 256) * 2), vbase_b = (int)(((size_t)(16 + h) * PJT + (size_t)rowbase * 256) * 2);
        for (int half2 = 0; half2 < 2; ++half2) {
            const int c = half2 ? 63 - pr : pr;
            const int tq = c * 64 + 32 * rg + r;
            const int n32 = 2 * (c + 1);
            f32x16 o[8];
#define ATP_QF(ks) __builtin_bit_cast(bf16x8, (f32x4){o[(ks) >> 2][4 * ((ks) & 3)], o[(ks) >> 2][4 * ((ks) & 3) + 1], o[(ks) >> 2][4 * ((ks) & 3) + 2], o[(ks) >> 2][4 * ((ks) & 3) + 3]})
            float mrun = 0.f, lsum = 0.f; bool fresh = true;
            if (producer) { const int qoff = (int)(((size_t)h * PJT + (size_t)(rowbase + c * 64) * 256 + map * 128) * 2);
#pragma unroll
                for (int ks = 0; ks < 8; ++ks) { const f32x4 q4 = __builtin_bit_cast(f32x4, __builtin_amdgcn_raw_buffer_load_b128(rs_qkv, qsrc_b, qoff + 32 * ks, 0));
                    o[ks >> 2][4 * (ks & 3)] = q4[0]; o[ks >> 2][4 * (ks & 3) + 1] = q4[1]; o[ks >> 2][4 * (ks & 3) + 2] = q4[2]; o[ks >> 2][4 * (ks & 3) + 3] = q4[3]; } }
            else {
#pragma unroll
                for (int eb = 0; eb < 8; ++eb)
#pragma unroll
                    for (int i = 0; i < 16; ++i) o[eb][i] = 0.f; }
            float qnk = 0.f;
            if (producer) { float qq = 0.f;
#pragma unroll
                for (int e = 0; e < 32; ++e) { const unsigned u_ = __float_as_uint(o[e >> 4][e & 15]); qq += bflo(u_) * bflo(u_) + bfhi(u_) * bfhi(u_); }
                qnk = sqrtf(hsum(qq)) * sqrtf(kmax[b * 16 + h * 2 + map]) * 1.004f; }
            int nend = n32;
            __builtin_amdgcn_s_waitcnt(0x0F70);
#define ATP_ISSUE(kt32, ti) do { const int k0_ = (kt32) * 32; \
        _Pragma("unroll") for (int i_ = 0; i_ < 2; ++i_) { const int pc_ = (w & 3) + 4 * i_; \
            dma16(sd_qkv, ksrc_b, kbase_b + (k0_ + 4 * pc_) * 512 + (w >> 2) * 256, (LAS void*)(L + K_OFF + ((ti) % 3) * KTILE + (w >> 2) * 8192 + pc_ * 1024)); } \
        _Pragma("unroll") for (int i_ = 0; i_ < 2; ++i_) { const int pc_ = 2 * w + i_; \
            dma16(sd_qkv, vsrc_b, vbase_b + (k0_ + pc_) * 512, (LAS void*)(L + V_OFF + ((ti) & 3) * VTILE + pc_ * VSTR)); } } while (0)
            ATP_ISSUE(n32 - 1, 0); ATP_ISSUE(n32 - 2, 1);
            int issued = 2;
            for (int i = 0; i <= nend; ++i) {
                if (issued > i + 1) asm volatile("s_waitcnt vmcnt(4)" ::: "memory"); else VM_WAIT();
                __syncthreads();
                if (i == 2) { const LAS float* mg = (const LAS float*)(L + MARG_OFF); const float need = fmaxf(fmaxf(mg[0], mg[1]), fmaxf(mg[2], mg[3]));
                    const float xcut = (need + 161.0f) / (32.0f * slope2) + 1.97f; const int idead = (xcut < 4096.0f ? (int)xcut : 4096) + 2; nend = idead < n32 ? idead : n32; if (nend < 2) nend = 2; }
                if (i + 2 < nend) { ATP_ISSUE(n32 - 3 - i, i + 2); issued = i + 3; }
                if (producer) {
                    if (i < nend) {
                        const int kt32 = n32 - 1 - i;
                        const LAS char* Kb = L + K_OFF + (i % 3) * KTILE + kfrag_l;
                        f32x16 S;
                        const int j0 = kt32 * 32 + 4 * hh - tq;
                        if (kt32 < 2 * c) {
                            const float b0 = slope2 * (float)j0 - mrun, b1 = b0 + slope2, b2 = b1 + slope2, b3 = b2 + slope2, s8 = 8.0f * slope2, s16 = 16.0f * slope2, s24 = 24.0f * slope2;
                            S[0] = b0; S[1] = b1; S[2] = b2; S[3] = b3; S[4] = b0 + s8; S[5] = b1 + s8; S[6] = b2 + s8; S[7] = b3 + s8;
                            S[8] = b0 + s16; S[9] = b1 + s16; S[10] = b2 + s16; S[11] = b3 + s16; S[12] = b0 + s24; S[13] = b1 + s24; S[14] = b2 + s24; S[15] = b3 + s24;
                        } else {
#pragma unroll
                            for (int i_ = 0; i_ < 16; ++i_) S[i_] = fmaf(-slope2, fabsf((float)(j0 + ((i_ & 3) + 8 * (i_ >> 2)))), -mrun);
                        }
                        { const unsigned kb_ = (unsigned)(uintptr_t)Kb;
                          asm volatile("s_nop 4\n\tv_xor_b32 v220, 0, %[c]\n\tv_add_u32 v220, v220, %[b]\n\tds_read_b128 v[220:223], v220\n\tv_xor_b32 v224, 32, %[c]\n\tv_add_u32 v224, v224, %[b]\n\tds_read_b128 v[224:227], v224\n\tv_xor_b32 v228, 64, %[c]\n\tv_add_u32 v228, v228, %[b]\n\tds_read_b128 v[228:231], v228\n\tv_xor_b32 v232, 96, %[c]\n\tv_add_u32 v232, v232, %[b]\n\tds_read_b128 v[232:235], v232\n\tv_xor_b32 v236, 128, %[c]\n\tv_add_u32 v236, v236, %[b]\n\tds_read_b128 v[236:239], v236\n\tv_xor_b32 v240, 160, %[c]\n\tv_add_u32 v240, v240, %[b]\n\tds_read_b128 v[240:243], v240\n\tv_xor_b32 v244, 192, %[c]\n\tv_add_u32 v244, v244, %[b]\n\tds_read_b128 v[244:247], v244\n\tv_xor_b32 v248, 224, %[c]\n\tv_add_u32 v248, v248, %[b]\n\tds_read_b128 v[248:251], v248\n\ts_waitcnt lgkmcnt(7)\n\tv_mfma_f32_32x32x16_bf16 %[s], v[220:223], %[q0], %[s]\n\ts_waitcnt lgkmcnt(6)\n\tv_mfma_f32_32x32x16_bf16 %[s], v[224:227], %[q1], %[s]\n\ts_waitcnt lgkmcnt(5)\n\tv_mfma_f32_32x32x16_bf16 %[s], v[228:231], %[q2], %[s]\n\ts_waitcnt lgkmcnt(4)\n\tv_mfma_f32_32x32x16_bf16 %[s], v[232:235], %[q3], %[s]\n\ts_waitcnt lgkmcnt(3)\n\tv_mfma_f32_32x32x16_bf16 %[s], v[236:239], %[q4], %[s]\n\ts_waitcnt lgkmcnt(2)\n\tv_mfma_f32_32x32x16_bf16 %[s], v[240:243], %[q5], %[s]\n\ts_waitcnt lgkmcnt(1)\n\tv_mfma_f32_32x32x16_bf16 %[s], v[244:247], %[q6], %[s]\n\ts_waitcnt lgkmcnt(0)\n\tv_mfma_f32_32x32x16_bf16 %[s], v[248:251], %[q7], %[s]\n\ts_nop 15"
                              : [s] "+v"(S) : [b] "v"(kb_), [c] "v"(kc16), [q0] "v"(ATP_QF(0)), [q1] "v"(ATP_QF(1)), [q2] "v"(ATP_QF(2)), [q3] "v"(ATP_QF(3)), [q4] "v"(ATP_QF(4)), [q5] "v"(ATP_QF(5)), [q6] "v"(ATP_QF(6)), [q7] "v"(ATP_QF(7))
                              : "memory", "v220", "v221", "v222", "v223", "v224", "v225", "v226", "v227", "v228", "v229", "v230", "v231", "v232", "v233", "v234", "v235", "v236", "v237", "v238", "v239", "v240", "v241", "v242", "v243", "v244", "v245", "v246", "v247", "v248", "v249", "v250", "v251"); }
                        float mx = fmaxf(S[0], S[1]);
#pragma unroll
                        for (int i_ = 2; i_ < 16; ++i_) mx = fmaxf(mx, S[i_]);
                        const bool live = fresh || !__all(mx < -160.0f);
                        LAS char* pb = L + P_OFF + (i & 1) * (4 * PSTREAM) + pst_l;
                        float alpha = 1.0f;
                        if (live) {
                            mx = hmax(mx);
                            if (fresh || __any(mx > 8.0f)) { const float sh = fresh ? mx : fmaxf(mx, 0.0f);
#pragma unroll
                                for (int i_ = 0; i_ < 16; ++i_) S[i_] -= sh;
                                mrun += sh; if (!fresh) alpha = __builtin_amdgcn_exp2f(-sh); fresh = false; }
                            float ls = 0.f;
#pragma unroll
                            for (int i_ = 0; i_ < 16; ++i_) { S[i_] = __builtin_amdgcn_exp2f(S[i_]); ls += S[i_]; }
                            lsum = lsum * alpha + ls;
                            *(LAS bf16x8*)(pb + lane * 16) = pack8(S, 0); *(LAS bf16x8*)(pb + 1024 + lane * 16) = pack8(S, 1);
                            *(LAS float*)(pb + 2048 + lane * 4) = alpha;
                        }
                        if (lane == 0) *(LAS unsigned*)(pb + 2304) = live ? 1u : 0u;
                        if (i == 1) { float mg = qnk - mrun;
#pragma unroll
                            for (int o_ = 1; o_ < 64; o_ <<= 1) mg = fmaxf(mg, __shfl_xor(mg, o_));
                            if (lane == 0) ((LAS float*)(L + MARG_OFF))[st] = mg; }
                    }
                } else if (i >= 1) {
                    const LAS char* pb = L + P_OFF + ((i - 1) & 1) * (4 * PSTREAM) + pst_l;
                    const unsigned live = __builtin_amdgcn_readfirstlane(*(const LAS unsigned*)(pb + 2304));
                    if (live) {
                        const float alpha = *(const LAS float*)(pb + 2048 + lane * 4);
                        const bf16x8 pf0 = *(const LAS bf16x8*)(pb + lane * 16), pf1 = *(const LAS bf16x8*)(pb + 1024 + lane * 16);
                        if (__any(alpha != 1.0f)) {
#pragma unroll
                            for (int eb = 0; eb < 8; ++eb) o[eb] = o[eb] * alpha; }
                        { const unsigned va_ = (unsigned)(uintptr_t)(L + V_OFF + ((i - 1) & 3) * VTILE + vfrag_l);
                          asm volatile("s_nop 4\n\tds_read_b64_tr_b16 v[228:229], %[a] offset:0\n\tds_read_b64_tr_b16 v[230:231], %[a] offset:8704\n\tds_read_b64_tr_b16 v[232:233], %[a] offset:512\n\tds_read_b64_tr_b16 v[234:235], %[a] offset:9216\n\tds_read_b64_tr_b16 v[236:237], %[a] offset:64\n\tds_read_b64_tr_b16 v[238:239], %[a] offset:8768\n\tds_read_b64_tr_b16 v[240:241], %[a] offset:576\n\tds_read_b64_tr_b16 v[242:243], %[a] offset:9280\n\tds_read_b64_tr_b16 v[244:245], %[a] offset:128\n\tds_read_b64_tr_b16 v[246:247], %[a] offset:8832\n\tds_read_b64_tr_b16 v[248:249], %[a] offset:640\n\tds_read_b64_tr_b16 v[250:251], %[a] offset:9344\n\ts_waitcnt lgkmcnt(10)\n\tv_mfma_f32_32x32x16_bf16 %[o0], v[228:231], %[p0], %[o0]\n\tds_read_b64_tr_b16 v[228:229], %[a] offset:192\n\tds_read_b64_tr_b16 v[230:231], %[a] offset:8896\n\ts_waitcnt lgkmcnt(10)\n\tv_mfma_f32_32x32x16_bf16 %[o0], v[232:235], %[p1], %[o0]\n\tds_read_b64_tr_b16 v[232:233], %[a] offset:704\n\tds_read_b64_tr_b16 v[234:235], %[a] offset:9408\n\ts_waitcnt lgkmcnt(10)\n\tv_mfma_f32_32x32x16_bf16 %[o1], v[236:239], %[p0], %[o1]\n\tds_read_b64_tr_b16 v[236:237], %[a] offset:256\n\tds_read_b64_tr_b16 v[238:239], %[a] offset:8960\n\ts_waitcnt lgkmcnt(10)\n\tv_mfma_f32_32x32x16_bf16 %[o1], v[240:243], %[p1], %[o1]\n\tds_read_b64_tr_b16 v[240:241], %[a] offset:768\n\tds_read_b64_tr_b16 v[242:243], %[a] offset:9472\n\ts_waitcnt lgkmcnt(10)\n\tv_mfma_f32_32x32x16_bf16 %[o2], v[244:247], %[p0], %[o2]\n\tds_read_b64_tr_b16 v[244:245], %[a] offset:320\n\tds_read_b64_tr_b16 v[246:247], %[a] offset:9024\n\ts_waitcnt lgkmcnt(10)\n\tv_mfma_f32_32x32x16_bf16 %[o2], v[248:251], %[p1], %[o2]\n\tds_read_b64_tr_b16 v[248:249], %[a] offset:832\n\tds_read_b64_tr_b16 v[250:251], %[a] offset:9536\n\ts_waitcnt lgkmcnt(10)\n\tv_mfma_f32_32x32x16_bf16 %[o3], v[228:231], %[p0], %[o3]\n\tds_read_b64_tr_b16 v[228:229], %[a] offset:384\n\tds_read_b64_tr_b16 v[230:231], %[a] offset:9088\n\ts_waitcnt lgkmcnt(10)\n\tv_mfma_f32_32x32x16_bf16 %[o3], v[232:235], %[p1], %[o3]\n\tds_read_b64_tr_b16 v[232:233], %[a] offset:896\n\tds_read_b64_tr_b16 v[234:235], %[a] offset:9600\n\ts_waitcnt lgkmcnt(10)\n\tv_mfma_f32_32x32x16_bf16 %[o4], v[236:239], %[p0], %[o4]\n\tds_read_b64_tr_b16 v[236:237], %[a] offset:448\n\tds_read_b64_tr_b16 v[238:239], %[a] offset:9152\n\ts_waitcnt lgkmcnt(10)\n\tv_mfma_f32_32x32x16_bf16 %[o4], v[240:243], %[p1], %[o4]\n\tds_read_b64_tr_b16 v[240:241], %[a] offset:960\n\tds_read_b64_tr_b16 v[242:243], %[a] offset:9664\n\ts_waitcnt lgkmcnt(10)\n\tv_mfma_f32_32x32x16_bf16 %[o5], v[244:247], %[p0], %[o5]\n\ts_waitcnt lgkmcnt(8)\n\tv_mfma_f32_32x32x16_bf16 %[o5], v[248:251], %[p1], %[o5]\n\ts_waitcnt lgkmcnt(6)\n\tv_mfma_f32_32x32x16_bf16 %[o6], v[228:231], %[p0], %[o6]\n\ts_waitcnt lgkmcnt(4)\n\tv_mfma_f32_32x32x16_bf16 %[o6], v[232:235], %[p1], %[o6]\n\ts_waitcnt lgkmcnt(2)\n\tv_mfma_f32_32x32x16_bf16 %[o7], v[236:239], %[p0], %[o7]\n\ts_waitcnt lgkmcnt(0)\n\tv_mfma_f32_32x32x16_bf16 %[o7], v[240:243], %[p1], %[o7]\n\ts_nop 15"
                              : [o0] "+v"(o[0]), [o1] "+v"(o[1]), [o2] "+v"(o[2]), [o3] "+v"(o[3]), [o4] "+v"(o[4]), [o5] "+v"(o[5]), [o6] "+v"(o[6]), [o7] "+v"(o[7])
                              : [a] "v"(va_), [p0] "v"(pf0), [p1] "v"(pf1)
                              : "memory", "v228", "v229", "v230", "v231", "v232", "v233", "v234", "v235", "v236", "v237", "v238", "v239", "v240", "v241", "v242", "v243", "v244", "v245", "v246", "v247", "v248", "v249", "v250", "v251"); }
                    }
                }
            }
#undef ATP_ISSUE
#undef ATP_QF
            int lane2 = F.lane; asm volatile("" : "+v"(lane2));
            const int hh2 = lane2 >> 5;
            LAS float* LQ = (LAS float*)(L + LQ_OFF) + st * 32 + (lane2 & 31);
            if (producer) { const float lt = hsum(lsum); if (hh2 == 0) *LQ = lt; }
            VM_WAIT();
            __syncthreads();
            LAS float* X = (LAS float*)L + (rg * 128) * 64 + lane2;
            float inv = 0.f;
            if (!producer) { inv = 1.0f / *LQ;
                if (map == 1) { const float f = inv * lamv;
#pragma unroll
                    for (int eb = 0; eb < 8; ++eb)
#pragma unroll
                        for (int i = 0; i < 16; ++i) X[(eb * 16 + i) * 64] = o[eb][i] * f; } }
            __syncthreads();
            if (!producer && map == 0) {
                float ssq = 0.f;
#pragma unroll
                for (int eb = 0; eb < 8; ++eb)
#pragma unroll
                    for (int i = 0; i < 16; ++i) { const float d = o[eb][i] * inv - X[(eb * 16 + i) * 64]; o[eb][i] = d; ssq += d * d; }
                ssq = hsum(ssq);
                const float rs = 1.0f / sqrtf(ssq * (1.0f / 256.0f) + EPS);
                const int R0 = rowbase + c * 64;
                const unsigned ovoff = (unsigned)((((R0 & 255) + 32 * rg + (lane2 & 31)) * 64 + 4 * hh2) * 2); const int osoff = (int)(((size_t)(R0 >> 8) * pg8::XS_PANEL + (size_t)(4 * h) * 16384) * 2);
                const LAS float* sg = (const LAS float*)(L + SUBG_OFF) + 4 * hh2;
#pragma unroll
                for (int eb = 0; eb < 8; ++eb)
#pragma unroll
                    for (int g = 0; g < 4; ++g) { const f32x4 gg = *(const LAS f32x4*)(sg + 32 * eb + 8 * g);
                        v2u wv; wv.x = pk2(o[eb][4 * g + 0] * rs * gg.x, o[eb][4 * g + 1] * rs * gg.y); wv.y = pk2(o[eb][4 * g + 2] * rs * gg.z, o[eb][4 * g + 3] * rs * gg.w);
                        __builtin_amdgcn_raw_buffer_store_b64(wv, rs_ao, ovoff, osoff + ((eb >> 1) * 16384 + 32 * (eb & 1) + 8 * g) * 2, 0); }
            }
            __syncthreads();
        }
    }
}

namespace ret {
typedef short bf16x8 __attribute__((ext_vector_type(8)));
typedef short s16x4 __attribute__((ext_vector_type(4)));
typedef float f32x16 __attribute__((ext_vector_type(16)));
constexpr int TS = 1040, TILE = 32 * TS, VS = 1088, VTILE = 8 * VS, PS = 272, PTILE = 32 * PS, SG = 264, SPLANE = 64 * SG, STILE = 2 * SPLANE;
constexpr int QB_OFF = 0, KB_OFF = TILE, VB_OFF = 3 * TILE, ST_OFF = VB_OFF + 2 * VTILE, P_OFF = ST_OFF + STILE, END_OFF = P_OFF + PTILE;
static_assert(END_OFF <= MISC_OFF && ST_OFF % 16 == 0 && P_OFF % 16 == 0, "retention LDS map");
__device__ __forceinline__ s16x4 vtr(const LAS char* p) { return __builtin_bit_cast(s16x4, __builtin_amdgcn_ds_read_tr16_b64_v4i16((LAS s16x4*)p)); }
}
#define RET_BAR0() asm volatile("s_waitcnt vmcnt(0) lgkmcnt(0)\n\ts_barrier" ::: "memory")
#define RET_BAR1() asm volatile("s_waitcnt lgkmcnt(0)\n\ts_barrier" ::: "memory")
__device__ __forceinline__ void ret_phase(Frame& F, const bf16* proj, bf16* ro) {
    using namespace ret;
    __builtin_amdgcn_s_waitcnt(0x0F70);
    LAS char* L = (LAS char*)F.lds;
    const int lane = F.lane, r = lane & 31, hh = lane >> 5, w = F.wave;
    const int q4 = (lane & 15) >> 2, p4 = lane & 3, blk = (lane >> 4) & 1;
    const v4u sd_proj = make_srd(proj, (unsigned)(48 * PJT * 2));
    const v4u sd_ro = make_srd(ro, (unsigned)(M * LDR * 2));
    const unsigned lo_qk = (unsigned)((lane >> 5) * 32 * 512 + (lane & 31) * 16);
    const unsigned lo_v = (unsigned)((lane >> 3) * 8 * 512 + (lane & 7) * 16);
    const int jb = w & 1, ib = (w >> 1) & 1, eb = w & 1;
    const int rb = r * TS + hh * 16;
    const int ktr_l = (8 * hh + q4) * TS + 32 * blk + 8 * p4 + 64 * w;
    const int vtr_l = q4 * VS + hh * 128 + 32 * blk + 8 * p4;
    const int str_l = ST_OFF + 2 * hh * SG + q4 * 64 + 32 * blk + 8 * p4;
    const int stw_l = ST_OFF + (8 * w + (r >> 2)) * SG + (r & 3) * 64 + 8 * hh;
    const int pw_l = P_OFF + r * PS + 8 * hh, pr_l = P_OFF + r * PS + 16 * hh;
    const int vsc_l = w * VS + lane * 16;
    if (w >= 4) __builtin_amdgcn_s_setprio(1);
    for (int it = blockIdx.x; it < NB * 8 * 8; it += F.G) {
        const int sl = (it >> 3) & 7, bh_ = ((it & 7) << 2) | (it >> 6), h = bh_ & 7, b = bh_ >> 3;
        const int rowbase = b * SEQ;
        const float lg2 = log2f(1.0f - exp2f(-5.0f - (float)h));
        const float g64 = exp2f(lg2 * 64.0f);
        float Dk[16];
#pragma unroll
        for (int i = 0; i < 16; ++i) { const int jj = 32 * jb + (i & 3) + 8 * (i >> 2) + 4 * hh, dj = (32 * ib + r) - jj; Dk[i] = exp2f(lg2 * (float)((dj < 0 ? -dj : dj) + jj - 64)); }
        const float qdec = exp2f(lg2 * (float)(32 * ib + r));
        const float vdec = exp2f(lg2 * (float)(64 - (w + 8 * (lane >> 3))));
        f32x16 acc[2];
#pragma unroll
        for (int e2 = 0; e2 < 2; ++e2)
#pragma unroll
            for (int i = 0; i < 16; ++i) acc[e2][i] = 0.f;
        const int qtile_b = (int)(((size_t)h * PJT + (size_t)rowbase * 256) * 2), ktile_b = (int)(((size_t)(8 + h) * PJT + (size_t)rowbase * 256) * 2),
                  vtile_b = (int)(((size_t)(16 + 2 * h + (sl >> 2)) * PJT + (size_t)rowbase * 256 + (sl & 3) * 64) * 2);
        const unsigned ovoff = (unsigned)((32 * ib + r) * LDR + 4 * hh) * 2u;
#define RET_ISSUE_QK(tile_b, n, bufoff) do { _Pragma("unroll") for (int i_ = 0; i_ < 4; ++i_) { const int pc_ = 4 * w + i_; \
        dma16(sd_proj, lo_qk, (tile_b) + ((n) * 64 + pc_) * 512, (LAS void*)(L + (bufoff) + pc_ * TS)); } } while (0)
#define RET_ISSUE_V(n, bufoff) dma16(sd_proj, lo_v, vtile_b + ((n) * 64 + w) * 512, (LAS void*)(L + (bufoff) + w * VS))
#define RET_ST_WRITE() do { _Pragma("unroll") for (int e2_ = 0; e2_ < 2; ++e2_) _Pragma("unroll") for (int g_ = 0; g_ < 4; ++g_) { v2u sv_; \
            sv_.x = pk2(acc[e2_][4 * g_ + 0], acc[e2_][4 * g_ + 1]); sv_.y = pk2(acc[e2_][4 * g_ + 2], acc[e2_][4 * g_ + 3]); *(LAS v2u*)(L + stw_l + e2_ * SPLANE + 16 * g_) = sv_; } } while (0)
        RET_BAR0();
        RET_ISSUE_QK(qtile_b, 0, QB_OFF); RET_ISSUE_QK(ktile_b, 0, KB_OFF); RET_ISSUE_V(0, VB_OFF);
        v4u qr[4];
#define RET_QLOAD(n) do { const int n_ = (n) < 64 ? (n) : 63; _Pragma("unroll") for (int i_ = 0; i_ < 4; ++i_) qr[i_] = bload16(sd_proj, lo_qk, qtile_b + (n_ * 64 + 4 * w + i_) * 512); } while (0)
        RET_QLOAD(1);
        RET_ST_WRITE();
        for (int n = 0; n < 64; ++n) {
            if (w >= 4 && n > 0) asm volatile("s_waitcnt vmcnt(8) lgkmcnt(0)\n\ts_barrier" ::: "memory"); else asm volatile("s_waitcnt vmcnt(4) lgkmcnt(0)\n\ts_barrier" ::: "memory");
            const int kb_off = KB_OFF + (n & 1) * TILE, vb_off = VB_OFF + (n & 1) * VTILE;
            const int n1 = n + 1 < 64 ? n + 1 : 63;
#define RET_ISSUE_PIECE(j) do { if ((j) < 4) dma16(sd_proj, lo_qk, ktile_b + (n1 * 64 + 4 * w + (j)) * 512, (LAS void*)(L + KB_OFF + ((n + 1) & 1) * TILE + (4 * w + (j)) * TS)); \
                                else RET_ISSUE_V(n1, VB_OFF + ((n + 1) & 1) * VTILE); } while (0)
            {
                LAS v4u* vp = (LAS v4u*)(L + vb_off + vsc_l);
                const v4u vv = *vp;
                acc[0] = acc[0] * g64; acc[1] = acc[1] * g64;
                v4u vo; vo.x = pk2(bflo(vv.x) * vdec, bfhi(vv.x) * vdec); vo.y = pk2(bflo(vv.y) * vdec, bfhi(vv.y) * vdec); vo.z = pk2(bflo(vv.z) * vdec, bfhi(vv.z) * vdec); vo.w = pk2(bflo(vv.w) * vdec, bfhi(vv.w) * vdec);
                *vp = vo;
            }
            f32x16 t;
#pragma unroll
            for (int j = 0; j < 5; ++j) RET_ISSUE_PIECE(j);
            if (w < 4) {
                const unsigned ap_ = (unsigned)(uintptr_t)(L + kb_off + rb + jb * 512), bp_ = (unsigned)(uintptr_t)(L + QB_OFF + rb + ib * 512);
                asm volatile("s_nop 4\n\tds_read_b128 v[200:203], %[a] offset:0\n\tds_read_b128 v[204:207], %[b] offset:0\n\tds_read_b128 v[208:211], %[a] offset:32\n\tds_read_b128 v[212:215], %[b] offset:32\n\tds_read_b128 v[216:219], %[a] offset:64\n\tds_read_b128 v[220:223], %[b] offset:64\n\tds_read_b128 v[224:227], %[a] offset:96\n\tds_read_b128 v[228:231], %[b] offset:96\n\tds_read_b128 v[232:235], %[a] offset:128\n\tds_read_b128 v[236:239], %[b] offset:128\n\ts_waitcnt lgkmcnt(8)\n\tv_mfma_f32_32x32x16_bf16 %[t], v[200:203], v[204:207], 0\n\tds_read_b128 v[200:203], %[a] offset:160\n\tds_read_b128 v[204:207], %[b] offset:160\n\ts_waitcnt lgkmcnt(8)\n\tv_mfma_f32_32x32x16_bf16 %[t], v[208:211], v[212:215], %[t]\n\tds_read_b128 v[208:211], %[a] offset:192\n\tds_read_b128 v[212:215], %[b] offset:192\n\ts_waitcnt lgkmcnt(8)\n\tv_mfma_f32_32x32x16_bf16 %[t], v[216:219], v[220:223], %[t]\n\tds_read_b128 v[216:219], %[a] offset:224\n\tds_read_b128 v[220:223], %[b] offset:224\n\ts_waitcnt lgkmcnt(8)\n\tv_mfma_f32_32x32x16_bf16 %[t], v[224:227], v[228:231], %[t]\n\tds_read_b128 v[224:227], %[a] offset:256\n\tds_read_b128 v[228:231], %[b] offset:256\n\ts_waitcnt lgkmcnt(8)\n\tv_mfma_f32_32x32x16_bf16 %[t], v[232:235], v[236:239], %[t]\n\tds_read_b128 v[232:235], %[a] offset:288\n\tds_read_b128 v[236:239], %[b] offset:288\n\ts_waitcnt lgkmcnt(8)\n\tv_mfma_f32_32x32x16_bf16 %[t], v[200:203], v[204:207], %[t]\n\tds_read_b128 v[200:203], %[a] offset:320\n\tds_read_b128 v[204:207], %[b] offset:320\n\ts_waitcnt lgkmcnt(8)\n\tv_mfma_f32_32x32x16_bf16 %[t], v[208:211], v[212:215], %[t]\n\tds_read_b128 v[208:211], %[a] offset:352\n\tds_read_b128 v[212:215], %[b] offset:352\n\ts_waitcnt lgkmcnt(8)\n\tv_mfma_f32_32x32x16_bf16 %[t], v[216:219], v[220:223], %[t]\n\tds_read_b128 v[216:219], %[a] offset:384\n\tds_read_b128 v[220:223], %[b] offset:384\n\ts_waitcnt lgkmcnt(8)\n\tv_mfma_f32_32x32x16_bf16 %[t], v[224:227], v[228:231], %[t]\n\tds_read_b128 v[224:227], %[a] offset:416\n\tds_read_b128 v[228:231], %[b] offset:416\n\ts_waitcnt lgkmcnt(8)\n\tv_mfma_f32_32x32x16_bf16 %[t], v[232:235], v[236:239], %[t]\n\tds_read_b128 v[232:235], %[a] offset:448\n\tds_read_b128 v[236:239], %[b] offset:448\n\ts_waitcnt lgkmcnt(8)\n\tv_mfma_f32_32x32x16_bf16 %[t], v[200:203], v[204:207], %[t]\n\tds_read_b128 v[200:203], %[a] offset:480\n\tds_read_b128 v[204:207], %[b] offset:480\n\ts_waitcnt lgkmcnt(8)\n\tv_mfma_f32_32x32x16_bf16 %[t], v[208:211], v[212:215], %[t]\n\ts_waitcnt lgkmcnt(6)\n\tv_mfma_f32_32x32x16_bf16 %[t], v[216:219], v[220:223], %[t]\n\ts_waitcnt lgkmcnt(4)\n\tv_mfma_f32_32x32x16_bf16 %[t], v[224:227], v[228:231], %[t]\n\ts_waitcnt lgkmcnt(2)\n\tv_mfma_f32_32x32x16_bf16 %[t], v[232:235], v[236:239], %[t]\n\ts_waitcnt lgkmcnt(0)\n\tv_mfma_f32_32x32x16_bf16 %[t], v[200:203], v[204:207], %[t]\n\ts_nop 15" : [t] "=&v"(t) : [a] "v"(ap_), [b] "v"(bp_) : "memory", "v200", "v201", "v202", "v203", "v204", "v205", "v206", "v207", "v208", "v209", "v210", "v211", "v212", "v213", "v214", "v215", "v216", "v217", "v218", "v219", "v220", "v221", "v222", "v223", "v224", "v225", "v226", "v227", "v228", "v229", "v230", "v231", "v232", "v233", "v234", "v235", "v236", "v237", "v238", "v239");
#pragma unroll
                for (int g = 0; g < 4; ++g) { v2u wv; wv.x = pk2(t[4 * g + 0] * Dk[4 * g + 0], t[4 * g + 1] * Dk[4 * g + 1]); wv.y = pk2(t[4 * g + 2] * Dk[4 * g + 2], t[4 * g + 3] * Dk[4 * g + 3]);
                    *(LAS v2u*)(L + pw_l + ib * 128 + jb * 64 + 16 * g) = wv; }
            } else {
                const unsigned ap_ = (unsigned)(uintptr_t)(L + str_l + eb * SPLANE), bp_ = (unsigned)(uintptr_t)(L + QB_OFF + rb + ib * 512);
                asm volatile("s_nop 4\n\tds_read_b64_tr_b16 v[200:201], %[a] offset:0\n\tds_read_b64_tr_b16 v[202:203], %[a] offset:264\n\tds_read_b128 v[204:207], %[b] offset:0\n\tds_read_b64_tr_b16 v[208:209], %[a] offset:1056\n\tds_read_b64_tr_b16 v[210:211], %[a] offset:1320\n\tds_read_b128 v[212:215], %[b] offset:32\n\tds_read_b64_tr_b16 v[216:217], %[a] offset:2112\n\tds_read_b64_tr_b16 v[218:219], %[a] offset:2376\n\tds_read_b128 v[220:223], %[b] offset:64\n\tds_read_b64_tr_b16 v[224:225], %[a] offset:3168\n\tds_read_b64_tr_b16 v[226:227], %[a] offset:3432\n\tds_read_b128 v[228:231], %[b] offset:96\n\tds_read_b64_tr_b16 v[232:233], %[a] offset:4224\n\tds_read_b64_tr_b16 v[234:235], %[a] offset:4488\n\tds_read_b128 v[236:239], %[b] offset:128\n\ts_waitcnt lgkmcnt(12)\n\tv_mfma_f32_32x32x16_bf16 %[t], v[200:203], v[204:207], 0\n\tds_read_b64_tr_b16 v[200:201], %[a] offset:5280\n\tds_read_b64_tr_b16 v[202:203], %[a] offset:5544\n\tds_read_b128 v[204:207], %[b] offset:160\n\ts_waitcnt lgkmcnt(12)\n\tv_mfma_f32_32x32x16_bf16 %[t], v[208:211], v[212:215], %[t]\n\tds_read_b64_tr_b16 v[208:209], %[a] offset:6336\n\tds_read_b64_tr_b16 v[210:211], %[a] offset:6600\n\tds_read_b128 v[212:215], %[b] offset:192\n\ts_waitcnt lgkmcnt(12)\n\tv_mfma_f32_32x32x16_bf16 %[t], v[216:219], v[220:223], %[t]\n\tds_read_b64_tr_b16 v[216:217], %[a] offset:7392\n\tds_read_b64_tr_b16 v[218:219], %[a] offset:7656\n\tds_read_b128 v[220:223], %[b] offset:224\n\ts_waitcnt lgkmcnt(12)\n\tv_mfma_f32_32x32x16_bf16 %[t], v[224:227], v[228:231], %[t]\n\tds_read_b64_tr_b16 v[224:225], %[a] offset:8448\n\tds_read_b64_tr_b16 v[226:227], %[a] offset:8712\n\tds_read_b128 v[228:231], %[b] offset:256\n\ts_waitcnt lgkmcnt(12)\n\tv_mfma_f32_32x32x16_bf16 %[t], v[232:235], v[236:239], %[t]\n\tds_read_b64_tr_b16 v[232:233], %[a] offset:9504\n\tds_read_b64_tr_b16 v[234:235], %[a] offset:9768\n\tds_read_b128 v[236:239], %[b] offset:288\n\ts_waitcnt lgkmcnt(12)\n\tv_mfma_f32_32x32x16_bf16 %[t], v[200:203], v[204:207], %[t]\n\tds_read_b64_tr_b16 v[200:201], %[a] offset:10560\n\tds_read_b64_tr_b16 v[202:203], %[a] offset:10824\n\tds_read_b128 v[204:207], %[b] offset:320\n\ts_waitcnt lgkmcnt(12)\n\tv_mfma_f32_32x32x16_bf16 %[t], v[208:211], v[212:215], %[t]\n\tds_read_b64_tr_b16 v[208:209], %[a] offset:11616\n\tds_read_b64_tr_b16 v[210:211], %[a] offset:11880\n\tds_read_b128 v[212:215], %[b] offset:352\n\ts_waitcnt lgkmcnt(12)\n\tv_mfma_f32_32x32x16_bf16 %[t], v[216:219], v[220:223], %[t]\n\tds_read_b64_tr_b16 v[216:217], %[a] offset:12672\n\tds_read_b64_tr_b16 v[218:219], %[a] offset:12936\n\tds_read_b128 v[220:223], %[b] offset:384\n\ts_waitcnt lgkmcnt(12)\n\tv_mfma_f32_32x32x16_bf16 %[t], v[224:227], v[228:231], %[t]\n\tds_read_b64_tr_b16 v[224:225], %[a] offset:13728\n\tds_read_b64_tr_b16 v[226:227], %[a] offset:13992\n\tds_read_b128 v[228:231], %[b] offset:416\n\ts_waitcnt lgkmcnt(12)\n\tv_mfma_f32_32x32x16_bf16 %[t], v[232:235], v[236:239], %[t]\n\tds_read_b64_tr_b16 v[232:233], %[a] offset:14784\n\tds_read_b64_tr_b16 v[234:235], %[a] offset:15048\n\tds_read_b128 v[236:239], %[b] offset:448\n\ts_waitcnt lgkmcnt(12)\n\tv_mfma_f32_32x32x16_bf16 %[t], v[200:203], v[204:207], %[t]\n\tds_read_b64_tr_b16 v[200:201], %[a] offset:15840\n\tds_read_b64_tr_b16 v[202:203], %[a] offset:16104\n\tds_read_b128 v[204:207], %[b] offset:480\n\ts_waitcnt lgkmcnt(12)\n\tv_mfma_f32_32x32x16_bf16 %[t], v[208:211], v[212:215], %[t]\n\ts_waitcnt lgkmcnt(9)\n\tv_mfma_f32_32x32x16_bf16 %[t], v[216:219], v[220:223], %[t]\n\ts_waitcnt lgkmcnt(6)\n\tv_mfma_f32_32x32x16_bf16 %[t], v[224:227], v[228:231], %[t]\n\ts_waitcnt lgkmcnt(3)\n\tv_mfma_f32_32x32x16_bf16 %[t], v[232:235], v[236:239], %[t]\n\ts_waitcnt lgkmcnt(0)\n\tv_mfma_f32_32x32x16_bf16 %[t], v[200:203], v[204:207], %[t]\n\ts_nop 15" : [t] "=&v"(t) : [a] "v"(ap_), [b] "v"(bp_) : "memory", "v200", "v201", "v202", "v203", "v204", "v205", "v206", "v207", "v208", "v209", "v210", "v211", "v212", "v213", "v214", "v215", "v216", "v217", "v218", "v219", "v220", "v221", "v222", "v223", "v224", "v225", "v226", "v227", "v228", "v229", "v230", "v231", "v232", "v233", "v234", "v235", "v236", "v237", "v238", "v239");
                t = t * qdec;
            }
            RET_BAR1();
            asm volatile("s_waitcnt vmcnt(5)" : "+v"(qr[0]), "+v"(qr[1]), "+v"(qr[2]), "+v"(qr[3]) :: "memory");
#pragma unroll
            for (int i = 0; i < 4; ++i) *(LAS v4u*)(L + QB_OFF + (4 * w + i) * TS + lane * 16) = qr[i];
            const int n2 = n + 2 < 64 ? n + 2 : 63;
            if (w >= 4) {
                { const unsigned va_ = (unsigned)(uintptr_t)(L + vb_off + vtr_l + eb * 64), pa_ = (unsigned)(uintptr_t)(L + pr_l + ib * 128);
                  asm volatile("s_nop 4\n\tds_read_b64_tr_b16 v[200:201], %[v] offset:0\n\tds_read_b64_tr_b16 v[202:203], %[v] offset:4352\n\tds_read_b128 v[204:207], %[p] offset:0\n\tds_read_b64_tr_b16 v[208:209], %[v] offset:256\n\tds_read_b64_tr_b16 v[210:211], %[v] offset:4608\n\tds_read_b128 v[212:215], %[p] offset:32\n\tds_read_b64_tr_b16 v[216:217], %[v] offset:512\n\tds_read_b64_tr_b16 v[218:219], %[v] offset:4864\n\tds_read_b128 v[220:223], %[p] offset:64\n\tds_read_b64_tr_b16 v[224:225], %[v] offset:768\n\tds_read_b64_tr_b16 v[226:227], %[v] offset:5120\n\tds_read_b128 v[228:231], %[p] offset:96\n\ts_waitcnt lgkmcnt(9)\n\tv_mfma_f32_32x32x16_bf16 %[t], v[200:203], v[204:207], %[t]\n\ts_waitcnt lgkmcnt(6)\n\tv_mfma_f32_32x32x16_bf16 %[t], v[208:211], v[212:215], %[t]\n\ts_waitcnt lgkmcnt(3)\n\tv_mfma_f32_32x32x16_bf16 %[t], v[216:219], v[220:223], %[t]\n\ts_waitcnt lgkmcnt(0)\n\tv_mfma_f32_32x32x16_bf16 %[t], v[224:227], v[228:231], %[t]\n\ts_nop 15" : [t] "+v"(t) : [v] "v"(va_), [p] "v"(pa_) : "memory", "v200", "v201", "v202", "v203", "v204", "v205", "v206", "v207", "v208", "v209", "v210", "v211", "v212", "v213", "v214", "v215", "v216", "v217", "v218", "v219", "v220", "v221", "v222", "v223", "v224", "v225", "v226", "v227", "v228", "v229", "v230", "v231"); }
                const int osoff = ((rowbase + 64 * n) * LDR + h * 512 + sl * 64 + 32 * eb) * 2;
#pragma unroll
                for (int g = 0; g < 4; ++g) { v2u wv; wv.x = pk2(t[4 * g + 0], t[4 * g + 1]); wv.y = pk2(t[4 * g + 2], t[4 * g + 3]);
                    bstore8(sd_ro, wv, ovoff, osoff + 16 * g); }
            }
#pragma unroll
            for (int ks = 0; ks < 4; ++ks) qr[ks] = bload16(sd_proj, lo_qk, qtile_b + (n2 * 64 + 4 * w + ks) * 512);
            { const unsigned ka_ = (unsigned)(uintptr_t)(L + kb_off + ktr_l), va_ = (unsigned)(uintptr_t)(L + vb_off + vtr_l);
              asm volatile("s_nop 4\n\tds_read_b64_tr_b16 v[200:201], %[k] offset:0\n\tds_read_b64_tr_b16 v[202:203], %[k] offset:4160\n\tds_read_b64_tr_b16 v[204:205], %[v] offset:0\n\tds_read_b64_tr_b16 v[206:207], %[v] offset:4352\n\tds_read_b64_tr_b16 v[208:209], %[v] offset:64\n\tds_read_b64_tr_b16 v[210:211], %[v] offset:4416\n\tds_read_b64_tr_b16 v[212:213], %[k] offset:16640\n\tds_read_b64_tr_b16 v[214:215], %[k] offset:20800\n\tds_read_b64_tr_b16 v[216:217], %[v] offset:256\n\tds_read_b64_tr_b16 v[218:219], %[v] offset:4608\n\tds_read_b64_tr_b16 v[220:221], %[v] offset:320\n\tds_read_b64_tr_b16 v[222:223], %[v] offset:4672\n\ts_waitcnt lgkmcnt(6)\n\tv_mfma_f32_32x32x16_bf16 %[c0], v[204:207], v[200:203], %[c0]\n\tv_mfma_f32_32x32x16_bf16 %[c1], v[208:211], v[200:203], %[c1]\n\tds_read_b64_tr_b16 v[224:225], %[k] offset:512\n\tds_read_b64_tr_b16 v[226:227], %[k] offset:4672\n\tds_read_b64_tr_b16 v[228:229], %[v] offset:512\n\tds_read_b64_tr_b16 v[230:231], %[v] offset:4864\n\tds_read_b64_tr_b16 v[232:233], %[v] offset:576\n\tds_read_b64_tr_b16 v[234:235], %[v] offset:4928\n\ts_waitcnt lgkmcnt(6)\n\tv_mfma_f32_32x32x16_bf16 %[c0], v[216:219], v[212:215], %[c0]\n\tv_mfma_f32_32x32x16_bf16 %[c1], v[220:223], v[212:215], %[c1]\n\tds_read_b64_tr_b16 v[200:201], %[k] offset:17152\n\tds_read_b64_tr_b16 v[202:203], %[k] offset:21312\n\tds_read_b64_tr_b16 v[204:205], %[v] offset:768\n\tds_read_b64_tr_b16 v[206:207], %[v] offset:5120\n\tds_read_b64_tr_b16 v[208:209], %[v] offset:832\n\tds_read_b64_tr_b16 v[210:211], %[v] offset:5184\n\ts_waitcnt lgkmcnt(6)\n\tv_mfma_f32_32x32x16_bf16 %[c0], v[228:231], v[224:227], %[c0]\n\tv_mfma_f32_32x32x16_bf16 %[c1], v[232:235], v[224:227], %[c1]\n\ts_waitcnt lgkmcnt(0)\n\tv_mfma_f32_32x32x16_bf16 %[c0], v[204:207], v[200:203], %[c0]\n\tv_mfma_f32_32x32x16_bf16 %[c1], v[208:211], v[200:203], %[c1]\n\ts_nop 15" : [c0] "+v"(acc[0]), [c1] "+v"(acc[1]) : [k] "v"(ka_), [v] "v"(va_) : "memory", "v200", "v201", "v202", "v203", "v204", "v205", "v206", "v207", "v208", "v209", "v210", "v211", "v212", "v213", "v214", "v215", "v216", "v217", "v218", "v219", "v220", "v221", "v222", "v223", "v224", "v225", "v226", "v227", "v228", "v229", "v230", "v231", "v232", "v233", "v234", "v235"); }
            RET_ST_WRITE();
        }
#undef RET_ST_WRITE
#undef RET_ISSUE_V
#undef RET_ISSUE_QK
#undef RET_QLOAD
#undef RET_ISSUE_PIECE
    }
    __builtin_amdgcn_s_setprio(0);
    RET_BAR0();
}

__device__ __forceinline__ void retfin_phase(Frame& F, const bf16* ro, const bf16* proj, const float* gn, bf16* rg) {
    const int gw = blockIdx.x * NWAVES + F.wave, NGW = F.G * NWAVES;
    const f32x4 g0 = *(const f32x4*)(gn + F.lane * 8), g1 = *(const f32x4*)(gn + F.lane * 8 + 4);
    for (int m = gw; m < M; m += NGW) {
        v4u ov[8], gv[8];
#pragma unroll
        for (int h = 0; h < 8; ++h) { ov[h] = *(const v4u*)(ro + (size_t)m * LDR + h * 512 + F.lane * 8); gv[h] = *(const v4u*)(proj + (size_t)(32 + 2 * h + (F.lane >> 5)) * PJT + (size_t)m * 256 + (F.lane & 31) * 8); }
#pragma unroll
        for (int h = 0; h < 8; ++h) {
            float x[8] = {bflo(ov[h].x), bfhi(ov[h].x), bflo(ov[h].y), bfhi(ov[h].y), bflo(ov[h].z), bfhi(ov[h].z), bflo(ov[h].w), bfhi(ov[h].w)};
            const float gt[8] = {bflo(gv[h].x), bfhi(gv[h].x), bflo(gv[h].y), bfhi(gv[h].y), bflo(gv[h].z), bfhi(gv[h].z), bflo(gv[h].w), bfhi(gv[h].w)};
            float s = 0.f;
#pragma unroll
            for (int k = 0; k < 8; ++k) s += x[k];
            const float mu = wave_sum(s) * (1.0f / 512.0f); float q = 0.f;
#pragma unroll
            for (int k = 0; k < 8; ++k) { x[k] -= mu; q += x[k] * x[k]; }
            const float rstd = 1.0f / sqrtf(wave_sum(q) * (1.0f / 512.0f) + EPS);
            v4u w; w.x = pk2(x[0] * rstd * g0.x * gt[0], x[1] * rstd * g0.y * gt[1]); w.y = pk2(x[2] * rstd * g0.z * gt[2], x[3] * rstd * g0.w * gt[3]);
            w.z = pk2(x[4] * rstd * g1.x * gt[4], x[5] * rstd * g1.y * gt[5]); w.w = pk2(x[6] * rstd * g1.z * gt[6], x[7] * rstd * g1.w * gt[7]);
            *(v4u*)(rg + (size_t)m * LDR + h * 512 + F.lane * 8) = w;
        }
    }
}

constexpr int NPH = 18;
struct Args { const float* in[15]; float* out; unsigned char* ws; int ph_lo, ph_hi; };
static_assert(sizeof(Args) == 17 * 8 + 8, "Args has no padding");
__global__ void __launch_bounds__(NWAVES * 64, 2) mk_fwd(Args args) {
    extern __shared__ __attribute__((aligned(16))) unsigned char lds[];
    Frame F;
    F.lds = (LAS unsigned char*)lds;
    F.MISC = (volatile LAS unsigned*)(F.lds + MISC_OFF);
    F.tid = threadIdx.x; F.lane = F.tid & 63; F.wave = __builtin_amdgcn_readfirstlane(F.tid >> 6);
    F.G = gridDim.x;
    unsigned char* ws = args.ws;
    F.ctl = (gu32*)(ws + WS_CTL);
    if (F.tid < 64) F.MISC[F.tid] = 0u;
    __syncthreads();
    XcdBarrier bar; bar.bar = (unsigned*)(F.ctl + CW_BAR); bar.x = 0; bar.st = nullptr;
    if (MK_ONE_LAUNCH) bar = xcd_barrier_post((unsigned*)(F.ctl + CW_BAR), F.MISC + 8);
    const int lo = args.ph_lo, hi = args.ph_hi;
#define IN(k) (lo <= (k) && (k) < hi)
#define SEAM(k) do { if (IN(k) && IN((k) + 1)) xcd_barrier(bar); } while (0)
    const float* x_in = args.in[0]; const float* c_in = args.in[1]; const float* ada_w = args.in[2]; const float* ada_b = args.in[3]; const float* norm_g = args.in[4];
    const float* da_lambda = args.in[8]; const float* da_subln = args.in[9]; const float* ret_gn = args.in[12]; const float* final_g = args.in[14];
    float* xres = args.out;
    unsigned short* XH = (unsigned short*)(ws + WS_XH);
    float* mod = (float*)(ws + WS_MOD);
    bf16* Hb = (bf16*)(ws + WS_H); bf16* BIG = (bf16*)(ws + WS_BIG); bf16* AO = (bf16*)(ws + WS_AO); bf16* RO = (bf16*)(ws + WS_RO);
    LAS unsigned char* glds = F.lds + RING_OFF;

    if (IN(0)) {
        mod_phase(F, c_in, ada_w, ada_b, mod);
        xcd_barrier(bar);
        WPtrs P{args.in[5], args.in[6], args.in[7], args.in[10], args.in[11], args.in[13], ws, mod, (float*)(ws + WS_BIG)};
        convert_phase(F, P);
    }
    SEAM(0);
    if (IN(1)) pre_phase(F, x_in, norm_g, mod, ws);
    SEAM(1);
    float* gsm = (float*)(ws + WS_GSM); float* biasv = (float*)(ws + WS_BIAS); float* ssq = (float*)(ws + WS_SSQ);
    float* PART = (float*)(ws + WS_AO - 2 * MiB);
#define GATE_OF(s) (mod + (size_t)((s) / 3) * NB * NMOD + (3 * ((s) % 3) + 2) * DM)
#define FFN_BLOCK(PH, f, s, XIN, NEXT, SN, FIRST) \
    if (IN(PH)) { pg8::Gemm g{Hb, (const bf16*)(ws + WS_WIN + (f) * WIN_BYTES), M, FF2, DM, LDH, LDH, 1}; pg8::StaticOrder S; S.init(M, FF2, F.G, (int)blockIdx.x); if ((s) != 0) ssq_local(F, S, PART, ssq + (size_t)(s) * M); \
        pg8::EpiSwiglu E{BIG, LDF, ssq + (size_t)(s) * M, biasv + (size_t)(s) * NB * BIASP, BIASP}; pg8::gemm_phase<pg8::EpiSwiglu, pg8::StaticOrder, PG8_ALIGN, PG8_SP2>(glds, g, S, E); } \
    SEAM(PH); \
    if (IN((PH) + 1)) { pg8::Gemm g{BIG, (const bf16*)(ws + WS_WOUT + (f) * WOUT_BYTES), M, DM, FF, LDF, LDF, 1}; pg8::StaticOrder S; S.init(M, DM, F.G, (int)blockIdx.x); \
        pg8::EpiResid<NEXT, FIRST> E{(XIN), XH, GATE_OF(s), Hb, gsm + (size_t)(SN) * NB * DM, PART, NMOD, LDH, 0.5f, 0}; \
        pg8::gemm_phase<pg8::EpiResid<NEXT, FIRST>, pg8::StaticOrder, PG8_ALIGN, PG8_SP2>(glds, g, S, E); } \
    SEAM((PH) + 1);

    FFN_BLOCK(2, 0, 0, x_in, true, 1, true)
    if (IN(4)) { pg8::Gemm g{Hb, (const bf16*)(ws + WS_WQKV), M, NQKV, DM, LDH, LDH, 1}; pg8::StaticOrder S; S.init(M, NQKV, F.G, (int)blockIdx.x); ssq_local(F, S, PART, ssq + (size_t)1 * M);
        pg8::EpiProj<0> E{BIG, LDQ, QSCALE, ssq + (size_t)1 * M, biasv + (size_t)1 * NB * BIASP, BIASP}; pg8::gemm_phase<pg8::EpiProj<0>, pg8::StaticOrder, PG8_ALIGN, PG8_SP2>(glds, g, S, E); }
    SEAM(4);
    if (IN(5)) { att_kmax_phase(F, BIG, (unsigned*)(ws + WS_KMAX)); xcd_barrier(bar); att_pc_phase(F, BIG, AO, da_lambda, da_subln, (const float*)(ws + WS_KMAX)); }
    SEAM(5);
    if (IN(6)) { pg8::Gemm g{AO, (const bf16*)(ws + WS_WODA), M, DM, DM, LDH, LDH, 1}; pg8::StaticOrder S; S.init(M, DM, F.G, (int)blockIdx.x);
        pg8::EpiResid<true, false> E{XH, XH, GATE_OF(1), Hb, gsm + (size_t)2 * NB * DM, PART, NMOD, LDH, 1.0f, 0};
        pg8::gemm_phase<pg8::EpiResid<true, false>, pg8::StaticOrder, PG8_ALIGN, PG8_SP2>(glds, g, S, E); }
    SEAM(6);
    FFN_BLOCK(7, 1, 2, XH, true, 3, false)
    FFN_BLOCK(9, 2, 3, XH, true, 4, false)
    if (IN(11)) { pg8::Gemm g{Hb, (const bf16*)(ws + WS_WQKVG), M, NPROJ, DM, LDH, LDH, 1}; pg8::StaticOrder S; S.init(M, NPROJ, F.G, (int)blockIdx.x); ssq_local(F, S, PART, ssq + (size_t)4 * M);
        pg8::EpiProj<1> E{BIG, LDP, 1.0f, ssq + (size_t)4 * M, biasv + (size_t)4 * NB * BIASP, BIASP}; pg8::gemm_phase<pg8::EpiProj<1>, pg8::StaticOrder, PG8_ALIGN, PG8_SP2>(glds, g, S, E); }
    SEAM(11);
    if (IN(12)) ret_phase(F, BIG, RO);
    SEAM(12);
    if (IN(13)) retfin_phase(F, RO, BIG, ret_gn, AO);
    SEAM(13);
    if (IN(14)) { pg8::Gemm g{AO, (const bf16*)(ws + WS_WORET), M, DM, RVW, LDR, LDR, 0}; pg8::StaticOrder S; S.init(M, DM, F.G, (int)blockIdx.x);
        pg8::EpiResid<true, false> E{XH, XH, GATE_OF(4), Hb, gsm + (size_t)5 * NB * DM, PART, NMOD, LDH, 1.0f, 0};
        pg8::gemm_phase<pg8::EpiResid<true, false>, pg8::StaticOrder, PG8_ALIGN, PG8_SP2>(glds, g, S, E); }
    SEAM(14);
    FFN_BLOCK(15, 3, 5, XH, false, 0, false)
    if (IN(17)) final_phase(F, XH, xres, final_g);
#undef IN
#undef SEAM
#undef GATE_OF
#undef FFN_BLOCK
}

extern "C" void kernel_launch(void* const* d_in, const int* in_sizes, int n_in, void* d_out, int out_size, void* d_ws, size_t ws_size, hipStream_t stream) {
    static int grid = 0;
    if (grid == 0) {
        if (n_in != 15 || in_sizes[0] != M * DM || out_size != M * DM || ws_size < WS_END) { fprintf(stderr, "kernel_launch: unexpected shapes: n_in %d in0 %d out %d ws %zu (need %zu)\n", n_in, n_in > 0 ? in_sizes[0] : -1, out_size, ws_size, (size_t)WS_END); grid = -1; return; }
        int dev = 0, cus = 0, per_cu = 0;
        if (hipGetDevice(&dev) != hipSuccess || hipDeviceGetAttribute(&cus, hipDeviceAttributeMultiprocessorCount, dev) != hipSuccess) { fprintf(stderr, "kernel_launch: device query failed\n"); grid = -1; return; }
        if (hipFuncSetAttribute((const void*)mk_fwd, hipFuncAttributeMaxDynamicSharedMemorySize, LDS_BYTES) != hipSuccess) { fprintf(stderr, "kernel_launch: hipFuncSetAttribute failed\n"); grid = -1; return; }
        if (hipOccupancyMaxActiveBlocksPerMultiprocessor(&per_cu, (const void*)mk_fwd, NWAVES * 64, LDS_BYTES) != hipSuccess || per_cu < 1) fprintf(stderr, "kernel_launch: note: occupancy query reports %d workgroups per CU\n", per_cu);
        (void)hipGetLastError();
        grid = cus;
    }
    if (grid < 0) return;
    if (hipMemsetAsync((char*)d_ws + WS_CTL, 0, CTL_ZERO_BYTES, stream) != hipSuccess) { fprintf(stderr, "kernel_launch: memset failed\n"); return; }
    Args a{};
    for (int i = 0; i < 15; ++i) a.in[i] = (const float*)d_in[i];
    a.out = (float*)d_out; a.ws = (unsigned char*)d_ws;
#if MK_ONE_LAUNCH
    a.ph_lo = 0; a.ph_hi = NPH;
    hipLaunchKernelGGL(mk_fwd, dim3(grid), dim3(NWAVES * 64), LDS_BYTES, stream, a);
#else
    for (int p = 0; p < NPH; ++p) { a.ph_lo = p; a.ph_hi = p + 1; hipLaunchKernelGGL(mk_fwd, dim3(grid), dim3(NWAVES * 64), LDS_BYTES, stream, a); }
#endif
    const hipError_t le = hipPeekAtLastError();
    if (le != hipSuccess) fprintf(stderr, "kernel_launch: launch failed: %s\n", hipGetErrorName(le));
}
```
